# Optimizing an MI355X kernel written in HIP

```python
import math
import jax, jax.numpy as jnp
from jax import lax
import numpy as np

D_MODEL = 1024
BATCH = 8
SEQ = 2048
DEPTH = 2

N_BRANCH = 4
BRANCH_W = D_MODEL // 2
DN_HEADS = 4
DN_DK = BRANCH_W // DN_HEADS
DN_DV = BRANCH_W // DN_HEADS
DN_CHUNK = 64
CONV_W = 4
GM_GROUPS = 4
GM_CH = BRANCH_W // GM_GROUPS
GM_CHUNK = 128
SW_HEADS = 8
SW_KV_HEADS = 2
SW_HD = BRANCH_W // SW_HEADS
SW_WINDOW = 128
SW_BLOCK = 128
MEM_LEN = 256
XM_HEADS = 4
XM_HD = BRANCH_W // XM_HEADS

EPS = 1e-6
NEG_INF = -1e30

IN_SPLITS = [
    3 * BRANCH_W,
    BRANCH_W,
    DN_HEADS,
    DN_HEADS,
    2 * BRANCH_W,
    BRANCH_W,
    SW_HEADS * SW_HD,
    SW_KV_HEADS * SW_HD,
    SW_KV_HEADS * SW_HD,
    BRANCH_W,
    XM_HEADS * XM_HD,
    BRANCH_W,
    N_BRANCH * D_MODEL,
]
D_IN = sum(IN_SPLITS)

kernel_name = "hybrid_parallel_gated_deltanet_gmlp_swa_memory"


def _rmsnorm(x, g):
    xf = x.astype(jnp.float32)
    y = xf * lax.rsqrt(jnp.mean(xf * xf, axis=-1, keepdims=True) + EPS)
    return (y * g.astype(jnp.float32)).astype(x.dtype)


def _l2norm(x):
    return x * lax.rsqrt(jnp.sum(x * x, axis=-1, keepdims=True) + EPS)


def _split_cols(cols):
    idx, acc = [], 0
    for s in IN_SPLITS[:-1]:
        acc += s
        idx.append(acc)
    return jnp.split(cols, idx, axis=-1)


def _causal_dwconv(x, w):
    c = x.shape[-1]
    return lax.conv_general_dilated(
        x, w[:, None, :].astype(x.dtype), window_strides=(1,),
        padding=[(CONV_W - 1, 0)], dimension_numbers=("NWC", "WIO", "NWC"),
        feature_group_count=c)


def _gated_delta_chunked(q, k, v, g, beta):
    B, T, H, dk = q.shape
    dv = v.shape[-1]
    C = DN_CHUNK
    n = T // C

    def blk(a):
        return jnp.moveaxis(a.reshape((B, n, C, H) + a.shape[3:]), 3, 1)

    q, k, v, g, beta = blk(q), blk(k), blk(v), blk(g), blk(beta)
    gc = jnp.cumsum(g, axis=-1)
    diff = gc[..., :, None] - gc[..., None, :]
    ii = jnp.arange(C)
    strict = ii[:, None] > ii[None, :]
    incl = ii[:, None] >= ii[None, :]
    kb = k * beta[..., None]
    L = jnp.where(strict, jnp.einsum("bhncd,bhnsd->bhncs", kb, k)
                  * jnp.exp(jnp.where(strict, diff, 0.0)), 0.0)
    eye = jnp.eye(C, dtype=q.dtype)
    rhs = jnp.concatenate([v * beta[..., None], kb * jnp.exp(gc)[..., None]], axis=-1)
    sol = lax.linalg.triangular_solve(eye + L, rhs, left_side=True, lower=True,
                                      unit_diagonal=True)
    u, w = sol[..., :dv], sol[..., dv:]
    a_qk = jnp.where(incl, jnp.einsum("bhncd,bhnsd->bhncs", q, k)
                     * jnp.exp(jnp.where(incl, diff, 0.0)), 0.0)
    g_last = gc[..., -1]
    qg = q * jnp.exp(gc)[..., None]
    kd = k * jnp.exp(g_last[..., None] - gc)[..., None]
    d_last = jnp.exp(g_last)
    xs = tuple(jnp.moveaxis(a, 2, 0) for a in (qg, kd, u, w, a_qk, d_last))

    def step(S, inp):
        qg_c, kd_c, u_c, w_c, a_c, d_c = inp
        v_new = u_c - jnp.einsum("bhck,bhkv->bhcv", w_c, S)
        o = (jnp.einsum("bhck,bhkv->bhcv", qg_c, S)
             + jnp.einsum("bhcs,bhsv->bhcv", a_c, v_new))
        S = S * d_c[..., None, None] + jnp.einsum("bhck,bhcv->bhkv", kd_c, v_new)
        return S, o

    S0 = jnp.zeros((B, H, dk, dv), jnp.float32)
    _, o = lax.scan(step, S0, xs)
    o = jnp.moveaxis(o, 0, 2)
    return jnp.moveaxis(o, 1, 3).reshape(B, T, H, dv)


def _deltanet_branch(qkv, z, b_logit, a_logit, conv_w, a_log, dt_bias, o_norm):
    B, T, _ = qkv.shape
    qkv = jax.nn.silu(_causal_dwconv(qkv, conv_w)).astype(jnp.float32)
    q, k, v = jnp.split(qkv, 3, axis=-1)
    q = _l2norm(q.reshape(B, T, DN_HEADS, DN_DK)) * (DN_DK ** -0.5)
    k = _l2norm(k.reshape(B, T, DN_HEADS, DN_DK))
    v = v.reshape(B, T, DN_HEADS, DN_DV)
    beta = jax.nn.sigmoid(b_logit.astype(jnp.float32))
    g = -jnp.exp(a_log.astype(jnp.float32)) * jax.nn.softplus(
        a_logit.astype(jnp.float32) + dt_bias.astype(jnp.float32))
    o = _gated_delta_chunked(q, k, v, g, beta)
    o = _rmsnorm(o, o_norm) * jax.nn.silu(z.astype(jnp.float32).reshape(B, T, DN_HEADS, DN_DV))
    return o.reshape(B, T, BRANCH_W).astype(z.dtype)


def _spatial_gating_branch(uv, z, v_gain, w_s, b_s):
    B, T, _ = uv.shape
    u, v = jnp.split(jax.nn.gelu(uv), 2, axis=-1)
    v = _rmsnorm(v, v_gain)
    n = T // GM_CHUNK
    vb = v.reshape(B, n, GM_CHUNK, GM_GROUPS, GM_CH)
    causal = jnp.tril(jnp.ones((GM_CHUNK, GM_CHUNK), dtype=bool))
    ws = jnp.where(causal, w_s, 0.0).astype(v.dtype)
    s = jnp.einsum("gpq,bnqgc->bnpgc", ws, vb) + b_s.T.astype(v.dtype)[None, None, :, :, None]
    return u * s.reshape(B, T, BRANCH_W) * jax.nn.silu(z)


def _sliding_window_branch(q, k, v, z, sinks):
    B, T, _ = q.shape
    P = SW_BLOCK
    n = T // P
    G = SW_HEADS // SW_KV_HEADS
    q = q.reshape(B, n, P, SW_KV_HEADS, G, SW_HD)
    k = k.reshape(B, n, P, SW_KV_HEADS, SW_HD)
    v = v.reshape(B, n, P, SW_KV_HEADS, SW_HD)
    pad = jnp.zeros_like(k[:, :1])
    kb = jnp.concatenate([jnp.concatenate([pad, k[:, :-1]], axis=1), k], axis=2)
    vb = jnp.concatenate([jnp.concatenate([pad, v[:, :-1]], axis=1), v], axis=2)
    s = jnp.einsum("bnqkgd,bnskd->bnkgqs", q, kb).astype(jnp.float32) * (SW_HD ** -0.5)
    qi = jnp.arange(P)[:, None]
    kj = jnp.arange(2 * P)[None, :]
    dist = qi + P - kj
    blk = jnp.arange(n)[:, None, None]
    valid = (dist >= 0) & (dist < SW_WINDOW) & (blk * P - P + kj >= 0)
    s = jnp.where(valid[None, :, None, None], s, NEG_INF)
    sink = jnp.broadcast_to(
        sinks.astype(jnp.float32).reshape(SW_KV_HEADS, G)[None, None, :, :, None, None],
        s.shape[:-1] + (1,))
    p = jax.nn.softmax(jnp.concatenate([s, sink], axis=-1), axis=-1)[..., :-1]
    o = jnp.einsum("bnkgqs,bnskd->bnqkgd", p.astype(vb.dtype), vb).reshape(B, T, BRANCH_W)
    return o * jax.nn.silu(z)


def _memory_branch(q, z, mem_kv):
    B, T, _ = q.shape
    q = q.reshape(B, T, XM_HEADS, XM_HD)
    mk, mv = jnp.split(mem_kv, 2, axis=-1)
    mk = mk.reshape(B, -1, XM_HEADS, XM_HD)
    mv = mv.reshape(B, -1, XM_HEADS, XM_HD)
    s = jnp.einsum("bthd,bmhd->bhtm", q, mk).astype(jnp.float32) * (XM_HD ** -0.5)
    p = jax.nn.softmax(s, axis=-1)
    o = jnp.einsum("bhtm,bmhd->bthd", p.astype(mv.dtype), mv).reshape(B, T, BRANCH_W)
    return o * jax.nn.silu(z)


def _layer(x, mem, norm_pre, norm_post, norm_mem, w_in, conv_w, a_log, dt_bias, dn_norm,
           gm_norm, spatial_w, spatial_b, sinks, w_mem_kv, w_up, w_out):
    B, T, D = x.shape
    h = _rmsnorm(x, norm_pre)
    cols = h @ w_in
    (dn_qkv, dn_z, dn_b, dn_a, gm_uv, gm_z, sw_q, sw_k, sw_v, sw_z,
     xm_q, xm_z, gate_logits) = _split_cols(cols)
    mem_kv = _rmsnorm(mem, norm_mem) @ w_mem_kv
    y_a = _deltanet_branch(dn_qkv, dn_z, dn_b, dn_a, conv_w, a_log, dt_bias, dn_norm)
    y_b = _spatial_gating_branch(gm_uv, gm_z, gm_norm, spatial_w, spatial_b)
    y_c = _sliding_window_branch(sw_q, sw_k, sw_v, sw_z, sinks)
    y_m = _memory_branch(xm_q, xm_z, mem_kv)
    ys = jnp.stack([y_a, y_b, y_c, y_m], axis=2)
    proj = jnp.einsum("btnc,ncd->btnd", ys, w_up)
    gates = jax.nn.sigmoid(gate_logits.reshape(B, T, N_BRANCH, D))
    merged = jnp.sum(gates * proj, axis=2)
    out = merged @ w_out
    return x + _rmsnorm(out, norm_post)


def setup_inputs(seed: int = 0) -> dict:
    key = jax.random.key(seed)
    ks = jax.random.split(key, 20)
    f32 = jnp.float32
    nrm = lambda k, shape, scale: jax.random.normal(k, shape, f32) * scale
    dt = jnp.exp(jax.random.uniform(ks[8], (DEPTH, DN_HEADS), f32,
                                    math.log(1e-3), math.log(1e-1)))
    return {
        "x": nrm(ks[0], (BATCH, SEQ, D_MODEL), 1.0),
        "mem": nrm(ks[1], (BATCH, MEM_LEN, D_MODEL), 1.0),
        "norm_pre": 1.0 + nrm(ks[2], (DEPTH, D_MODEL), 0.1),
        "norm_post": 1.0 + nrm(ks[3], (DEPTH, D_MODEL), 0.1),
        "norm_mem": 1.0 + nrm(ks[4], (DEPTH, D_MODEL), 0.1),
        "w_in": nrm(ks[5], (DEPTH, D_MODEL, D_IN), D_MODEL ** -0.5),
        "conv_w": nrm(ks[6], (DEPTH, CONV_W, 3 * BRANCH_W), CONV_W ** -0.5),
        "a_log": jnp.log(jax.random.uniform(ks[7], (DEPTH, DN_HEADS), f32, 1.0, 16.0)),
        "dt_bias": dt + jnp.log(-jnp.expm1(-dt)),
        "dn_norm": 1.0 + nrm(ks[9], (DEPTH, DN_DV), 0.1),
        "gm_norm": 1.0 + nrm(ks[10], (DEPTH, BRANCH_W), 0.1),
        "spatial_w": nrm(ks[11], (DEPTH, GM_GROUPS, GM_CHUNK, GM_CHUNK), GM_CHUNK ** -0.5),
        "spatial_b": 1.0 + nrm(ks[12], (DEPTH, GM_GROUPS, GM_CHUNK), 0.1),
        "sinks": nrm(ks[13], (DEPTH, SW_HEADS), 1.0),
        "w_mem_kv": nrm(ks[14], (DEPTH, D_MODEL, 2 * BRANCH_W), D_MODEL ** -0.5),
        "w_up": nrm(ks[15], (DEPTH, N_BRANCH, BRANCH_W, D_MODEL), BRANCH_W ** -0.5),
        "w_out": nrm(ks[16], (DEPTH, D_MODEL, D_MODEL), D_MODEL ** -0.5),
    }


def reference(x, mem, norm_pre, norm_post, norm_mem, w_in, conv_w, a_log, dt_bias, dn_norm,
              gm_norm, spatial_w, spatial_b, sinks, w_mem_kv, w_up, w_out):
    for l in range(DEPTH):
        x = _layer(x, mem, norm_pre[l], norm_post[l], norm_mem[l], w_in[l], conv_w[l],
                   a_log[l], dt_bias[l], dn_norm[l], gm_norm[l], spatial_w[l], spatial_b[l],
                   sinks[l], w_mem_kv[l], w_up[l], w_out[l])
    return x
```

```cpp
#include <hip/hip_runtime.h>
#include <hip/hip_cooperative_groups.h>
#include <cstdio>
#include <cstdint>
namespace cg = cooperative_groups;

#define LAS __attribute__((address_space(3)))
typedef unsigned short bf16_t;
typedef short bf16x8 __attribute__((ext_vector_type(8)));
typedef float f32x4 __attribute__((ext_vector_type(4)));
typedef unsigned u32x4 __attribute__((ext_vector_type(4)));
typedef unsigned u32x2 __attribute__((ext_vector_type(2)));

constexpr int NB = 8, T = 2048, M = NB * T, D = 1024, NC = 5888, DIN = 9992;
constexpr int C_DNQ = 0, C_DNK = 512, C_DNV = 1024, C_DNZ = 1536, C_GMU = 2048, C_GMV = 2560, C_GMZ = 3072, C_SWQ = 3584, C_SWK = 4096, C_SWV = 4224,
              C_SWZ = 4352, C_XMQ = 4864, C_XMZ = 5376;
constexpr float EPS = 1e-6f;
constexpr size_t MiB = 1u << 20;
constexpr size_t WS_WINT = 1 * MiB, WS_WGT = WS_WINT + 12058624, WS_WUPT = WS_WGT + 8 * MiB, WS_WOUTT = WS_WUPT + 4 * MiB, WS_WMKVT = WS_WOUTT + 2 * MiB,
                 WS_SPW = WS_WMKVT + 2 * MiB;
constexpr size_t WS_H = 29 * MiB, WS_COLS = 61 * MiB, WS_OUT = WS_COLS, WS_X = 245 * MiB;
constexpr size_t WS_WA_W = WS_X, WS_WA_A = WS_X + 16 * MiB, WS_HALO = WS_X + 24 * MiB, WS_SM = WS_X + 27 * MiB, WS_DL = WS_SM + 512 * 1024,
                 WS_MEMN = WS_X + 28 * MiB, WS_MEMKV = WS_X + 32 * MiB, WS_GSCR = WS_X, WS_MERGED = WS_X + 32 * MiB, WS_END = 309 * MiB;
constexpr int LDS_BYTES = 155648;

struct Params {
    const float *x, *mem, *norm_pre, *norm_post, *norm_mem, *w_in, *conv_w, *a_log, *dt_bias, *dn_norm, *gm_norm, *spatial_w, *spatial_b, *sinks, *w_mem_kv,
        *w_up, *w_out;
    float* out;
    unsigned char* ws;
};

__device__ __forceinline__ unsigned f2bf(float f) { unsigned u = __float_as_uint(f); return (u + 0x7fffu + ((u >> 16) & 1u)) >> 16; }
__device__ __forceinline__ float bf2f(unsigned b) { return __uint_as_float(b << 16); }
__device__ __forceinline__ unsigned cvt_pk_bf16(float lo, float hi) { unsigned r; asm volatile("v_cvt_pk_bf16_f32 %0, %1, %2" : "=v"(r) : "v"(lo), "v"(hi)); return r; }
__device__ __forceinline__ float lo_bf(unsigned w) { return __uint_as_float(w << 16); }
__device__ __forceinline__ float hi_bf(unsigned w) { return __uint_as_float(w & 0xffff0000u); }
__device__ __forceinline__ float wave_sum(float v) {
#pragma unroll
    for (int o = 1; o < 64; o <<= 1) v += __shfl_xor(v, o);
    return v;
}
__device__ __forceinline__ float silu_f(float y) { return y / (1.f + __expf(-y)); }
__device__ __forceinline__ float sigmoid_f(float y) { return 1.f / (1.f + __expf(-y)); }
__device__ __forceinline__ float gelu_tanh_f(float x) {
    const float u = 0.7978845608f * (x + 0.044715f * x * x * x);
    const float t = 1.f - 2.f / (__expf(2.f * u) + 1.f);
    return 0.5f * x * (1.f + t);
}
__device__ __forceinline__ bf16x8 pack8(const f32x4 a, const f32x4 b) {
    u32x4 w; w.x = cvt_pk_bf16(a[0], a[1]); w.y = cvt_pk_bf16(a[2], a[3]); w.z = cvt_pk_bf16(b[0], b[1]); w.w = cvt_pk_bf16(b[2], b[3]);
    return __builtin_bit_cast(bf16x8, w);
}
__device__ __forceinline__ bf16x8 lds_ld2x8(const LAS unsigned char* pl) {
    const u32x2 lo = *(const LAS u32x2*)pl, hi = *(const LAS u32x2*)(pl + 32);
    u32x4 w; w.x = lo.x; w.y = lo.y; w.z = hi.x; w.w = hi.y; return __builtin_bit_cast(bf16x8, w);
}
#define MFMA16(a, b, c) __builtin_amdgcn_mfma_f32_16x16x32_bf16((a), (b), (c), 0, 0, 0)

namespace pg8 {
constexpr int BM = 256, BK = 64, HALF = 128, HTB = HALF * BK * 2, STAGE_BYTES = 8 * HTB;
__device__ __forceinline__ int lds_byte(int r, int c) { const int st = (r >> 4) * 2 + (c >> 5), rr = r & 15, cc = c & 31, ob = rr * 64 + cc * 2; return st * 1024 + (ob ^ (((ob >> 9) & 1) << 5)); }
__device__ __forceinline__ void stage_rc(int b, int& R, int& C) { const int st = b / 1024, sb = b % 1024, swz = sb ^ (((sb >> 9) & 1) << 5); R = (st >> 1) * 16 + swz / 64; C = (st & 1) * 32 + (swz % 64) / 2; }
__device__ __forceinline__ int perm32(int rho) { const int n = rho >> 4, i = rho & 15; return 8 * (i >> 2) + 4 * n + (i & 3); }

struct Unit { const char* a; const char* b; unsigned lda, ldb; int nt; int pm, pn, kind, sub; };

__device__ __forceinline__ void mkoff(const Unit& u, int tid, unsigned (&vA)[2], unsigned (&vB)[2]) {
#pragma unroll
    for (int i = 0; i < 2; ++i) { int R, C; stage_rc(tid * 16 + i * 8192, R, C); const int Rb = (R & ~31) + perm32(R & 31);
        vA[i] = (unsigned)(R * u.lda + C) * 2u; vB[i] = (unsigned)(Rb * u.ldb + C) * 2u; }
}

template <class Epi, class Sched>
__device__ __forceinline__ void gemm_phase(LAS unsigned char* lds, const Sched& S, const Epi& E) {
    int tid_ = threadIdx.x; asm volatile("" : "+v"(tid_));
    const int tid = tid_, wid = __builtin_amdgcn_readfirstlane(tid >> 6), lane = tid & 63, wr = wid >> 2, wc = wid & 3, fr = lane & 15, fq = lane >> 4;
    const size_t kstep = (size_t)(BK * 2);
    const unsigned ldsw = (unsigned)wid * 1024u;
    const int aoff = lds_byte(wr * 64 + fr, fq * 8), boff = lds_byte(wc * 32 + fr, fq * 8);
#define PG8_SA(b, h) (((b) * 2 + (h)) * HTB)
#define PG8_SB(b, h) ((4 + (b) * 2 + (h)) * HTB)
#define PG8_STAGE(bufoff, gbase, voff) do { _Pragma("unroll") for (int _i = 0; _i < 2; ++_i) \
        __builtin_amdgcn_global_load_lds((const unsigned*)((const char*)(gbase) + (voff)[_i]), (LAS unsigned*)(lds + (bufoff) + ldsw + _i * 8192), 16, 0, 0); } while (0)
#define PG8_LDA(dst, b, h) do { _Pragma("unroll") for (int m = 0; m < 4; ++m) _Pragma("unroll") for (int k = 0; k < 2; ++k) dst[m][k] = *(const LAS bf16x8*)(lds + PG8_SA(b, h) + aoff + m * 2048 + k * 1024); } while (0)
#define PG8_LDB(dst, b, h) do { _Pragma("unroll") for (int n = 0; n < 2; ++n) _Pragma("unroll") for (int k = 0; k < 2; ++k) dst[n][k] = *(const LAS bf16x8*)(lds + PG8_SB(b, h) + boff + n * 2048 + k * 1024); } while (0)
#define PG8_MMA(ai, bj, At, Bt) do { __builtin_amdgcn_s_setprio(1); _Pragma("unroll") for (int m = 0; m < 4; ++m) _Pragma("unroll") for (int n = 0; n < 2; ++n) _Pragma("unroll") for (int k = 0; k < 2; ++k) \
        acc[ai][bj][m][n] = __builtin_amdgcn_mfma_f32_16x16x32_bf16(Bt[n][k], At[m][k], acc[ai][bj][m][n], 0, 0, 0); __builtin_amdgcn_s_setprio(0); } while (0)
#define PG8_WAIT_V(n) asm volatile("s_waitcnt vmcnt(" #n ")" ::: "memory")
#define PG8_WAIT_L(n) asm volatile("s_waitcnt lgkmcnt(" #n ")" ::: "memory")
#define PG8_BAR __builtin_amdgcn_s_barrier()
#define PG8_SCHED __builtin_amdgcn_sched_barrier(0)
    Unit cur, nxt; int ui = 0;
    if (!S.next(0, cur)) return;
    f32x4 acc[2][2][4][2];
#pragma unroll
    for (int a = 0; a < 2; ++a)
#pragma unroll
        for (int b = 0; b < 2; ++b)
#pragma unroll
            for (int m = 0; m < 4; ++m)
#pragma unroll
                for (int n = 0; n < 2; ++n) acc[a][b][m][n] = (f32x4){0.f, 0.f, 0.f, 0.f};
    bf16x8 At[4][2], B0[2][2], B1[2][2];
    unsigned vAc[2], vBc[2], vAn[2], vBn[2];
    mkoff(cur, tid, vAc, vBc);
    const char* cA = cur.a; const char* cB = cur.b;
    size_t hAc = (size_t)HALF * cur.lda * 2, hBc = (size_t)HALF * cur.ldb * 2;
    PG8_STAGE(PG8_SB(0, 0), cB, vBc); PG8_STAGE(PG8_SB(0, 1), cB + hBc, vBc); PG8_STAGE(PG8_SA(0, 0), cA, vAc); PG8_STAGE(PG8_SA(0, 1), cA + hAc, vAc);
    if (wr == 1) PG8_BAR;
    PG8_WAIT_V(2); PG8_BAR;
    PG8_STAGE(PG8_SB(1, 0), cB + kstep, vBc); PG8_STAGE(PG8_SA(1, 0), cA + kstep, vAc); PG8_STAGE(PG8_SB(1, 1), cB + hBc + kstep, vBc);
    PG8_WAIT_V(6); PG8_BAR;
    for (;;) {
        const bool has_next = S.next(ui + 1, nxt);
        const char* nA = cA; const char* nB = cB; size_t hAn = hAc, hBn = hBc;
        vAn[0] = vAc[0]; vAn[1] = vAc[1]; vBn[0] = vBc[0]; vBn[1] = vBc[1];
        if (has_next) { nA = nxt.a; nB = nxt.b; mkoff(nxt, tid, vAn, vBn); hAn = (size_t)HALF * nxt.lda * 2; hBn = (size_t)HALF * nxt.ldb * 2; }
        const int nt = cur.nt;
        for (int t = 0; t < nt; t += 2) {
            const bool last = (t == nt - 2);
            const char* a1 = cA + (size_t)(t + 1) * kstep;
            const char* a2 = last ? nA : cA + (size_t)(t + 2) * kstep; const char* b2 = last ? nB : cB + (size_t)(t + 2) * kstep;
            const char* a3 = a2 + kstep; const char* b3 = b2 + kstep;
            unsigned vA2[2], vB2[2];
            vA2[0] = last ? vAn[0] : vAc[0]; vA2[1] = last ? vAn[1] : vAc[1]; vB2[0] = last ? vBn[0] : vBc[0]; vB2[1] = last ? vBn[1] : vBc[1];
            const size_t hA2 = last ? hAn : hAc, hB2 = last ? hBn : hBc;
            PG8_LDB(B0, 0, 0); PG8_LDB(B1, 0, 1); PG8_SCHED; PG8_LDA(At, 0, 0); PG8_STAGE(PG8_SA(1, 1), a1 + hAc, vAc);
            PG8_WAIT_V(8); PG8_WAIT_L(0); PG8_BAR; PG8_MMA(0, 0, At, B0); PG8_MMA(0, 1, At, B1); PG8_BAR; PG8_SCHED;
            PG8_LDA(At, 0, 1); PG8_STAGE(PG8_SB(0, 0), b2, vB2); PG8_STAGE(PG8_SB(0, 1), b2 + hB2, vB2); PG8_STAGE(PG8_SA(0, 0), a2, vA2);
            PG8_WAIT_V(8); PG8_WAIT_L(0); PG8_BAR; PG8_MMA(1, 0, At, B0); PG8_MMA(1, 1, At, B1); PG8_BAR; PG8_SCHED;
            PG8_LDB(B0, 1, 0); PG8_LDB(B1, 1, 1); PG8_SCHED; PG8_LDA(At, 1, 0); PG8_STAGE(PG8_SA(0, 1), a2 + hA2, vA2);
            PG8_WAIT_V(8); PG8_WAIT_L(0); PG8_BAR; PG8_MMA(0, 0, At, B0); PG8_MMA(0, 1, At, B1); PG8_BAR; PG8_SCHED;
            PG8_LDA(At, 1, 1); PG8_STAGE(PG8_SB(1, 0), b3, vB2); PG8_STAGE(PG8_SB(1, 1), b3 + hB2, vB2); PG8_STAGE(PG8_SA(1, 0), a3, vA2);
            PG8_WAIT_V(8); PG8_WAIT_L(0); PG8_BAR; PG8_MMA(1, 0, At, B0); PG8_MMA(1, 1, At, B1); PG8_BAR; PG8_SCHED;
        }
        if (wr == 0) PG8_BAR;
        E(acc, cur, wr, wc, fr, fq, tid);
        if (!has_next) break;
#pragma unroll
        for (int a = 0; a < 2; ++a)
#pragma unroll
            for (int b = 0; b < 2; ++b)
#pragma unroll
                for (int m = 0; m < 4; ++m)
#pragma unroll
                    for (int n = 0; n < 2; ++n) acc[a][b][m][n] = (f32x4){0.f, 0.f, 0.f, 0.f};
        cur = nxt; cA = nA; cB = nB; hAc = hAn; hBc = hBn; vAc[0] = vAn[0]; vAc[1] = vAn[1]; vBc[0] = vBn[0]; vBc[1] = vBn[1]; ++ui;
        if (wr == 1) PG8_BAR;
    }
    PG8_WAIT_V(0);
    PG8_BAR;
#undef PG8_SA
#undef PG8_SB
#undef PG8_STAGE
#undef PG8_LDA
#undef PG8_LDB
#undef PG8_MMA
#undef PG8_WAIT_V
#undef PG8_WAIT_L
#undef PG8_BAR
#undef PG8_SCHED
}
}
using pg8::Unit;

struct Epi {
    unsigned char* ws;
    __device__ __forceinline__ void operator()(const f32x4 (&acc)[2][2][4][2], const Unit& u, int wr, int wc, int fr, int fq, int tid) const {
        asm volatile("" : "+v"(tid), "+v"(fr), "+v"(fq));
        const int row0 = u.pm * 256 + wr * 64 + fr, col0 = u.pn * 256 + wc * 32 + 8 * fq;
        if (u.kind == 0) {
            bf16_t* cols = (bf16_t*)(ws + WS_COLS); bf16_t* halo = (bf16_t*)(ws + WS_HALO);
            const int pn = u.pn;
            const int act = (pn == 6 || pn == 7 || pn == 12 || pn == 13 || pn == 17 || pn == 18 || pn >= 21) ? 1 : ((pn >= 8 && pn <= 11) ? 2 : 0);
#pragma unroll
            for (int ai = 0; ai < 2; ++ai)
#pragma unroll
                for (int m = 0; m < 4; ++m) {
                    const int r = row0 + ai * 128 + m * 16;
                    bf16_t* rowp = cols + (size_t)r * NC + col0;
#pragma unroll
                    for (int bj = 0; bj < 2; ++bj) {
                        f32x4 v0 = acc[ai][bj][m][0], v1 = acc[ai][bj][m][1];
                        if (act == 1) {
#pragma unroll
                            for (int e = 0; e < 4; ++e) { v0[e] = silu_f(v0[e]); v1[e] = silu_f(v1[e]); }
                        } else if (act == 2) {
#pragma unroll
                            for (int e = 0; e < 4; ++e) { v0[e] = gelu_tanh_f(v0[e]); v1[e] = gelu_tanh_f(v1[e]); }
                        }
                        u32x4 w; w.x = cvt_pk_bf16(v0[0], v0[1]); w.y = cvt_pk_bf16(v0[2], v0[3]); w.z = cvt_pk_bf16(v1[0], v1[1]); w.w = cvt_pk_bf16(v1[2], v1[3]);
                        *(u32x4*)(rowp + bj * 128) = w;
                        if (pn < 6 && (r & 63) >= 61) *(u32x4*)(halo + ((size_t)(r >> 6) * 3 + ((r & 63) - 61)) * 1536 + col0 + bj * 128) = w;
                    }
                }
        } else if (u.kind == 1) {
            bf16_t* o = (bf16_t*)(ws + WS_MEMKV);
#pragma unroll
            for (int ai = 0; ai < 2; ++ai)
#pragma unroll
                for (int m = 0; m < 4; ++m) {
                    bf16_t* rowp = o + (size_t)(row0 + ai * 128 + m * 16) * 1024 + col0;
#pragma unroll
                    for (int bj = 0; bj < 2; ++bj) {
                        const f32x4 v0 = acc[ai][bj][m][0], v1 = acc[ai][bj][m][1];
                        u32x4 w; w.x = cvt_pk_bf16(v0[0], v0[1]); w.y = cvt_pk_bf16(v0[2], v0[3]); w.z = cvt_pk_bf16(v1[0], v1[1]); w.w = cvt_pk_bf16(v1[2], v1[3]);
                        *(u32x4*)(rowp + bj * 128) = w;
                    }
                }
        } else if (u.kind == 2) {
            u32x4* g = (u32x4*)(ws + WS_GSCR) + (size_t)(u.pm * 4 + u.pn) * 16 * 512 + tid;
#pragma unroll
            for (int ai = 0; ai < 2; ++ai)
#pragma unroll
                for (int m = 0; m < 4; ++m)
#pragma unroll
                    for (int bj = 0; bj < 2; ++bj) {
                        const f32x4 v0 = acc[ai][bj][m][0], v1 = acc[ai][bj][m][1];
                        u32x4 w; w.x = cvt_pk_bf16(sigmoid_f(v0[0]), sigmoid_f(v0[1])); w.y = cvt_pk_bf16(sigmoid_f(v0[2]), sigmoid_f(v0[3]));
                        w.z = cvt_pk_bf16(sigmoid_f(v1[0]), sigmoid_f(v1[1])); w.w = cvt_pk_bf16(sigmoid_f(v1[2]), sigmoid_f(v1[3]));
                        g[(size_t)((ai * 4 + m) * 2 + bj) * 512] = w;
                    }
        } else if (u.kind == 3) {
            const u32x4* g = (const u32x4*)(ws + WS_GSCR) + (size_t)(u.pm * 4 + u.pn) * 16 * 512 + tid;
            bf16_t* mg = (bf16_t*)(ws + WS_MERGED);
#pragma unroll
            for (int ai = 0; ai < 2; ++ai)
#pragma unroll
                for (int m = 0; m < 4; ++m) {
                    bf16_t* rowp = mg + (size_t)(row0 + ai * 128 + m * 16) * 1024 + col0;
#pragma unroll
                    for (int bj = 0; bj < 2; ++bj) {
                        const f32x4 v0 = acc[ai][bj][m][0], v1 = acc[ai][bj][m][1];
                        const u32x4 gw = g[(size_t)((ai * 4 + m) * 2 + bj) * 512];
                        float r0 = lo_bf(gw.x) * v0[0], r1 = hi_bf(gw.x) * v0[1], r2 = lo_bf(gw.y) * v0[2], r3 = hi_bf(gw.y) * v0[3];
                        float r4 = lo_bf(gw.z) * v1[0], r5 = hi_bf(gw.z) * v1[1], r6 = lo_bf(gw.w) * v1[2], r7 = hi_bf(gw.w) * v1[3];
                        if (u.sub > 0) { const u32x4 pw = *(const u32x4*)(rowp + bj * 128);
                            r0 += lo_bf(pw.x); r1 += hi_bf(pw.x); r2 += lo_bf(pw.y); r3 += hi_bf(pw.y); r4 += lo_bf(pw.z); r5 += hi_bf(pw.z); r6 += lo_bf(pw.w); r7 += hi_bf(pw.w); }
                        u32x4 w; w.x = cvt_pk_bf16(r0, r1); w.y = cvt_pk_bf16(r2, r3); w.z = cvt_pk_bf16(r4, r5); w.w = cvt_pk_bf16(r6, r7);
                        *(u32x4*)(rowp + bj * 128) = w;
                        asm volatile("" ::: "memory");
                    }
                }
        } else {
            float* o = (float*)(ws + WS_OUT);
#pragma unroll
            for (int ai = 0; ai < 2; ++ai)
#pragma unroll
                for (int m = 0; m < 4; ++m) {
                    float* rowp = o + (size_t)(row0 + ai * 128 + m * 16) * 1024 + col0;
#pragma unroll
                    for (int bj = 0; bj < 2; ++bj) { *(f32x4*)(rowp + bj * 128) = acc[ai][bj][m][0]; *(f32x4*)(rowp + bj * 128 + 4) = acc[ai][bj][m][1]; }
                }
        }
    }
};

struct SchedA {
    const unsigned char* ws; int G, c;
    __device__ __forceinline__ bool next(int i, Unit& u) const {
        const int L = i * G + c;
        constexpr int nN = 23, nwg = 64 * nN;
        if (L < nwg) {
            int wgid = L; { const int q = nwg / 8, xcd = wgid % 8, off = wgid / 8; wgid = xcd * q + off; }
            const int nig = 8 * nN, gid = wgid / nig, fm = gid * 8;
            u.pm = fm + ((wgid % nig) % 8); u.pn = (wgid % nig) / 8; u.kind = 0; u.sub = 0; u.lda = 1024; u.ldb = 1024; u.nt = 16;
            u.a = (const char*)(ws + WS_H) + (size_t)u.pm * 256 * 1024 * 2; u.b = (const char*)(ws + WS_WINT) + (size_t)u.pn * 256 * 1024 * 2;
            return true;
        }
        const int r = L - nwg; if (r >= 32) return false;
        u.pm = r >> 2; u.pn = r & 3; u.kind = 1; u.sub = 0; u.lda = 1024; u.ldb = 1024; u.nt = 16;
        u.a = (const char*)(ws + WS_MEMN) + (size_t)u.pm * 256 * 1024 * 2; u.b = (const char*)(ws + WS_WMKVT) + (size_t)u.pn * 256 * 1024 * 2;
        return true;
    }
};
struct SchedD {
    const unsigned char* ws; int G, vcu;
    __device__ __forceinline__ bool next(int i, Unit& u) const {
        const int tile = vcu + (i >> 3) * G; if (tile >= 256) return false;
        const int sub = i & 7, n = sub >> 1;
        u.pm = tile >> 2; u.pn = tile & 3; u.sub = n;
        if ((sub & 1) == 0) { u.kind = 2; u.lda = 1024; u.ldb = 1024; u.nt = 16;
            u.a = (const char*)(ws + WS_H) + (size_t)u.pm * 256 * 1024 * 2; u.b = (const char*)(ws + WS_WGT) + (size_t)(n * 1024 + u.pn * 256) * 1024 * 2;
        } else { u.kind = 3; u.lda = NC; u.ldb = 512; u.nt = 8;
            const int yoff = n == 0 ? C_DNZ : (n == 1 ? C_GMU : (n == 2 ? C_SWQ : C_XMQ));
            u.a = (const char*)(ws + WS_COLS) + ((size_t)u.pm * 256 * NC + yoff) * 2; u.b = (const char*)(ws + WS_WUPT) + (size_t)(n * 1024 + u.pn * 256) * 512 * 2; }
        return true;
    }
};
struct SchedE {
    const unsigned char* ws; int G, vcu;
    __device__ __forceinline__ bool next(int i, Unit& u) const {
        const int tile = vcu + i * G; if (tile >= 256) return false;
        u.pm = tile >> 2; u.pn = tile & 3; u.kind = 4; u.sub = 0; u.lda = 1024; u.ldb = 1024; u.nt = 16;
        u.a = (const char*)(ws + WS_MERGED) + (size_t)u.pm * 256 * 1024 * 2; u.b = (const char*)(ws + WS_WOUTT) + (size_t)u.pn * 256 * 1024 * 2;
        return true;
    }
};

__device__ __forceinline__ void tr_item(const float* W, int ldw, int k0, bf16_t* WT, int Kdst, LAS float* scr, int lane) {
#pragma unroll 8
    for (int i = 0; i < 32; ++i) { const int kk = 2 * i + (lane >> 5); scr[kk * 33 + (lane & 31)] = W[(size_t)(k0 + kk) * ldw + (lane & 31)]; }
    asm volatile("s_waitcnt lgkmcnt(0)" ::: "memory");
    const int c = lane & 7;
#pragma unroll
    for (int j = 0; j < 4; ++j) { const int n = (lane >> 3) + 8 * j; const LAS float* s = scr + (8 * c) * 33 + n;
        u32x4 o; o.x = cvt_pk_bf16(s[0 * 33], s[1 * 33]); o.y = cvt_pk_bf16(s[2 * 33], s[3 * 33]); o.z = cvt_pk_bf16(s[4 * 33], s[5 * 33]); o.w = cvt_pk_bf16(s[6 * 33], s[7 * 33]);
        *(u32x4*)(WT + (size_t)n * Kdst + k0 + 8 * c) = o; }
    asm volatile("s_waitcnt lgkmcnt(0)" ::: "memory");
}

__device__ __forceinline__ void p0_stage(const Params& p, int rk, LAS unsigned char* lds) {
    int tid_ = threadIdx.x; asm volatile("" : "+v"(tid_));
    const int tid = tid_, lane = tid & 63, wave = tid >> 6;
    const int gw = blockIdx.x * 8 + wave, NGW = gridDim.x * 8;
    unsigned char* ws = p.ws;
    LAS float* W8T = (LAS float*)(lds + 8 * 8448);
    if (rk <= 1) {
        const int l = rk;
        const float* win = p.w_in + (size_t)l * 1024 * DIN;
        for (int idx = tid; idx < 8192; idx += 512) { const int k = idx >> 3, j = idx & 7; W8T[j * 1024 + k] = win[(size_t)k * DIN + 2048 + j]; }
        LAS float* scr = (LAS float*)(lds + wave * 8448);
        for (int it = gw; it < 7040; it += NGW) {
            if (it < 2944) { const int kb = it / 184, nb = it % 184, n0 = 32 * nb, sc = n0 < 2048 ? n0 : n0 + 8;
                tr_item(win + sc, DIN, 64 * kb, (bf16_t*)(ws + WS_WINT) + (size_t)n0 * 1024, 1024, scr, lane);
            } else if (it < 4992) { const int r = it - 2944, kb = r / 128, nb = r % 128;
                tr_item(win + 5896 + 32 * nb, DIN, 64 * kb, (bf16_t*)(ws + WS_WGT) + (size_t)(32 * nb) * 1024, 1024, scr, lane);
            } else if (it < 6016) { const int r = it - 4992, n = r / 256, r2 = r % 256, kb = r2 / 32, nb = r2 % 32;
                tr_item(p.w_up + (size_t)(l * 4 + n) * 512 * 1024 + 32 * nb, 1024, 64 * kb, (bf16_t*)(ws + WS_WUPT) + (size_t)(n * 1024 + 32 * nb) * 512, 512, scr, lane);
            } else if (it < 6528) { const int r = it - 6016, kb = r / 32, nb = r % 32;
                tr_item(p.w_out + (size_t)l * 1024 * 1024 + 32 * nb, 1024, 64 * kb, (bf16_t*)(ws + WS_WOUTT) + (size_t)(32 * nb) * 1024, 1024, scr, lane);
            } else { const int r = it - 6528, kb = r / 32, nb = r % 32;
                tr_item(p.w_mem_kv + (size_t)l * 1024 * 1024 + 32 * nb, 1024, 64 * kb, (bf16_t*)(ws + WS_WMKVT) + (size_t)(32 * nb) * 1024, 1024, scr, lane);
            }
        }
        for (int e = blockIdx.x * 512 + tid; e < 65536; e += gridDim.x * 512) { const int pp = (e >> 7) & 127, qq = e & 127;
            ((bf16_t*)(ws + WS_SPW))[e] = (bf16_t)(qq <= pp ? f2bf(p.spatial_w[(size_t)l * 65536 + e]) : 0u); }
        for (int r = gw; r < 2048; r += NGW) {
            const f32x4* xr = (const f32x4*)(p.mem + (size_t)r * D) + lane; const f32x4* gr = (const f32x4*)(p.norm_mem + l * D) + lane;
            f32x4 v[4]; float ss = 0.f;
#pragma unroll
            for (int j = 0; j < 4; ++j) { v[j] = xr[64 * j]; ss += v[j][0] * v[j][0] + v[j][1] * v[j][1] + v[j][2] * v[j][2] + v[j][3] * v[j][3]; }
            const float rstd = rsqrtf(wave_sum(ss) * (1.f / D) + EPS);
            u32x2* o = (u32x2*)((bf16_t*)(ws + WS_MEMN) + (size_t)r * D) + lane;
#pragma unroll
            for (int j = 0; j < 4; ++j) { const f32x4 g = gr[64 * j]; u32x2 w; w.x = cvt_pk_bf16(v[j][0] * rstd * g[0], v[j][1] * rstd * g[1]); w.y = cvt_pk_bf16(v[j][2] * rstd * g[2], v[j][3] * rstd * g[3]); o[64 * j] = w; }
        }
    }
    __syncthreads();
    const float* xin = rk == 2 ? p.out : p.x;
    for (int row = gw; row < M; row += NGW) {
        const f32x4* xr = (const f32x4*)(xin + (size_t)row * D) + lane;
        f32x4 v[4];
#pragma unroll
        for (int j = 0; j < 4; ++j) v[j] = xr[64 * j];
        if (rk >= 1) {
            const f32x4* orow = (const f32x4*)((const float*)(ws + WS_OUT) + (size_t)row * D) + lane; const f32x4* gr = (const f32x4*)(p.norm_post + (rk - 1) * D) + lane;
            f32x4 o[4]; float ss = 0.f;
#pragma unroll
            for (int j = 0; j < 4; ++j) { o[j] = orow[64 * j]; ss += o[j][0] * o[j][0] + o[j][1] * o[j][1] + o[j][2] * o[j][2] + o[j][3] * o[j][3]; }
            const float rstd = rsqrtf(wave_sum(ss) * (1.f / D) + EPS);
            f32x4* dst = (f32x4*)(p.out + (size_t)row * D) + lane;
#pragma unroll
            for (int j = 0; j < 4; ++j) { const f32x4 g = gr[64 * j]; v[j] = v[j] + o[j] * rstd * g; dst[64 * j] = v[j]; }
        }
        if (rk <= 1) {
            const f32x4* gr = (const f32x4*)(p.norm_pre + rk * D) + lane;
            float ss = 0.f;
#pragma unroll
            for (int j = 0; j < 4; ++j) ss += v[j][0] * v[j][0] + v[j][1] * v[j][1] + v[j][2] * v[j][2] + v[j][3] * v[j][3];
            const float rstd = rsqrtf(wave_sum(ss) * (1.f / D) + EPS);
            u32x2* o = (u32x2*)((bf16_t*)(ws + WS_H) + (size_t)row * D) + lane;
#pragma unroll
            for (int j = 0; j < 4; ++j) { const f32x4 g = gr[64 * j]; v[j] = v[j] * rstd * g; u32x2 w; w.x = cvt_pk_bf16(v[j][0], v[j][1]); w.y = cvt_pk_bf16(v[j][2], v[j][3]); o[64 * j] = w; }
            float* sm = (float*)(ws + WS_SM) + (size_t)row * 8;
#pragma unroll
            for (int jj = 0; jj < 8; ++jj) { float a = 0.f;
#pragma unroll
                for (int j = 0; j < 4; ++j) { const f32x4 w = *(const LAS f32x4*)(W8T + jj * 1024 + 256 * j + 4 * lane); a += v[j][0] * w[0] + v[j][1] * w[1] + v[j][2] * w[2] + v[j][3] * w[3]; }
                a = wave_sum(a); if (lane == 0) sm[jj] = a; }
        }
    }
    __syncthreads();
}

__device__ __forceinline__ void delta_pre_unit(const Params& p, int l, int unit, LAS unsigned char* lds) {
    int tid_ = threadIdx.x; asm volatile("" : "+v"(tid_));
    const int tid = tid_, lane = tid & 63, wave = tid >> 6;
    const int h = unit & 3, gch = unit >> 2, c = gch & 31;
    const size_t row0 = (size_t)gch * 64;
    unsigned char* ws = p.ws;
    bf16_t* cols = (bf16_t*)(ws + WS_COLS);
    LAS float* Qf = (LAS float*)lds; LAS float* Kf = Qf + 64 * 129; LAS float* Vf = Kf + 64 * 129; LAS float* Lf = Vf + 64 * 129;
    LAS bf16_t* Qb = (LAS bf16_t*)(Lf + 64 * 68); LAS bf16_t* Kb = Qb + 64 * 136;
    LAS float* gcs = (LAS float*)(Kb + 64 * 136); LAS float* betas = gcs + 64; LAS float* facs = betas + 64;
    if (tid < 384) {
        const int part = tid >> 7, cc = tid & 127, col = part * 512 + h * 128 + cc;
        const float* cw = p.conv_w + (size_t)l * 4 * 1536 + col;
        const float w0 = cw[0], w1 = cw[1536], w2 = cw[2 * 1536], w3 = cw[3 * 1536];
        float x3 = 0.f, x2 = 0.f, x1 = 0.f;
        if (c > 0) { const bf16_t* hp = (const bf16_t*)(ws + WS_HALO) + (size_t)(gch - 1) * 3 * 1536 + col; x3 = bf2f(hp[0]); x2 = bf2f(hp[1536]); x1 = bf2f(hp[2 * 1536]); }
        LAS float* dst = (part == 0 ? Qf : (part == 1 ? Kf : Vf)) + cc;
        const bf16_t* src = cols + row0 * NC + col;
#pragma unroll 4
        for (int r = 0; r < 64; ++r) { const float x0 = bf2f(src[(size_t)r * NC]); const float y = w0 * x3 + w1 * x2 + w2 * x1 + w3 * x0; dst[r * 129] = silu_f(y); x3 = x2; x2 = x1; x1 = x0; }
    } else if (wave == 6) {
        const float* sm = (const float*)(ws + WS_SM) + (row0 + lane) * 8;
        const float a = sm[4 + h] + p.dt_bias[l * 4 + h];
        const float sp = a > 20.f ? a : log1pf(__expf(a));
        float g = -__expf(p.a_log[l * 4 + h]) * sp;
#pragma unroll
        for (int o = 1; o < 64; o <<= 1) { const float t = __shfl_up(g, o); if (lane >= o) g += t; }
        gcs[lane] = g;
    } else {
        const float* sm = (const float*)(ws + WS_SM) + (row0 + lane) * 8;
        betas[lane] = sigmoid_f(sm[h]);
    }
    __syncthreads();
    if (tid < 64) { facs[tid] = betas[tid]; facs[64 + tid] = betas[tid] * __expf(gcs[tid]); }
    {
        const int r = tid >> 3, sub = tid & 7; float sq = 0.f, sk = 0.f;
#pragma unroll
        for (int e = 0; e < 16; ++e) { const float a = Qf[r * 129 + sub * 16 + e]; sq += a * a; const float b = Kf[r * 129 + sub * 16 + e]; sk += b * b; }
        sq += __shfl_xor(sq, 1); sq += __shfl_xor(sq, 2); sq += __shfl_xor(sq, 4);
        sk += __shfl_xor(sk, 1); sk += __shfl_xor(sk, 2); sk += __shfl_xor(sk, 4);
        const float rq = rsqrtf(sq + EPS) * 0.08838834764831845f, rkk = rsqrtf(sk + EPS);
#pragma unroll
        for (int e = 0; e < 16; ++e) { const int o = sub * 16 + e; const float a = Qf[r * 129 + o] * rq; Qb[r * 136 + o] = (bf16_t)f2bf(a);
            const float b = Kf[r * 129 + o] * rkk; Kf[r * 129 + o] = b; Kb[r * 136 + o] = (bf16_t)f2bf(b); }
    }
    __syncthreads();
    bf16_t* a_out = (bf16_t*)(ws + WS_WA_A) + (size_t)unit * 4096;
    {
        const int i = lane & 15, q = lane >> 4;
        for (int job = wave; job < 26; job += 8) {
            int kind, ct, st;
            if (job < 10) { kind = 0; ct = job >= 6 ? 3 : (job >= 3 ? 2 : (job >= 1 ? 1 : 0)); st = job - ct * (ct + 1) / 2; }
            else { kind = 1; ct = (job - 10) >> 2; st = (job - 10) & 3; }
            f32x4 acc = {0.f, 0.f, 0.f, 0.f};
            if (st <= ct) {
                const LAS bf16_t* Ab = kind == 0 ? Kb : Qb;
#pragma unroll
                for (int ks = 0; ks < 4; ++ks) { const bf16x8 a = *(const LAS bf16x8*)(Ab + (16 * ct + i) * 136 + 32 * ks + 8 * q); const bf16x8 b = *(const LAS bf16x8*)(Kb + (16 * st + i) * 136 + 32 * ks + 8 * q);
                    acc = MFMA16(a, b, acc); }
            }
            const int s = 16 * st + i; const float gs = gcs[s];
#pragma unroll
            for (int r = 0; r < 4; ++r) { const int cr = 16 * ct + 4 * q + r; const float e = __expf(fminf(gcs[cr] - gs, 0.f));
                if (kind == 0) Lf[cr * 68 + s] = (cr > s) ? acc[r] * betas[cr] * e : 0.f;
                else a_out[cr * 64 + s] = (bf16_t)f2bf(cr >= s ? acc[r] * e : 0.f); }
        }
    }
    __syncthreads();
    if (tid < 256) {
        const int j = tid; const bool isv = j < 128; const int jj = j & 127;
        const LAS float* src = (isv ? Vf : Kf) + jj;
        const LAS float* fac = facs + (isv ? 0 : 64);
        float x[64];
#pragma unroll
        for (int i = 0; i < 64; ++i) {
            const int Lrow = __float_as_int(Lf[i * 68 + lane]);
            float s = src[i * 129] * fac[i];
#pragma unroll
            for (int jx = 0; jx < i; ++jx) s -= __int_as_float(__builtin_amdgcn_readlane(Lrow, jx)) * x[jx];
            x[i] = s;
        }
        if (isv) { bf16_t* dst = cols + (row0 + (jj >> 1)) * NC + C_DNV + h * 128 + (jj & 1) * 64;
#pragma unroll
            for (int g8 = 0; g8 < 8; ++g8) { u32x4 w; w.x = cvt_pk_bf16(x[8 * g8], x[8 * g8 + 1]); w.y = cvt_pk_bf16(x[8 * g8 + 2], x[8 * g8 + 3]); w.z = cvt_pk_bf16(x[8 * g8 + 4], x[8 * g8 + 5]); w.w = cvt_pk_bf16(x[8 * g8 + 6], x[8 * g8 + 7]);
                *(u32x4*)(dst + 8 * g8) = w; }
        } else { bf16_t* wo = (bf16_t*)(ws + WS_WA_W) + (size_t)unit * 8192 + jj;
#pragma unroll
            for (int i = 0; i < 64; ++i) wo[i * 128] = (bf16_t)f2bf(x[i]); }
    } else {
        const int t2 = tid - 256;
        { const int cr = t2 >> 2, d0 = (t2 & 3) * 32; const float e = __expf(gcs[cr]);
            bf16_t* dst = cols + (row0 + cr) * NC + C_DNQ + h * 128 + d0;
#pragma unroll
            for (int g4 = 0; g4 < 4; ++g4) { const u32x4 v = *(const LAS u32x4*)(Qb + cr * 136 + d0 + 8 * g4); u32x4 w;
                w.x = cvt_pk_bf16(lo_bf(v.x) * e, hi_bf(v.x) * e); w.y = cvt_pk_bf16(lo_bf(v.y) * e, hi_bf(v.y) * e); w.z = cvt_pk_bf16(lo_bf(v.z) * e, hi_bf(v.z) * e); w.w = cvt_pk_bf16(lo_bf(v.w) * e, hi_bf(v.w) * e);
                *(u32x4*)(dst + 8 * g4) = w; } }
        { const int dk = t2 & 127, c0 = (t2 >> 7) * 32; const float gl = gcs[63];
            bf16_t* dst = cols + (row0 + (dk >> 1)) * NC + C_DNK + h * 128 + (dk & 1) * 64 + c0;
#pragma unroll
            for (int g4 = 0; g4 < 4; ++g4) { float v[8];
#pragma unroll
                for (int e = 0; e < 8; ++e) { const int cr = c0 + 8 * g4 + e; v[e] = Kf[cr * 129 + dk] * __expf(gl - gcs[cr]); }
                u32x4 w; w.x = cvt_pk_bf16(v[0], v[1]); w.y = cvt_pk_bf16(v[2], v[3]); w.z = cvt_pk_bf16(v[4], v[5]); w.w = cvt_pk_bf16(v[6], v[7]);
                *(u32x4*)(dst + 8 * g4) = w; } }
        if (t2 == 0) ((float*)(ws + WS_DL))[unit] = __expf(gcs[63]);
    }
    __syncthreads();
}

__device__ __forceinline__ void delta_scan_unit(const Params& p, int l, int bh, LAS unsigned char* lds) {
    int tid_ = threadIdx.x; asm volatile("" : "+v"(tid_));
    const int tid = tid_, lane = tid & 63, wave = tid >> 6, i = lane & 15, q = lane >> 4, dv0 = 16 * wave;
    const int b = bh >> 2, h = bh & 3;
    unsigned char* ws = p.ws;
    const unsigned char* colsb = ws + WS_COLS;
    constexpr int BUFB = 62464, O_W = 0, O_QG = 17408, O_KD = 34816, O_A = 53248;
    LAS float* part = (LAS float*)(lds + 2 * BUFB);
    const float gn = p.dn_norm[l * 128 + dv0 + i];
    const int pw0 = tid, pw1 = tid + 512;
    u32x4 pre[7];
#define SCAN_LOAD(cidx) do { const int gch_ = b * 32 + (cidx); const size_t r0_ = (size_t)gch_ * 64; const int un_ = gch_ * 4 + h; \
        const unsigned char* wsrc_ = ws + WS_WA_W + (size_t)un_ * 16384; const unsigned char* asrc_ = ws + WS_WA_A + (size_t)un_ * 8192; \
        pre[0] = *(const u32x4*)(wsrc_ + pw0 * 16); pre[1] = *(const u32x4*)(wsrc_ + pw1 * 16); \
        pre[2] = *(const u32x4*)(colsb + ((r0_ + (pw0 >> 4)) * NC + C_DNQ + h * 128) * 2 + (pw0 & 15) * 16); pre[3] = *(const u32x4*)(colsb + ((r0_ + (pw1 >> 4)) * NC + C_DNQ + h * 128) * 2 + (pw1 & 15) * 16); \
        pre[4] = *(const u32x4*)(colsb + ((r0_ + (pw0 >> 4)) * NC + C_DNK + h * 128) * 2 + (pw0 & 15) * 16); pre[5] = *(const u32x4*)(colsb + ((r0_ + (pw1 >> 4)) * NC + C_DNK + h * 128) * 2 + (pw1 & 15) * 16); \
        pre[6] = *(const u32x4*)(asrc_ + pw0 * 16); } while (0)
#define SCAN_STORE(bufp) do { LAS unsigned char* b_ = (bufp); \
        *(LAS u32x4*)(b_ + O_W + (pw0 >> 4) * 272 + (pw0 & 15) * 16) = pre[0]; *(LAS u32x4*)(b_ + O_W + (pw1 >> 4) * 272 + (pw1 & 15) * 16) = pre[1]; \
        *(LAS u32x4*)(b_ + O_QG + (pw0 >> 4) * 272 + (pw0 & 15) * 16) = pre[2]; *(LAS u32x4*)(b_ + O_QG + (pw1 >> 4) * 272 + (pw1 & 15) * 16) = pre[3]; \
        *(LAS u32x4*)(b_ + O_KD + (pw0 >> 3) * 144 + (pw0 & 7) * 16) = pre[4]; *(LAS u32x4*)(b_ + O_KD + (pw1 >> 3) * 144 + (pw1 & 7) * 16) = pre[5]; \
        *(LAS u32x4*)(b_ + O_A + (pw0 >> 3) * 144 + (pw0 & 7) * 16) = pre[6]; } while (0)
    SCAN_LOAD(0); SCAN_STORE(lds);
    __syncthreads();
    f32x4 S[8];
#pragma unroll
    for (int t = 0; t < 8; ++t) S[t] = (f32x4){0.f, 0.f, 0.f, 0.f};
#pragma unroll 1
    for (int c = 0; c < 32; ++c) {
        const LAS unsigned char* buf = lds + (c & 1) * BUFB;
        if (c + 1 < 32) SCAN_LOAD(c + 1);
        const int gch = b * 32 + c; const size_t row0 = (size_t)gch * 64; const int un = gch * 4 + h;
        const float dl = ((const float*)(ws + WS_DL))[un];
        bf16x8 Sb[4];
#pragma unroll
        for (int ks = 0; ks < 4; ++ks) Sb[ks] = pack8(S[2 * ks], S[2 * ks + 1]);
        u32x2 uraw[4];
        { const unsigned char* ub = colsb + ((row0 + ((dv0 + i) >> 1)) * NC + C_DNV + h * 128 + ((dv0 + i) & 1) * 64 + 4 * q) * 2;
#pragma unroll
            for (int mt = 0; mt < 4; ++mt) uraw[mt] = *(const u32x2*)(ub + mt * 32); }
        f32x4 vn[4];
#pragma unroll
        for (int mt = 0; mt < 4; ++mt) { f32x4 acc = {0.f, 0.f, 0.f, 0.f};
#pragma unroll
            for (int ks = 0; ks < 4; ++ks) acc = MFMA16(lds_ld2x8(buf + O_W + (16 * mt + i) * 272 + (32 * ks + 4 * q) * 2), Sb[ks], acc);
            vn[mt] = (f32x4){lo_bf(uraw[mt].x) - acc[0], hi_bf(uraw[mt].x) - acc[1], lo_bf(uraw[mt].y) - acc[2], hi_bf(uraw[mt].y) - acc[3]}; }
        bf16x8 Vb[2];
        Vb[0] = pack8(vn[0], vn[1]); Vb[1] = pack8(vn[2], vn[3]);
        f32x4 o[4];
#pragma unroll
        for (int mt = 0; mt < 4; ++mt) { f32x4 acc = {0.f, 0.f, 0.f, 0.f};
#pragma unroll
            for (int ks = 0; ks < 4; ++ks) acc = MFMA16(lds_ld2x8(buf + O_QG + (16 * mt + i) * 272 + (32 * ks + 4 * q) * 2), Sb[ks], acc);
#pragma unroll
            for (int k2 = 0; k2 < 2; ++k2) if (k2 <= (mt >> 1)) acc = MFMA16(lds_ld2x8(buf + O_A + (16 * mt + i) * 144 + (32 * k2 + 4 * q) * 2), Vb[k2], acc);
            o[mt] = acc; }
#pragma unroll
        for (int t = 0; t < 8; ++t) { f32x4 acc = S[t] * dl;
#pragma unroll
            for (int k2 = 0; k2 < 2; ++k2) acc = MFMA16(lds_ld2x8(buf + O_KD + (16 * t + i) * 144 + (32 * k2 + 4 * q) * 2), Vb[k2], acc);
            S[t] = acc; }
        LAS float* pt = part + (c & 1) * 512;
#pragma unroll
        for (int mt = 0; mt < 4; ++mt)
#pragma unroll
            for (int r = 0; r < 4; ++r) { float sq = o[mt][r] * o[mt][r]; sq += __shfl_xor(sq, 1); sq += __shfl_xor(sq, 2); sq += __shfl_xor(sq, 4); sq += __shfl_xor(sq, 8);
                if (i == 0) pt[(16 * mt + 4 * q + r) * 8 + wave] = sq; }
        if (c + 1 < 32) SCAN_STORE(lds + ((c + 1) & 1) * BUFB);
        __syncthreads();
#pragma unroll
        for (int mt = 0; mt < 4; ++mt)
#pragma unroll
            for (int r = 0; r < 4; ++r) { const int cr = 16 * mt + 4 * q + r;
                const f32x4 s0 = *(const LAS f32x4*)(pt + cr * 8), s1 = *(const LAS f32x4*)(pt + cr * 8 + 4);
                const float ss = (s0[0] + s0[1]) + (s0[2] + s0[3]) + (s1[0] + s1[1]) + (s1[2] + s1[3]);
                const float rstd = rsqrtf(ss * (1.f / 128.f) + EPS);
                bf16_t* zp = (bf16_t*)(ws + WS_COLS) + (row0 + cr) * NC + C_DNZ + h * 128 + dv0 + i;
                const float z = bf2f(*zp);
                *zp = (bf16_t)f2bf(o[mt][r] * rstd * gn * z); }
    }
#undef SCAN_LOAD
#undef SCAN_STORE
    __syncthreads();
}

__device__ __forceinline__ void gmlp_unit(const Params& p, int l, int unit, LAS unsigned char* lds) {
    int tid_ = threadIdx.x; asm volatile("" : "+v"(tid_));
    const int tid = tid_, lane = tid & 63, wave = tid >> 6, i = lane & 15, q = lane >> 4;
    const int g = unit & 3, bn = unit >> 2;
    const size_t row0 = (size_t)bn * 128;
    unsigned char* ws = p.ws;
    bf16_t* cols = (bf16_t*)(ws + WS_COLS);
    LAS float* rstd = (LAS float*)lds;
    LAS bf16_t* vT = (LAS bf16_t*)(lds + 512);
    for (int tt = 0; tt < 16; ++tt) { const int r = 16 * wave + tt;
        const u32x4 v = *(const u32x4*)(cols + (row0 + r) * NC + C_GMV + lane * 8);
        float ss = lo_bf(v.x) * lo_bf(v.x) + hi_bf(v.x) * hi_bf(v.x) + lo_bf(v.y) * lo_bf(v.y) + hi_bf(v.y) * hi_bf(v.y) + lo_bf(v.z) * lo_bf(v.z) + hi_bf(v.z) * hi_bf(v.z) + lo_bf(v.w) * lo_bf(v.w) + hi_bf(v.w) * hi_bf(v.w);
        ss = wave_sum(ss); if (lane == 0) rstd[r] = rsqrtf(ss * (1.f / 512.f) + EPS); }
    __syncthreads();
#pragma unroll
    for (int it = 0; it < 4; ++it) { const int pc = tid + 512 * it, qrow = pc >> 4, cp = pc & 15;
        const u32x4 v = *(const u32x4*)(cols + (row0 + qrow) * NC + C_GMV + g * 128 + cp * 8);
        const float* gp = p.gm_norm + l * 512 + g * 128 + cp * 8; const float rs = rstd[qrow];
        const float f[8] = {lo_bf(v.x), hi_bf(v.x), lo_bf(v.y), hi_bf(v.y), lo_bf(v.z), hi_bf(v.z), lo_bf(v.w), hi_bf(v.w)};
#pragma unroll
        for (int e = 0; e < 8; ++e) vT[(cp * 8 + e) * 136 + qrow] = (bf16_t)f2bf(f[e] * rs * gp[e]); }
    __syncthreads();
    {
        const int pt = wave; const int nks = (pt >> 1) + 1;
        const bf16_t* spw = (const bf16_t*)(ws + WS_SPW) + (size_t)g * 16384 + (16 * pt + i) * 128 + 8 * q;
        bf16x8 Bf[4];
#pragma unroll
        for (int ks = 0; ks < 4; ++ks) Bf[ks] = *(const bf16x8*)(spw + 32 * ks);
        const float bias = p.spatial_b[l * 512 + g * 128 + 16 * pt + i];
        const size_t prow = row0 + 16 * pt + i;
#pragma unroll 2
        for (int ct = 0; ct < 8; ++ct) { f32x4 acc = {0.f, 0.f, 0.f, 0.f};
#pragma unroll
            for (int ks = 0; ks < 4; ++ks) if (ks < nks) acc = MFMA16(*(const LAS bf16x8*)(vT + (16 * ct + i) * 136 + 32 * ks + 8 * q), Bf[ks], acc);
            const int ch = g * 128 + 16 * ct + 4 * q;
            u32x2* up = (u32x2*)(cols + prow * NC + C_GMU + ch); const u32x2 uu = *up; const u32x2 zz = *(const u32x2*)(cols + prow * NC + C_GMZ + ch);
            u32x2 w; w.x = cvt_pk_bf16(lo_bf(uu.x) * (acc[0] + bias) * lo_bf(zz.x), hi_bf(uu.x) * (acc[1] + bias) * hi_bf(zz.x));
            w.y = cvt_pk_bf16(lo_bf(uu.y) * (acc[2] + bias) * lo_bf(zz.y), hi_bf(uu.y) * (acc[3] + bias) * hi_bf(zz.y));
            *up = w; }
    }
    __syncthreads();
}

template <int HD, int NK, bool SWA>
__device__ __forceinline__ void attn_tile16(bf16_t* qp, const bf16_t* zp, const LAS bf16_t* Kl, const LAS bf16_t* VTl, int kp_lo, int kp_hi, float scale, float m0, float l0, int qi0, bool blk0, int lane) {
    const int i = lane & 15, q = lane >> 4;
    bf16x8 Qf[HD / 32];
#pragma unroll
    for (int kd = 0; kd < HD / 32; ++kd) Qf[kd] = *(const bf16x8*)(qp + (size_t)i * NC + 32 * kd + 8 * q);
    float m = m0, lsum = l0;
    f32x4 O[HD / 16];
#pragma unroll
    for (int dt = 0; dt < HD / 16; ++dt) O[dt] = (f32x4){0.f, 0.f, 0.f, 0.f};
    const int qi = qi0 + i;
    for (int kp = kp_lo; kp <= kp_hi; ++kp) {
        f32x4 s0 = {0.f, 0.f, 0.f, 0.f}, s1 = {0.f, 0.f, 0.f, 0.f};
#pragma unroll
        for (int kd = 0; kd < HD / 32; ++kd) {
            s0 = MFMA16(*(const LAS bf16x8*)(Kl + (32 * kp + i) * (HD + 8) + 32 * kd + 8 * q), Qf[kd], s0);
            s1 = MFMA16(*(const LAS bf16x8*)(Kl + (32 * kp + 16 + i) * (HD + 8) + 32 * kd + 8 * q), Qf[kd], s1);
        }
        float mx = -1e30f;
#pragma unroll
        for (int r = 0; r < 4; ++r) {
            float a = s0[r] * scale, b = s1[r] * scale;
            if (SWA) { const int k0 = 32 * kp + 4 * q + r, k1 = k0 + 16;
                if (!(k0 >= qi + 1 && k0 <= qi + 128 && (!blk0 || k0 >= 128))) a = -1e30f;
                if (!(k1 >= qi + 1 && k1 <= qi + 128 && (!blk0 || k1 >= 128))) b = -1e30f; }
            s0[r] = a; s1[r] = b; mx = fmaxf(mx, fmaxf(a, b));
        }
        mx = fmaxf(mx, __shfl_xor(mx, 16)); mx = fmaxf(mx, __shfl_xor(mx, 32));
        const float mn = fmaxf(m, mx), alpha = __expf(m - mn);
        float ps = 0.f;
#pragma unroll
        for (int r = 0; r < 4; ++r) { s0[r] = __expf(s0[r] - mn); s1[r] = __expf(s1[r] - mn); ps += s0[r] + s1[r]; }
        ps += __shfl_xor(ps, 16); ps += __shfl_xor(ps, 32);
        lsum = lsum * alpha + ps; m = mn;
        const bf16x8 Pb = pack8(s0, s1);
#pragma unroll
        for (int dt = 0; dt < HD / 16; ++dt) { O[dt] = O[dt] * alpha;
            O[dt] = MFMA16(lds_ld2x8((const LAS unsigned char*)(VTl + (16 * dt + i) * (NK + 8) + 32 * kp + 4 * q)), Pb, O[dt]); }
    }
    const float inv = 1.f / lsum;
#pragma unroll
    for (int dt = 0; dt < HD / 16; ++dt) { const int d = 16 * dt + 4 * q;
        const u32x2 zz = *(const u32x2*)(zp + (size_t)i * NC + d);
        u32x2 w; w.x = cvt_pk_bf16(O[dt][0] * inv * lo_bf(zz.x), O[dt][1] * inv * hi_bf(zz.x)); w.y = cvt_pk_bf16(O[dt][2] * inv * lo_bf(zz.y), O[dt][3] * inv * hi_bf(zz.y));
        *(u32x2*)(qp + (size_t)i * NC + d) = w; }
}

__device__ __forceinline__ void swa_unit(const Params& p, int l, int unit, LAS unsigned char* lds) {
    int tid_ = threadIdx.x; asm volatile("" : "+v"(tid_));
    const int tid = tid_, lane = tid & 63, wave = tid >> 6;
    const int kvh = unit & 1, bn = unit >> 1, n = bn & 15, b = bn >> 4;
    unsigned char* ws = p.ws; bf16_t* cols = (bf16_t*)(ws + WS_COLS);
    LAS bf16_t* Kl = (LAS bf16_t*)lds;
    LAS bf16_t* VTl = Kl + 256 * 72;
    const long krow0 = (long)b * T + (long)(n - 1) * 128;
#pragma unroll
    for (int it = 0; it < 4; ++it) { const int pc = tid + 512 * it, kj = pc >> 3, cp = pc & 7;
        u32x4 kv = {0u, 0u, 0u, 0u}, vv = {0u, 0u, 0u, 0u};
        if (n > 0 || kj >= 128) { const bf16_t* rp = cols + (size_t)(krow0 + kj) * NC; kv = *(const u32x4*)(rp + C_SWK + kvh * 64 + cp * 8); vv = *(const u32x4*)(rp + C_SWV + kvh * 64 + cp * 8); }
        *(LAS u32x4*)(Kl + kj * 72 + cp * 8) = kv;
        const unsigned vw[4] = {vv.x, vv.y, vv.z, vv.w};
#pragma unroll
        for (int e = 0; e < 4; ++e) { VTl[(cp * 8 + 2 * e) * 264 + kj] = (bf16_t)(vw[e] & 0xffffu); VTl[(cp * 8 + 2 * e + 1) * 264 + kj] = (bf16_t)(vw[e] >> 16); } }
    __syncthreads();
    {
        const int g = wave >> 1, hq = kvh * 4 + g;
        const float sink = p.sinks[l * 8 + hq];
        for (int qt = 0; qt < 4; ++qt) {
            const int qi0 = (wave & 1) * 64 + 16 * qt;
            const size_t qrow = (size_t)b * T + n * 128 + qi0;
            int kp_lo = (qi0 + 1) >> 5, kp_hi = (qi0 + 143) >> 5; if (kp_hi > 7) kp_hi = 7; if (n == 0 && kp_lo < 4) kp_lo = 4;
            attn_tile16<64, 256, true>(cols + qrow * NC + C_SWQ + hq * 64, cols + qrow * NC + C_SWZ + hq * 64, Kl, VTl, kp_lo, kp_hi, 0.125f, sink, 1.f, qi0, n == 0, lane);
        }
    }
    __syncthreads();
}

__device__ __forceinline__ void xmem_unit(const Params& p, int l, int unit, LAS unsigned char* lds) {
    int tid_ = threadIdx.x; asm volatile("" : "+v"(tid_));
    const int tid = tid_, lane = tid & 63, wave = tid >> 6;
    const int qb = unit & 7, hm = (unit >> 3) & 3, b = unit >> 5;
    unsigned char* ws = p.ws; bf16_t* cols = (bf16_t*)(ws + WS_COLS);
    const bf16_t* mkv = (const bf16_t*)(ws + WS_MEMKV) + (size_t)b * 256 * 1024;
    LAS bf16_t* Kl = (LAS bf16_t*)lds;
    LAS bf16_t* VTl = Kl + 256 * 136;
#pragma unroll
    for (int it = 0; it < 8; ++it) { const int pc = tid + 512 * it, kj = pc >> 4, cp = pc & 15;
        const bf16_t* rp = mkv + (size_t)kj * 1024 + hm * 128 + cp * 8;
        const u32x4 kv = *(const u32x4*)rp, vv = *(const u32x4*)(rp + 512);
        *(LAS u32x4*)(Kl + kj * 136 + cp * 8) = kv;
        const unsigned vw[4] = {vv.x, vv.y, vv.z, vv.w};
#pragma unroll
        for (int e = 0; e < 4; ++e) { VTl[(cp * 8 + 2 * e) * 264 + kj] = (bf16_t)(vw[e] & 0xffffu); VTl[(cp * 8 + 2 * e + 1) * 264 + kj] = (bf16_t)(vw[e] >> 16); } }
    __syncthreads();
    for (int qt = 0; qt < 2; ++qt) {
        const size_t qrow = (size_t)b * T + qb * 256 + 32 * wave + 16 * qt;
        attn_tile16<128, 256, false>(cols + qrow * NC + C_XMQ + hm * 128, cols + qrow * NC + C_XMZ + hm * 128, Kl, VTl, 0, 7, 0.08838834764831845f, -1e30f, 0.f, 0, false, lane);
    }
    __syncthreads();
}

__global__ void __launch_bounds__(512) mega_fwd(Params p) {
    extern __shared__ __attribute__((aligned(16))) unsigned char lds_raw[];
    LAS unsigned char* lds = (LAS unsigned char*)lds_raw;
    cg::grid_group grid = cg::this_grid();
    const int G = gridDim.x, bx = blockIdx.x;
    const int vcu = (G % 8 == 0) ? (bx % 8) * (G / 8) + bx / 8 : bx;
    const Epi E{p.ws};
#pragma unroll 1
    for (int l = 0; l < 2; ++l) {
        p0_stage(p, l, lds);
        grid.sync();
        { SchedA S{p.ws, G, bx}; pg8::gemm_phase<Epi, SchedA>(lds, S, E); }
        grid.sync();
        for (int u = bx; u < 1024 + 512; u += G) { if (u < 1024) delta_pre_unit(p, l, u, lds); else gmlp_unit(p, l, u - 1024, lds); }
        grid.sync();
        if (G >= 64) {
            if (bx < 32) delta_scan_unit(p, l, bx, lds);
            else for (int u = bx - 32; u < 512; u += G - 32) { if (u < 256) swa_unit(p, l, u, lds); else xmem_unit(p, l, u - 256, lds); }
        } else {
            for (int u = bx; u < 32 + 512; u += G) { if (u < 32) delta_scan_unit(p, l, u, lds); else if (u < 288) swa_unit(p, l, u - 32, lds); else xmem_unit(p, l, u - 288, lds); }
        }
        grid.sync();
        { SchedD S{p.ws, G, vcu}; pg8::gemm_phase<Epi, SchedD>(lds, S, E); }
        grid.sync();
        { SchedE S{p.ws, G, vcu}; pg8::gemm_phase<Epi, SchedE>(lds, S, E); }
        grid.sync();
    }
    p0_stage(p, 2, lds);
}

extern "C" void kernel_launch(void* const* d_in, const int* in_sizes, int n_in, void* d_out, int out_size, void* d_ws, size_t ws_size, hipStream_t stream) {
    static int grid = 0;
    if (grid == 0) {
        if (n_in != 17 || out_size != M * D || ws_size < WS_END) { fprintf(stderr, "kernel_launch: unexpected shapes / workspace (%d inputs, out %d, ws %zu)\n", n_in, out_size, ws_size); grid = -1; return; }
        int dev = 0, cus = 0, per_cu = 0;
        hipGetDevice(&dev);
        hipDeviceGetAttribute(&cus, hipDeviceAttributeMultiprocessorCount, dev);
        hipFuncSetAttribute((const void*)mega_fwd, hipFuncAttributeMaxDynamicSharedMemorySize, LDS_BYTES);
        hipOccupancyMaxActiveBlocksPerMultiprocessor(&per_cu, (const void*)mega_fwd, 512, LDS_BYTES);
        if (per_cu < 1) { fprintf(stderr, "kernel_launch: occupancy query reports %d blocks per CU\n", per_cu); (void)hipGetLastError(); per_cu = 1; }
        grid = cus * 1;
    }
    if (grid < 0) return;
    Params p{};
    p.x = (const float*)d_in[0]; p.mem = (const float*)d_in[1]; p.norm_pre = (const float*)d_in[2]; p.norm_post = (const float*)d_in[3]; p.norm_mem = (const float*)d_in[4];
    p.w_in = (const float*)d_in[5]; p.conv_w = (const float*)d_in[6]; p.a_log = (const float*)d_in[7]; p.dt_bias = (const float*)d_in[8]; p.dn_norm = (const float*)d_in[9];
    p.gm_norm = (const float*)d_in[10]; p.spatial_w = (const float*)d_in[11]; p.spatial_b = (const float*)d_in[12]; p.sinks = (const float*)d_in[13];
    p.w_mem_kv = (const float*)d_in[14]; p.w_up = (const float*)d_in[15]; p.w_out = (const float*)d_in[16];
    p.out = (float*)d_out; p.ws = (unsigned char*)d_ws;
    void* args[] = {&p};
    hipError_t e = hipLaunchCooperativeKernel((const void*)mega_fwd, dim3(grid), dim3(512), args, LDS_BYTES, stream);
    if (e != hipSuccess) fprintf(stderr, "cooperative launch failed: %s (grid %d)\n", hipGetErrorString(e), grid);
}
```

```cpp
#include <hip/hip_runtime.h>
#include <hip/hip_cooperative_groups.h>
#include <cstdio>
#include <cstdint>
namespace cg = cooperative_groups;

#define LAS __attribute__((address_space(3)))
typedef unsigned short bf16_t;
typedef short bf16x8 __attribute__((ext_vector_type(8)));
typedef float f32x4 __attribute__((ext_vector_type(4)));
typedef unsigned u32x4 __attribute__((ext_vector_type(4)));
typedef unsigned u32x2 __attribute__((ext_vector_type(2)));

constexpr int NB = 8, T = 2048, M = NB * T, D = 1024, NC = 5888, DIN = 9992;
constexpr int C_DNQ = 0, C_DNK = 512, C_DNV = 1024, C_DNZ = 1536, C_GMU = 2048, C_GMV = 2560, C_GMZ = 3072, C_SWQ = 3584, C_SWK = 4096, C_SWV = 4224,
              C_SWZ = 4352, C_XMQ = 4864, C_XMZ = 5376;
constexpr float EPS = 1e-6f;
constexpr size_t MiB = 1u << 20;
constexpr size_t WS_WINT = 1 * MiB, WS_WGT = WS_WINT + 12058624, WS_WUPT = WS_WGT + 8 * MiB, WS_WOUTT = WS_WUPT + 4 * MiB, WS_WMKVT = WS_WOUTT + 2 * MiB,
                 WS_SPW = WS_WMKVT + 2 * MiB;
constexpr size_t WS_H = 29 * MiB, WS_COLS = 61 * MiB, WS_OUT = WS_COLS, WS_X = 245 * MiB;
constexpr size_t WS_WA_W = WS_X, WS_WA_A = WS_X + 16 * MiB, WS_HALO = WS_X + 24 * MiB, WS_SM = WS_X + 27 * MiB, WS_DL = WS_SM + 512 * 1024,
                 WS_MEMN = WS_X + 28 * MiB, WS_MEMKV = WS_X + 32 * MiB, WS_GSCR = WS_X, WS_MERGED = WS_X + 32 * MiB, WS_END = 309 * MiB;
constexpr int LDS_BYTES = 155648;

struct Params {
    const float *x, *mem, *norm_pre, *norm_post, *norm_mem, *w_in, *conv_w, *a_log, *dt_bias, *dn_norm, *gm_norm, *spatial_w, *spatial_b, *sinks, *w_mem_kv,
        *w_up, *w_out;
    float* out;
    unsigned char* ws;
};

__device__ __forceinline__ unsigned f2bf(float f) { unsigned u = __float_as_uint(f); return (u + 0x7fffu + ((u >> 16) & 1u)) >> 16; }
__device__ __forceinline__ float bf2f(unsigned b) { return __uint_as_float(b << 16); }
__device__ __forceinline__ unsigned cvt_pk_bf16(float lo, float hi) { unsigned r; asm volatile("v_cvt_pk_bf16_f32 %0, %1, %2" : "=v"(r) : "v"(lo), "v"(hi)); return r; }
__device__ __forceinline__ float lo_bf(unsigned w) { return __uint_as_float(w << 16); }
__device__ __forceinline__ float hi_bf(unsigned w) { return __uint_as_float(w & 0xffff0000u); }
__device__ __forceinline__ float wave_sum(float v) {
#pragma unroll
    for (int o = 1; o < 64; o <<= 1) v += __shfl_xor(v, o);
    return v;
}
__device__ __forceinline__ float silu_f(float y) { return y / (1.f + __expf(-y)); }
__device__ __forceinline__ float sigmoid_f(float y) { return 1.f / (1.f + __expf(-y)); }
__device__ __forceinline__ float gelu_tanh_f(float x) {
    const float u = 0.7978845608f * (x + 0.044715f * x * x * x);
    const float t = 1.f - 2.f / (__expf(2.f * u) + 1.f);
    return 0.5f * x * (1.f + t);
}
__device__ __forceinline__ bf16x8 pack8(const f32x4 a, const f32x4 b) {
    u32x4 w; w.x = cvt_pk_bf16(a[0], a[1]); w.y = cvt_pk_bf16(a[2], a[3]); w.z = cvt_pk_bf16(b[0], b[1]); w.w = cvt_pk_bf16(b[2], b[3]);
    return __builtin_bit_cast(bf16x8, w);
}
__device__ __forceinline__ bf16x8 lds_ld2x8(const LAS unsigned char* pl) {
    const u32x2 lo = *(const LAS u32x2*)pl, hi = *(const LAS u32x2*)(pl + 32);
    u32x4 w; w.x = lo.x; w.y = lo.y; w.z = hi.x; w.w = hi.y; return __builtin_bit_cast(bf16x8, w);
}
#define MFMA16(a, b, c) __builtin_amdgcn_mfma_f32_16x16x32_bf16((a), (b), (c), 0, 0, 0)

namespace pg8 {
constexpr int BM = 256, BK = 64, HALF = 128, HTB = HALF * BK * 2, STAGE_BYTES = 8 * HTB;
__device__ __forceinline__ int lds_byte(int r, int c) { const int st = (r >> 4) * 2 + (c >> 5), rr = r & 15, cc = c & 31, ob = rr * 64 + cc * 2; return st * 1024 + (ob ^ (((ob >> 9) & 1) << 5)); }
__device__ __forceinline__ void stage_rc(int b, int& R, int& C) { const int st = b / 1024, sb = b % 1024, swz = sb ^ (((sb >> 9) & 1) << 5); R = (st >> 1) * 16 + swz / 64; C = (st & 1) * 32 + (swz % 64) / 2; }
__device__ __forceinline__ int perm32(int rho) { const int n = rho >> 4, i = rho & 15; return 8 * (i >> 2) + 4 * n + (i & 3); }

struct Unit { const char* a; const char* b; unsigned lda, ldb; int nt; int pm, pn, kind, sub; };

__device__ __forceinline__ void mkoff(const Unit& u, int tid, unsigned (&vA)[2], unsigned (&vB)[2]) {
#pragma unroll
    for (int i = 0; i < 2; ++i) { int R, C; stage_rc(tid * 16 + i * 8192, R, C); const int Rb = (R & ~31) + perm32(R & 31);
        vA[i] = (unsigned)(R * u.lda + C) * 2u; vB[i] = (unsigned)(Rb * u.ldb + C) * 2u; }
}

template <class Epi, class Sched>
__device__ __forceinline__ void gemm_phase(LAS unsigned char* lds, const Sched& S, const Epi& E) {
    int tid_ = threadIdx.x; asm volatile("" : "+v"(tid_));
    const int tid = tid_, wid = __builtin_amdgcn_readfirstlane(tid >> 6), lane = tid & 63, wr = wid >> 2, wc = wid & 3, fr = lane & 15, fq = lane >> 4;
    const size_t kstep = (size_t)(BK * 2);
    const unsigned ldsw = (unsigned)wid * 1024u;
    const int aoff = lds_byte(wr * 64 + fr, fq * 8), boff = lds_byte(wc * 32 + fr, fq * 8);
#define PG8_SA(b, h) (((b) * 2 + (h)) * HTB)
#define PG8_SB(b, h) ((4 + (b) * 2 + (h)) * HTB)
#define PG8_STAGE(bufoff, gbase, voff) do { _Pragma("unroll") for (int _i = 0; _i < 2; ++_i) \
        __builtin_amdgcn_global_load_lds((const unsigned*)((const char*)(gbase) + (voff)[_i]), (LAS unsigned*)(lds + (bufoff) + ldsw + _i * 8192), 16, 0, 0); } while (0)
#define PG8_LDA(dst, b, h) do { _Pragma("unroll") for (int m = 0; m < 4; ++m) _Pragma("unroll") for (int k = 0; k < 2; ++k) dst[m][k] = *(const LAS bf16x8*)(lds + PG8_SA(b, h) + aoff + m * 2048 + k * 1024); } while (0)
#define PG8_LDB(dst, b, h) do { _Pragma("unroll") for (int n = 0; n < 2; ++n) _Pragma("unroll") for (int k = 0; k < 2; ++k) dst[n][k] = *(const LAS bf16x8*)(lds + PG8_SB(b, h) + boff + n * 2048 + k * 1024); } while (0)
#define PG8_MMA(ai, bj, At, Bt) do { __builtin_amdgcn_s_setprio(1); _Pragma("unroll") for (int m = 0; m < 4; ++m) _Pragma("unroll") for (int n = 0; n < 2; ++n) _Pragma("unroll") for (int k = 0; k < 2; ++k) \
        acc[ai][bj][m][n] = __builtin_amdgcn_mfma_f32_16x16x32_bf16(Bt[n][k], At[m][k], acc[ai][bj][m][n], 0, 0, 0); __builtin_amdgcn_s_setprio(0); } while (0)
#define PG8_WAIT_V(n) asm volatile("s_waitcnt vmcnt(" #n ")" ::: "memory")
#define PG8_WAIT_L(n) asm volatile("s_waitcnt lgkmcnt(" #n ")" ::: "memory")
#define PG8_BAR __builtin_amdgcn_s_barrier()
#define PG8_SCHED __builtin_amdgcn_sched_barrier(0)
    Unit cur, nxt; int ui = 0;
    if (!S.next(0, cur)) return;
    f32x4 acc[2][2][4][2];
#pragma unroll
    for (int a = 0; a < 2; ++a)
#pragma unroll
        for (int b = 0; b < 2; ++b)
#pragma unroll
            for (int m = 0; m < 4; ++m)
#pragma unroll
                for (int n = 0; n < 2; ++n) acc[a][b][m][n] = (f32x4){0.f, 0.f, 0.f, 0.f};
    bf16x8 At[4][2], B0[2][2], B1[2][2];
    unsigned vAc[2], vBc[2], vAn[2], vBn[2];
    mkoff(cur, tid, vAc, vBc);
    const char* cA = cur.a; const char* cB = cur.b;
    size_t hAc = (size_t)HALF * cur.lda * 2, hBc = (size_t)HALF * cur.ldb * 2;
    PG8_STAGE(PG8_SB(0, 0), cB, vBc); PG8_STAGE(PG8_SB(0, 1), cB + hBc, vBc); PG8_STAGE(PG8_SA(0, 0), cA, vAc); PG8_STAGE(PG8_SA(0, 1), cA + hAc, vAc);
    if (wr == 1) PG8_BAR;
    PG8_WAIT_V(2); PG8_BAR;
    PG8_STAGE(PG8_SB(1, 0), cB + kstep, vBc); PG8_STAGE(PG8_SA(1, 0), cA + kstep, vAc); PG8_STAGE(PG8_SB(1, 1), cB + hBc + kstep, vBc);
    PG8_WAIT_V(6); PG8_BAR;
    for (;;) {
        const bool has_next = S.next(ui + 1, nxt);
        const char* nA = cA; const char* nB = cB; size_t hAn = hAc, hBn = hBc;
        vAn[0] = vAc[0]; vAn[1] = vAc[1]; vBn[0] = vBc[0]; vBn[1] = vBc[1];
        if (has_next) { nA = nxt.a; nB = nxt.b; mkoff(nxt, tid, vAn, vBn); hAn = (size_t)HALF * nxt.lda * 2; hBn = (size_t)HALF * nxt.ldb * 2; }
        const int nt = cur.nt;
        for (int t = 0; t < nt; t += 2) {
            const bool last = (t == nt - 2);
            const char* a1 = cA + (size_t)(t + 1) * kstep;
            const char* a2 = last ? nA : cA + (size_t)(t + 2) * kstep; const char* b2 = last ? nB : cB + (size_t)(t + 2) * kstep;
            const char* a3 = a2 + kstep; const char* b3 = b2 + kstep;
            unsigned vA2[2], vB2[2];
            vA2[0] = last ? vAn[0] : vAc[0]; vA2[1] = last ? vAn[1] : vAc[1]; vB2[0] = last ? vBn[0] : vBc[0]; vB2[1] = last ? vBn[1] : vBc[1];
            const size_t hA2 = last ? hAn : hAc, hB2 = last ? hBn : hBc;
            PG8_LDB(B0, 0, 0); PG8_LDB(B1, 0, 1); PG8_SCHED; PG8_LDA(At, 0, 0); PG8_STAGE(PG8_SA(1, 1), a1 + hAc, vAc);
            PG8_WAIT_V(8); PG8_WAIT_L(0); PG8_BAR; PG8_MMA(0, 0, At, B0); PG8_MMA(0, 1, At, B1); PG8_BAR; PG8_SCHED;
            PG8_LDA(At, 0, 1); PG8_STAGE(PG8_SB(0, 0), b2, vB2); PG8_STAGE(PG8_SB(0, 1), b2 + hB2, vB2); PG8_STAGE(PG8_SA(0, 0), a2, vA2);
            PG8_WAIT_V(8); PG8_WAIT_L(0); PG8_BAR; PG8_MMA(1, 0, At, B0); PG8_MMA(1, 1, At, B1); PG8_BAR; PG8_SCHED;
            PG8_LDB(B0, 1, 0); PG8_LDB(B1, 1, 1); PG8_SCHED; PG8_LDA(At, 1, 0); PG8_STAGE(PG8_SA(0, 1), a2 + hA2, vA2);
            PG8_WAIT_V(8); PG8_WAIT_L(0); PG8_BAR; PG8_MMA(0, 0, At, B0); PG8_MMA(0, 1, At, B1); PG8_BAR; PG8_SCHED;
            PG8_LDA(At, 1, 1); PG8_STAGE(PG8_SB(1, 0), b3, vB2); PG8_STAGE(PG8_SB(1, 1), b3 + hB2, vB2); PG8_STAGE(PG8_SA(1, 0), a3, vA2);
            PG8_WAIT_V(8); PG8_WAIT_L(0); PG8_BAR; PG8_MMA(1, 0, At, B0); PG8_MMA(1, 1, At, B1); PG8_BAR; PG8_SCHED;
        }
        if (wr == 0) PG8_BAR;
        E(acc, cur, wr, wc, fr, fq, tid);
        if (!has_next) break;
#pragma unroll
        for (int a = 0; a < 2; ++a)
#pragma unroll
            for (int b = 0; b < 2; ++b)
#pragma unroll
                for (int m = 0; m < 4; ++m)
#pragma unroll
                    for (int n = 0; n < 2; ++n) acc[a][b][m][n] = (f32x4){0.f, 0.f, 0.f, 0.f};
        cur = nxt; cA = nA; cB = nB; hAc = hAn; hBc = hBn; vAc[0] = vAn[0]; vAc[1] = vAn[1]; vBc[0] = vBn[0]; vBc[1] = vBn[1]; ++ui;
        if (wr == 1) PG8_BAR;
    }
    PG8_WAIT_V(0);
    PG8_BAR;
#undef PG8_SA
#undef PG8_SB
#undef PG8_STAGE
#undef PG8_LDA
#undef PG8_LDB
#undef PG8_MMA
#undef PG8_WAIT_V
#undef PG8_WAIT_L
#undef PG8_BAR
#undef PG8_SCHED
}
}
using pg8::Unit;

struct Epi {
    unsigned char* ws;
    __device__ __forceinline__ void operator()(const f32x4 (&acc)[2][2][4][2], const Unit& u, int wr, int wc, int fr, int fq, int tid) const {
        asm volatile("" : "+v"(tid), "+v"(fr), "+v"(fq));
        const int row0 = u.pm * 256 + wr * 64 + fr, col0 = u.pn * 256 + wc * 32 + 8 * fq;
        if (u.kind == 0) {
            bf16_t* cols = (bf16_t*)(ws + WS_COLS); bf16_t* halo = (bf16_t*)(ws + WS_HALO);
            const int pn = u.pn;
            const int act = (pn == 6 || pn == 7 || pn == 12 || pn == 13 || pn == 17 || pn == 18 || pn >= 21) ? 1 : ((pn >= 8 && pn <= 11) ? 2 : 0);
#pragma unroll
            for (int ai = 0; ai < 2; ++ai)
#pragma unroll
                for (int m = 0; m < 4; ++m) {
                    const int r = row0 + ai * 128 + m * 16;
                    bf16_t* rowp = cols + (size_t)r * NC + col0;
#pragma unroll
                    for (int bj = 0; bj < 2; ++bj) {
                        f32x4 v0 = acc[ai][bj][m][0], v1 = acc[ai][bj][m][1];
                        if (act == 1) {
#pragma unroll
                            for (int e = 0; e < 4; ++e) { v0[e] = silu_f(v0[e]); v1[e] = silu_f(v1[e]); }
                        } else if (act == 2) {
#pragma unroll
                            for (int e = 0; e < 4; ++e) { v0[e] = gelu_tanh_f(v0[e]); v1[e] = gelu_tanh_f(v1[e]); }
                        }
                        u32x4 w; w.x = cvt_pk_bf16(v0[0], v0[1]); w.y = cvt_pk_bf16(v0[2], v0[3]); w.z = cvt_pk_bf16(v1[0], v1[1]); w.w = cvt_pk_bf16(v1[2], v1[3]);
                        *(u32x4*)(rowp + bj * 128) = w;
                        if (pn < 6 && (r & 63) >= 61) *(u32x4*)(halo + ((size_t)(r >> 6) * 3 + ((r & 63) - 61)) * 1536 + col0 + bj * 128) = w;
                    }
                }
        } else if (u.kind == 1) {
            bf16_t* o = (bf16_t*)(ws + WS_MEMKV);
#pragma unroll
            for (int ai = 0; ai < 2; ++ai)
#pragma unroll
                for (int m = 0; m < 4; ++m) {
                    bf16_t* rowp = o + (size_t)(row0 + ai * 128 + m * 16) * 1024 + col0;
#pragma unroll
                    for (int bj = 0; bj < 2; ++bj) {
                        const f32x4 v0 = acc[ai][bj][m][0], v1 = acc[ai][bj][m][1];
                        u32x4 w; w.x = cvt_pk_bf16(v0[0], v0[1]); w.y = cvt_pk_bf16(v0[2], v0[3]); w.z = cvt_pk_bf16(v1[0], v1[1]); w.w = cvt_pk_bf16(v1[2], v1[3]);
                        *(u32x4*)(rowp + bj * 128) = w;
                    }
                }
        } else if (u.kind == 2) {
            u32x4* g = (u32x4*)(ws + WS_GSCR) + (size_t)(u.pm * 4 + u.pn) * 16 * 512 + tid;
#pragma unroll
            for (int ai = 0; ai < 2; ++ai)
#pragma unroll
                for (int m = 0; m < 4; ++m)
#pragma unroll
                    for (int bj = 0; bj < 2; ++bj) {
                        const f32x4 v0 = acc[ai][bj][m][0], v1 = acc[ai][bj][m][1];
                        u32x4 w; w.x = cvt_pk_bf16(sigmoid_f(v0[0]), sigmoid_f(v0[1])); w.y = cvt_pk_bf16(sigmoid_f(v0[2]), sigmoid_f(v0[3]));
                        w.z = cvt_pk_bf16(sigmoid_f(v1[0]), sigmoid_f(v1[1])); w.w = cvt_pk_bf16(sigmoid_f(v1[2]), sigmoid_f(v1[3]));
                        g[(size_t)((ai * 4 + m) * 2 + bj) * 512] = w;
                    }
        } else if (u.kind == 3) {
            const u32x4* g = (const u32x4*)(ws + WS_GSCR) + (size_t)(u.pm * 4 + u.pn) * 16 * 512 + tid;
            bf16_t* mg = (bf16_t*)(ws + WS_MERGED);
#pragma unroll
            for (int ai = 0; ai < 2; ++ai)
#pragma unroll
                for (int m = 0; m < 4; ++m) {
                    bf16_t* rowp = mg + (size_t)(row0 + ai * 128 + m * 16) * 1024 + col0;
#pragma unroll
                    for (int bj = 0; bj < 2; ++bj) {
                        const f32x4 v0 = acc[ai][bj][m][0], v1 = acc[ai][bj][m][1];
                        const u32x4 gw = g[(size_t)((ai * 4 + m) * 2 + bj) * 512];
                        float r0 = lo_bf(gw.x) * v0[0], r1 = hi_bf(gw.x) * v0[1], r2 = lo_bf(gw.y) * v0[2], r3 = hi_bf(gw.y) * v0[3];
                        float r4 = lo_bf(gw.z) * v1[0], r5 = hi_bf(gw.z) * v1[1], r6 = lo_bf(gw.w) * v1[2], r7 = hi_bf(gw.w) * v1[3];
                        if (u.sub > 0) { const u32x4 pw = *(const u32x4*)(rowp + bj * 128);
                            r0 += lo_bf(pw.x); r1 += hi_bf(pw.x); r2 += lo_bf(pw.y); r3 += hi_bf(pw.y); r4 += lo_bf(pw.z); r5 += hi_bf(pw.z); r6 += lo_bf(pw.w); r7 += hi_bf(pw.w); }
                        u32x4 w; w.x = cvt_pk_bf16(r0, r1); w.y = cvt_pk_bf16(r2, r3); w.z = cvt_pk_bf16(r4, r5); w.w = cvt_pk_bf16(r6, r7);
                        *(u32x4*)(rowp + bj * 128) = w;
                        asm volatile("" ::: "memory");
                    }
                }
        } else {
            float* o = (float*)(ws + WS_OUT);
#pragma unroll
            for (int ai = 0; ai < 2; ++ai)
#pragma unroll
                for (int m = 0; m < 4; ++m) {
                    float* rowp = o + (size_t)(row0 + ai * 128 + m * 16) * 1024 + col0;
#pragma unroll
                    for (int bj = 0; bj < 2; ++bj) { *(f32x4*)(rowp + bj * 128) = acc[ai][bj][m][0]; *(f32x4*)(rowp + bj * 128 + 4) = acc[ai][bj][m][1]; }
                }
        }
    }
};

struct SchedA {
    const unsigned char* ws; int G, c;
    __device__ __forceinline__ bool next(int i, Unit& u) const {
        const int L = i * G + c;
        constexpr int nN = 23, nwg = 64 * nN;
        if (L < nwg) {
            int wgid = L; { const int q = nwg / 8, xcd = wgid % 8, off = wgid / 8; wgid = xcd * q + off; }
            const int nig = 8 * nN, gid = wgid / nig, fm = gid * 8;
            u.pm = fm + ((wgid % nig) % 8); u.pn = (wgid % nig) / 8; u.kind = 0; u.sub = 0; u.lda = 1024; u.ldb = 1024; u.nt = 16;
            u.a = (const char*)(ws + WS_H) + (size_t)u.pm * 256 * 1024 * 2; u.b = (const char*)(ws + WS_WINT) + (size_t)u.pn * 256 * 1024 * 2;
            return true;
        }
        const int r = L - nwg; if (r >= 32) return false;
        u.pm = r >> 2; u.pn = r & 3; u.kind = 1; u.sub = 0; u.lda = 1024; u.ldb = 1024; u.nt = 16;
        u.a = (const char*)(ws + WS_MEMN) + (size_t)u.pm * 256 * 1024 * 2; u.b = (const char*)(ws + WS_WMKVT) + (size_t)u.pn * 256 * 1024 * 2;
        return true;
    }
};
struct SchedD {
    const unsigned char* ws; int G, vcu;
    __device__ __forceinline__ bool next(int i, Unit& u) const {
        const int tile = vcu + (i >> 3) * G; if (tile >= 256) return false;
        const int sub = i & 7, n = sub >> 1;
        u.pm = tile >> 2; u.pn = tile & 3; u.sub = n;
        if ((sub & 1) == 0) { u.kind = 2; u.lda = 1024; u.ldb = 1024; u.nt = 16;
            u.a = (const char*)(ws + WS_H) + (size_t)u.pm * 256 * 1024 * 2; u.b = (const char*)(ws + WS_WGT) + (size_t)(n * 1024 + u.pn * 256) * 1024 * 2;
        } else { u.kind = 3; u.lda = NC; u.ldb = 512; u.nt = 8;
            const int yoff = n == 0 ? C_DNZ : (n == 1 ? C_GMU : (n == 2 ? C_SWQ : C_XMQ));
            u.a = (const char*)(ws + WS_COLS) + ((size_t)u.pm * 256 * NC + yoff) * 2; u.b = (const char*)(ws + WS_WUPT) + (size_t)(n * 1024 + u.pn * 256) * 512 * 2; }
        return true;
    }
};
struct SchedE {
    const unsigned char* ws; int G, vcu;
    __device__ __forceinline__ bool next(int i, Unit& u) const {
        const int tile = vcu + i * G; if (tile >= 256) return false;
        u.pm = tile >> 2; u.pn = tile & 3; u.kind = 4; u.sub = 0; u.lda = 1024; u.ldb = 1024; u.nt = 16;
        u.a = (const char*)(ws + WS_MERGED) + (size_t)u.pm * 256 * 1024 * 2; u.b = (const char*)(ws + WS_WOUTT) + (size_t)u.pn * 256 * 1024 * 2;
        return true;
    }
};

__device__ __forceinline__ void tr_item(const float* W, int ldw, int k0, bf16_t* WT, int Kdst, LAS float* scr, int lane) {
    float tv[32];
#pragma unroll
    for (int i = 0; i < 32; ++i) tv[i] = W[(size_t)(k0 + 2 * i + (lane >> 5)) * ldw + (lane & 31)];
#pragma unroll
    for (int i = 0; i < 32; ++i) scr[(2 * i + (lane >> 5)) * 33 + (lane & 31)] = tv[i];
    asm volatile("s_waitcnt lgkmcnt(0)" ::: "memory");
    const int c = lane & 7;
#pragma unroll
    for (int j = 0; j < 4; ++j) { const int n = (lane >> 3) + 8 * j; const LAS float* s = scr + (8 * c) * 33 + n;
        u32x4 o; o.x = cvt_pk_bf16(s[0 * 33], s[1 * 33]); o.y = cvt_pk_bf16(s[2 * 33], s[3 * 33]); o.z = cvt_pk_bf16(s[4 * 33], s[5 * 33]); o.w = cvt_pk_bf16(s[6 * 33], s[7 * 33]);
        *(u32x4*)(WT + (size_t)n * Kdst + k0 + 8 * c) = o; }
    asm volatile("s_waitcnt lgkmcnt(0)" ::: "memory");
}

__device__ __forceinline__ void p0_stage(const Params& p, int rk, LAS unsigned char* lds) {
    int tid_ = threadIdx.x; asm volatile("" : "+v"(tid_));
    const int tid = tid_, lane = tid & 63, wave = tid >> 6;
    const int gw = blockIdx.x * 8 + wave, NGW = gridDim.x * 8;
    unsigned char* ws = p.ws;
    LAS float* W8T = (LAS float*)(lds + 8 * 8448);
    if (rk <= 1) {
        const int l = rk;
        const float* win = p.w_in + (size_t)l * 1024 * DIN;
        {   f32x4 wv[4];
#pragma unroll
            for (int t2 = 0; t2 < 2; ++t2) { const float* wp = win + (size_t)(tid + 512 * t2) * DIN + 2048; wv[2 * t2] = *(const f32x4*)wp; wv[2 * t2 + 1] = *(const f32x4*)(wp + 4); }
#pragma unroll
            for (int t2 = 0; t2 < 2; ++t2)
#pragma unroll
                for (int j = 0; j < 8; ++j) W8T[j * 1024 + tid + 512 * t2] = wv[2 * t2 + (j >> 2)][j & 3]; }
        LAS float* scr = (LAS float*)(lds + wave * 8448);
        for (int it = gw; it < 7040; it += NGW) {
            if (it < 2944) { const int kb = it / 184, nb = it % 184, n0 = 32 * nb, sc = n0 < 2048 ? n0 : n0 + 8;
                tr_item(win + sc, DIN, 64 * kb, (bf16_t*)(ws + WS_WINT) + (size_t)n0 * 1024, 1024, scr, lane);
            } else if (it < 4992) { const int r = it - 2944, kb = r / 128, nb = r % 128;
                tr_item(win + 5896 + 32 * nb, DIN, 64 * kb, (bf16_t*)(ws + WS_WGT) + (size_t)(32 * nb) * 1024, 1024, scr, lane);
            } else if (it < 6016) { const int r = it - 4992, n = r / 256, r2 = r % 256, kb = r2 / 32, nb = r2 % 32;
                tr_item(p.w_up + (size_t)(l * 4 + n) * 512 * 1024 + 32 * nb, 1024, 64 * kb, (bf16_t*)(ws + WS_WUPT) + (size_t)(n * 1024 + 32 * nb) * 512, 512, scr, lane);
            } else if (it < 6528) { const int r = it - 6016, kb = r / 32, nb = r % 32;
                tr_item(p.w_out + (size_t)l * 1024 * 1024 + 32 * nb, 1024, 64 * kb, (bf16_t*)(ws + WS_WOUTT) + (size_t)(32 * nb) * 1024, 1024, scr, lane);
            } else { const int r = it - 6528, kb = r / 32, nb = r % 32;
                tr_item(p.w_mem_kv + (size_t)l * 1024 * 1024 + 32 * nb, 1024, 64 * kb, (bf16_t*)(ws + WS_WMKVT) + (size_t)(32 * nb) * 1024, 1024, scr, lane);
            }
        }
        for (int e = blockIdx.x * 512 + tid; e < 65536; e += gridDim.x * 512) { const int pp = (e >> 7) & 127, qq = e & 127;
            ((bf16_t*)(ws + WS_SPW))[e] = (bf16_t)(qq <= pp ? f2bf(p.spatial_w[(size_t)l * 65536 + e]) : 0u); }
        for (int r = gw; r < 2048; r += NGW) {
            const f32x4* xr = (const f32x4*)(p.mem + (size_t)r * D) + lane; const f32x4* gr = (const f32x4*)(p.norm_mem + l * D) + lane;
            f32x4 v[4]; float ss = 0.f;
#pragma unroll
            for (int j = 0; j < 4; ++j) { v[j] = xr[64 * j]; ss += v[j][0] * v[j][0] + v[j][1] * v[j][1] + v[j][2] * v[j][2] + v[j][3] * v[j][3]; }
            const float rstd = rsqrtf(wave_sum(ss) * (1.f / D) + EPS);
            u32x2* o = (u32x2*)((bf16_t*)(ws + WS_MEMN) + (size_t)r * D) + lane;
#pragma unroll
            for (int j = 0; j < 4; ++j) { const f32x4 g = gr[64 * j]; u32x2 w; w.x = cvt_pk_bf16(v[j][0] * rstd * g[0], v[j][1] * rstd * g[1]); w.y = cvt_pk_bf16(v[j][2] * rstd * g[2], v[j][3] * rstd * g[3]); o[64 * j] = w; }
        }
    }
    __syncthreads();
    const float* xin = rk == 2 ? p.out : p.x;
    for (int row = gw; row < M; row += NGW) {
        const f32x4* xr = (const f32x4*)(xin + (size_t)row * D) + lane;
        f32x4 v[4];
#pragma unroll
        for (int j = 0; j < 4; ++j) v[j] = xr[64 * j];
        if (rk >= 1) {
            const f32x4* orow = (const f32x4*)((const float*)(ws + WS_OUT) + (size_t)row * D) + lane; const f32x4* gr = (const f32x4*)(p.norm_post + (rk - 1) * D) + lane;
            f32x4 o[4]; float ss = 0.f;
#pragma unroll
            for (int j = 0; j < 4; ++j) { o[j] = orow[64 * j]; ss += o[j][0] * o[j][0] + o[j][1] * o[j][1] + o[j][2] * o[j][2] + o[j][3] * o[j][3]; }
            const float rstd = rsqrtf(wave_sum(ss) * (1.f / D) + EPS);
            f32x4* dst = (f32x4*)(p.out + (size_t)row * D) + lane;
#pragma unroll
            for (int j = 0; j < 4; ++j) { const f32x4 g = gr[64 * j]; v[j] = v[j] + o[j] * rstd * g; dst[64 * j] = v[j]; }
        }
        if (rk <= 1) {
            const f32x4* gr = (const f32x4*)(p.norm_pre + rk * D) + lane;
            float ss = 0.f;
#pragma unroll
            for (int j = 0; j < 4; ++j) ss += v[j][0] * v[j][0] + v[j][1] * v[j][1] + v[j][2] * v[j][2] + v[j][3] * v[j][3];
            const float rstd = rsqrtf(wave_sum(ss) * (1.f / D) + EPS);
            u32x2* o = (u32x2*)((bf16_t*)(ws + WS_H) + (size_t)row * D) + lane;
#pragma unroll
            for (int j = 0; j < 4; ++j) { const f32x4 g = gr[64 * j]; v[j] = v[j] * rstd * g; u32x2 w; w.x = cvt_pk_bf16(v[j][0], v[j][1]); w.y = cvt_pk_bf16(v[j][2], v[j][3]); o[64 * j] = w; }
            float* sm = (float*)(ws + WS_SM) + (size_t)row * 8;
            LAS float* red = (LAS float*)(lds + 8 * 8448 + 32768) + wave * 512;
#pragma unroll
            for (int jj = 0; jj < 8; ++jj) { float a = 0.f;
#pragma unroll
                for (int j = 0; j < 4; ++j) { const f32x4 w = *(const LAS f32x4*)(W8T + jj * 1024 + 256 * j + 4 * lane); a += v[j][0] * w[0] + v[j][1] * w[1] + v[j][2] * w[2] + v[j][3] * w[3]; }
                red[jj * 64 + lane] = a; }
            asm volatile("s_waitcnt lgkmcnt(0)" ::: "memory");
            { const f32x4 r0 = *(const LAS f32x4*)(red + lane * 8), r1 = *(const LAS f32x4*)(red + lane * 8 + 4);
              float a = (r0[0] + r0[1]) + (r0[2] + r0[3]) + (r1[0] + r1[1]) + (r1[2] + r1[3]);
              a += __shfl_xor(a, 1); a += __shfl_xor(a, 2); a += __shfl_xor(a, 4);
              if ((lane & 7) == 0) sm[lane >> 3] = a; }
            asm volatile("s_waitcnt lgkmcnt(0)" ::: "memory");
        }
    }
    __syncthreads();
}

__device__ __forceinline__ void delta_pre_unit(const Params& p, int l, int unit, LAS unsigned char* lds) {
    int tid_ = threadIdx.x; asm volatile("" : "+v"(tid_));
    const int tid = tid_, lane = tid & 63, wave = tid >> 6;
    const int h = unit & 3, gch = unit >> 2, c = gch & 31;
    const size_t row0 = (size_t)gch * 64;
    unsigned char* ws = p.ws;
    bf16_t* cols = (bf16_t*)(ws + WS_COLS);
    LAS float* Qf = (LAS float*)lds; LAS float* Kf = Qf + 64 * 129; LAS float* Vf = Kf + 64 * 129; LAS float* Lf = Vf + 64 * 129;
    LAS bf16_t* Qb = (LAS bf16_t*)(Lf + 64 * 68); LAS bf16_t* Kb = Qb + 64 * 136;
    LAS float* gcs = (LAS float*)(Kb + 64 * 136); LAS float* betas = gcs + 64; LAS float* facs = betas + 64;
    LAS bf16_t* Rw = (LAS bf16_t*)Lf;
    {
#pragma unroll
        for (int it = 0; it < 6; ++it) { const int pc = tid + 512 * it, r = pc / 48, rem = pc % 48, part = rem >> 4, cp = rem & 15;
            const u32x4 v = *(const u32x4*)(cols + (row0 + r) * NC + part * 512 + h * 128 + cp * 8);
            *(LAS u32x4*)(Rw + (r + 3) * 384 + part * 128 + cp * 8) = v; }
        if (tid < 144) { const int r = tid / 48, rem = tid % 48, part = rem >> 4, cp = rem & 15;
            u32x4 v = {0u, 0u, 0u, 0u};
            if (c > 0) v = *(const u32x4*)((const bf16_t*)(ws + WS_HALO) + ((size_t)(gch - 1) * 3 + r) * 1536 + part * 512 + h * 128 + cp * 8);
            *(LAS u32x4*)(Rw + r * 384 + part * 128 + cp * 8) = v; }
        if (wave == 6) {
            const float* sm = (const float*)(ws + WS_SM) + (row0 + lane) * 8;
            const float a = sm[4 + h] + p.dt_bias[l * 4 + h];
            const float sp = a > 20.f ? a : log1pf(__expf(a));
            float g = -__expf(p.a_log[l * 4 + h]) * sp;
#pragma unroll
            for (int o = 1; o < 64; o <<= 1) { const float t = __shfl_up(g, o); if (lane >= o) g += t; }
            gcs[lane] = g;
        } else if (wave == 7) {
            const float* sm = (const float*)(ws + WS_SM) + (row0 + lane) * 8;
            betas[lane] = sigmoid_f(sm[h]);
        }
    }
    __syncthreads();
    if (tid < 384) {
        const int part = tid >> 7, cc = tid & 127, col = part * 512 + h * 128 + cc;
        const float* cw = p.conv_w + (size_t)l * 4 * 1536 + col;
        const float w0 = cw[0], w1 = cw[1536], w2 = cw[2 * 1536], w3 = cw[3 * 1536];
        const LAS bf16_t* src = Rw + tid;
        float x3 = bf2f(src[0]), x2 = bf2f(src[384]), x1 = bf2f(src[2 * 384]);
        LAS float* dst = (part == 0 ? Qf : (part == 1 ? Kf : Vf)) + cc;
#pragma unroll 8
        for (int r = 0; r < 64; ++r) { const float x0 = bf2f(src[(r + 3) * 384]); const float y = w0 * x3 + w1 * x2 + w2 * x1 + w3 * x0; dst[r * 129] = silu_f(y); x3 = x2; x2 = x1; x1 = x0; }
    }
    __syncthreads();
    if (tid < 64) { facs[tid] = betas[tid]; facs[64 + tid] = betas[tid] * __expf(gcs[tid]); }
    {
        const int r = tid >> 3, sub = tid & 7; float sq = 0.f, sk = 0.f;
#pragma unroll
        for (int e = 0; e < 16; ++e) { const float a = Qf[r * 129 + sub * 16 + e]; sq += a * a; const float b = Kf[r * 129 + sub * 16 + e]; sk += b * b; }
        sq += __shfl_xor(sq, 1); sq += __shfl_xor(sq, 2); sq += __shfl_xor(sq, 4);
        sk += __shfl_xor(sk, 1); sk += __shfl_xor(sk, 2); sk += __shfl_xor(sk, 4);
        const float rq = rsqrtf(sq + EPS) * 0.08838834764831845f, rkk = rsqrtf(sk + EPS);
#pragma unroll
        for (int e = 0; e < 16; ++e) { const int o = sub * 16 + e; const float a = Qf[r * 129 + o] * rq; Qb[r * 136 + o] = (bf16_t)f2bf(a);
            const float b = Kf[r * 129 + o] * rkk; Kf[r * 129 + o] = b; Kb[r * 136 + o] = (bf16_t)f2bf(b); }
    }
    __syncthreads();
    LAS bf16_t* Al = (LAS bf16_t*)Qf;
    LAS bf16_t* Wl = Al + 64 * 72;
    {
        const int i = lane & 15, q = lane >> 4;
        for (int job = wave; job < 26; job += 8) {
            int kind, ct, st;
            if (job < 10) { kind = 0; ct = job >= 6 ? 3 : (job >= 3 ? 2 : (job >= 1 ? 1 : 0)); st = job - ct * (ct + 1) / 2; }
            else { kind = 1; ct = (job - 10) >> 2; st = (job - 10) & 3; }
            f32x4 acc = {0.f, 0.f, 0.f, 0.f};
            if (st <= ct) {
                const LAS bf16_t* Ab = kind == 0 ? Kb : Qb;
#pragma unroll
                for (int ks = 0; ks < 4; ++ks) { const bf16x8 a = *(const LAS bf16x8*)(Ab + (16 * ct + i) * 136 + 32 * ks + 8 * q); const bf16x8 b = *(const LAS bf16x8*)(Kb + (16 * st + i) * 136 + 32 * ks + 8 * q);
                    acc = MFMA16(a, b, acc); }
            }
            const int s = 16 * st + i; const float gs = gcs[s];
#pragma unroll
            for (int r = 0; r < 4; ++r) { const int cr = 16 * ct + 4 * q + r; const float e = __expf(fminf(gcs[cr] - gs, 0.f));
                if (kind == 0) Lf[cr * 68 + s] = (cr > s) ? acc[r] * betas[cr] * e : 0.f;
                else Al[cr * 72 + s] = (bf16_t)f2bf(cr >= s ? acc[r] * e : 0.f); }
        }
    }
    __syncthreads();
    if (tid < 256) {
        const int j = tid; const bool isv = j < 128; const int jj = j & 127;
        const LAS float* src = (isv ? Vf : Kf) + jj;
        const LAS float* fac = facs + (isv ? 0 : 64);
        float x[64];
#pragma unroll
        for (int i = 0; i < 64; ++i) {
            const int Lrow = __float_as_int(Lf[i * 68 + lane]);
            float s = src[i * 129] * fac[i];
#pragma unroll
            for (int jx = 0; jx < i; ++jx) s -= __int_as_float(__builtin_amdgcn_readlane(Lrow, jx)) * x[jx];
            x[i] = s;
        }
        if (isv) { bf16_t* dst = cols + (row0 + (jj >> 1)) * NC + C_DNV + h * 128 + (jj & 1) * 64;
#pragma unroll
            for (int g8 = 0; g8 < 8; ++g8) { u32x4 w; w.x = cvt_pk_bf16(x[8 * g8], x[8 * g8 + 1]); w.y = cvt_pk_bf16(x[8 * g8 + 2], x[8 * g8 + 3]); w.z = cvt_pk_bf16(x[8 * g8 + 4], x[8 * g8 + 5]); w.w = cvt_pk_bf16(x[8 * g8 + 6], x[8 * g8 + 7]);
                *(u32x4*)(dst + 8 * g8) = w; }
        } else {
#pragma unroll
            for (int i = 0; i < 64; ++i) Wl[i * 136 + jj] = (bf16_t)f2bf(x[i]); }
    } else {
        const int t2 = tid - 256;
        { const int cr = t2 >> 2, d0 = (t2 & 3) * 32; const float e = __expf(gcs[cr]);
            bf16_t* dst = cols + (row0 + cr) * NC + C_DNQ + h * 128 + d0;
#pragma unroll
            for (int g4 = 0; g4 < 4; ++g4) { const u32x4 v = *(const LAS u32x4*)(Qb + cr * 136 + d0 + 8 * g4); u32x4 w;
                w.x = cvt_pk_bf16(lo_bf(v.x) * e, hi_bf(v.x) * e); w.y = cvt_pk_bf16(lo_bf(v.y) * e, hi_bf(v.y) * e); w.z = cvt_pk_bf16(lo_bf(v.z) * e, hi_bf(v.z) * e); w.w = cvt_pk_bf16(lo_bf(v.w) * e, hi_bf(v.w) * e);
                *(u32x4*)(dst + 8 * g4) = w; } }
        { const int dk = t2 & 127, c0 = (t2 >> 7) * 32; const float gl = gcs[63];
            bf16_t* dst = cols + (row0 + (dk >> 1)) * NC + C_DNK + h * 128 + (dk & 1) * 64 + c0;
#pragma unroll
            for (int g4 = 0; g4 < 4; ++g4) { float v[8];
#pragma unroll
                for (int e = 0; e < 8; ++e) { const int cr = c0 + 8 * g4 + e; v[e] = Kf[cr * 129 + dk] * __expf(gl - gcs[cr]); }
                u32x4 w; w.x = cvt_pk_bf16(v[0], v[1]); w.y = cvt_pk_bf16(v[2], v[3]); w.z = cvt_pk_bf16(v[4], v[5]); w.w = cvt_pk_bf16(v[6], v[7]);
                *(u32x4*)(dst + 8 * g4) = w; } }
        if (t2 == 0) ((float*)(ws + WS_DL))[unit] = __expf(gcs[63]);
    }
    __syncthreads();
    {
        unsigned char* wo = ws + WS_WA_W + (size_t)unit * 16384; unsigned char* ao = ws + WS_WA_A + (size_t)unit * 8192;
#pragma unroll
        for (int it = 0; it < 2; ++it) { const int pc = tid + 512 * it; *(u32x4*)(wo + pc * 16) = *(const LAS u32x4*)(Wl + (pc >> 4) * 136 + (pc & 15) * 8); }
        *(u32x4*)(ao + tid * 16) = *(const LAS u32x4*)(Al + (tid >> 3) * 72 + (tid & 7) * 8);
    }
    __syncthreads();
}

__device__ __forceinline__ void delta_scan_unit(const Params& p, int l, int bh, LAS unsigned char* lds) {
    int tid_ = threadIdx.x; asm volatile("" : "+v"(tid_));
    const int tid = tid_, lane = tid & 63, wave = tid >> 6, i = lane & 15, q = lane >> 4, dv0 = 16 * wave;
    const int b = bh >> 2, h = bh & 3;
    unsigned char* ws = p.ws;
    unsigned char* colsb = ws + WS_COLS;
    constexpr int BUFB = 62464, O_W = 0, O_QG = 17408, O_KD = 34816, O_A = 53248;
    LAS bf16_t* Ot = (LAS bf16_t*)(lds + 2 * BUFB);
    const int fr_ = tid >> 3, fs_ = tid & 7;
    float gn[16];
#pragma unroll
    for (int e = 0; e < 16; ++e) gn[e] = p.dn_norm[l * 128 + fs_ * 16 + e];
    const int pw0 = tid, pw1 = tid + 512;
    u32x4 pre[9]; u32x2 un_[4]; float dln;
#define SCAN_LOAD(cidx) do { const int gch_ = b * 32 + (cidx); const size_t r0_ = (size_t)gch_ * 64; const int un2_ = gch_ * 4 + h; \
        const unsigned char* wsrc_ = ws + WS_WA_W + (size_t)un2_ * 16384; const unsigned char* asrc_ = ws + WS_WA_A + (size_t)un2_ * 8192; \
        pre[0] = *(const u32x4*)(wsrc_ + pw0 * 16); pre[1] = *(const u32x4*)(wsrc_ + pw1 * 16); \
        pre[2] = *(const u32x4*)(colsb + ((r0_ + (pw0 >> 4)) * NC + C_DNQ + h * 128) * 2 + (pw0 & 15) * 16); pre[3] = *(const u32x4*)(colsb + ((r0_ + (pw1 >> 4)) * NC + C_DNQ + h * 128) * 2 + (pw1 & 15) * 16); \
        pre[4] = *(const u32x4*)(colsb + ((r0_ + (pw0 >> 4)) * NC + C_DNK + h * 128) * 2 + (pw0 & 15) * 16); pre[5] = *(const u32x4*)(colsb + ((r0_ + (pw1 >> 4)) * NC + C_DNK + h * 128) * 2 + (pw1 & 15) * 16); \
        pre[6] = *(const u32x4*)(asrc_ + pw0 * 16); \
        { const unsigned char* zb_ = colsb + ((r0_ + fr_) * NC + C_DNZ + h * 128 + fs_ * 16) * 2; pre[7] = *(const u32x4*)zb_; pre[8] = *(const u32x4*)(zb_ + 16); } \
        { const unsigned char* ub_ = colsb + ((r0_ + ((dv0 + i) >> 1)) * NC + C_DNV + h * 128 + ((dv0 + i) & 1) * 64 + 4 * q) * 2; \
          un_[0] = *(const u32x2*)ub_; un_[1] = *(const u32x2*)(ub_ + 32); un_[2] = *(const u32x2*)(ub_ + 64); un_[3] = *(const u32x2*)(ub_ + 96); } \
        dln = ((const float*)(ws + WS_DL))[un2_]; } while (0)
#define SCAN_STORE(bufp) do { LAS unsigned char* b_ = (bufp); \
        *(LAS u32x4*)(b_ + O_W + (pw0 >> 4) * 272 + (pw0 & 15) * 16) = pre[0]; *(LAS u32x4*)(b_ + O_W + (pw1 >> 4) * 272 + (pw1 & 15) * 16) = pre[1]; \
        *(LAS u32x4*)(b_ + O_QG + (pw0 >> 4) * 272 + (pw0 & 15) * 16) = pre[2]; *(LAS u32x4*)(b_ + O_QG + (pw1 >> 4) * 272 + (pw1 & 15) * 16) = pre[3]; \
        *(LAS u32x4*)(b_ + O_KD + (pw0 >> 3) * 144 + (pw0 & 7) * 16) = pre[4]; *(LAS u32x4*)(b_ + O_KD + (pw1 >> 3) * 144 + (pw1 & 7) * 16) = pre[5]; \
        *(LAS u32x4*)(b_ + O_A + (pw0 >> 3) * 144 + (pw0 & 7) * 16) = pre[6]; } while (0)
    SCAN_LOAD(0); SCAN_STORE(lds);
    u32x4 zc0 = pre[7], zc1 = pre[8]; u32x2 uraw[4]; float dl = dln;
#pragma unroll
    for (int mt = 0; mt < 4; ++mt) uraw[mt] = un_[mt];
    __syncthreads();
    f32x4 S[8];
#pragma unroll
    for (int t = 0; t < 8; ++t) S[t] = (f32x4){0.f, 0.f, 0.f, 0.f};
#pragma unroll 1
    for (int c = 0; c < 32; ++c) {
        const LAS unsigned char* buf = lds + (c & 1) * BUFB;
        if (c + 1 < 32) SCAN_LOAD(c + 1);
        const size_t row0 = (size_t)(b * 32 + c) * 64;
        bf16x8 Sb[4];
#pragma unroll
        for (int ks = 0; ks < 4; ++ks) Sb[ks] = pack8(S[2 * ks], S[2 * ks + 1]);
        f32x4 vn[4];
#pragma unroll
        for (int mt = 0; mt < 4; ++mt) { f32x4 acc = {0.f, 0.f, 0.f, 0.f};
#pragma unroll
            for (int ks = 0; ks < 4; ++ks) acc = MFMA16(lds_ld2x8(buf + O_W + (16 * mt + i) * 272 + (32 * ks + 4 * q) * 2), Sb[ks], acc);
            vn[mt] = (f32x4){lo_bf(uraw[mt].x) - acc[0], hi_bf(uraw[mt].x) - acc[1], lo_bf(uraw[mt].y) - acc[2], hi_bf(uraw[mt].y) - acc[3]}; }
        bf16x8 Vb[2];
        Vb[0] = pack8(vn[0], vn[1]); Vb[1] = pack8(vn[2], vn[3]);
        f32x4 o[4];
#pragma unroll
        for (int mt = 0; mt < 4; ++mt) { f32x4 acc = {0.f, 0.f, 0.f, 0.f};
#pragma unroll
            for (int ks = 0; ks < 4; ++ks) acc = MFMA16(lds_ld2x8(buf + O_QG + (16 * mt + i) * 272 + (32 * ks + 4 * q) * 2), Sb[ks], acc);
#pragma unroll
            for (int k2 = 0; k2 < 2; ++k2) if (k2 <= (mt >> 1)) acc = MFMA16(lds_ld2x8(buf + O_A + (16 * mt + i) * 144 + (32 * k2 + 4 * q) * 2), Vb[k2], acc);
            o[mt] = acc; }
#pragma unroll
        for (int t = 0; t < 8; ++t) { f32x4 acc = S[t] * dl;
#pragma unroll
            for (int k2 = 0; k2 < 2; ++k2) acc = MFMA16(lds_ld2x8(buf + O_KD + (16 * t + i) * 144 + (32 * k2 + 4 * q) * 2), Vb[k2], acc);
            S[t] = acc; }
        __syncthreads();
#pragma unroll
        for (int mt = 0; mt < 4; ++mt)
#pragma unroll
            for (int r = 0; r < 4; ++r) Ot[(16 * mt + 4 * q + r) * 136 + dv0 + i] = (bf16_t)f2bf(o[mt][r]);
        if (c + 1 < 32) SCAN_STORE(lds + ((c + 1) & 1) * BUFB);
        __syncthreads();
        {
            const u32x4 o0 = *(const LAS u32x4*)(Ot + fr_ * 136 + fs_ * 16), o1 = *(const LAS u32x4*)(Ot + fr_ * 136 + fs_ * 16 + 8);
            float ov[16] = {lo_bf(o0.x), hi_bf(o0.x), lo_bf(o0.y), hi_bf(o0.y), lo_bf(o0.z), hi_bf(o0.z), lo_bf(o0.w), hi_bf(o0.w),
                            lo_bf(o1.x), hi_bf(o1.x), lo_bf(o1.y), hi_bf(o1.y), lo_bf(o1.z), hi_bf(o1.z), lo_bf(o1.w), hi_bf(o1.w)};
            const float zv[16] = {lo_bf(zc0.x), hi_bf(zc0.x), lo_bf(zc0.y), hi_bf(zc0.y), lo_bf(zc0.z), hi_bf(zc0.z), lo_bf(zc0.w), hi_bf(zc0.w),
                                  lo_bf(zc1.x), hi_bf(zc1.x), lo_bf(zc1.y), hi_bf(zc1.y), lo_bf(zc1.z), hi_bf(zc1.z), lo_bf(zc1.w), hi_bf(zc1.w)};
            float ss = 0.f;
#pragma unroll
            for (int e = 0; e < 16; ++e) ss += ov[e] * ov[e];
            ss += __shfl_xor(ss, 1); ss += __shfl_xor(ss, 2); ss += __shfl_xor(ss, 4);
            const float rstd = rsqrtf(ss * (1.f / 128.f) + EPS);
#pragma unroll
            for (int e = 0; e < 16; ++e) ov[e] = ov[e] * rstd * gn[e] * zv[e];
            u32x4 w0, w1;
            w0.x = cvt_pk_bf16(ov[0], ov[1]); w0.y = cvt_pk_bf16(ov[2], ov[3]); w0.z = cvt_pk_bf16(ov[4], ov[5]); w0.w = cvt_pk_bf16(ov[6], ov[7]);
            w1.x = cvt_pk_bf16(ov[8], ov[9]); w1.y = cvt_pk_bf16(ov[10], ov[11]); w1.z = cvt_pk_bf16(ov[12], ov[13]); w1.w = cvt_pk_bf16(ov[14], ov[15]);
            unsigned char* yb = colsb + ((row0 + fr_) * NC + C_DNZ + h * 128 + fs_ * 16) * 2;
            *(u32x4*)yb = w0; *(u32x4*)(yb + 16) = w1;
        }
        zc0 = pre[7]; zc1 = pre[8]; dl = dln;
#pragma unroll
        for (int mt = 0; mt < 4; ++mt) uraw[mt] = un_[mt];
    }
#undef SCAN_LOAD
#undef SCAN_STORE
    __syncthreads();
}

__device__ __forceinline__ void gmlp_unit(const Params& p, int l, int unit, LAS unsigned char* lds) {
    int tid_ = threadIdx.x; asm volatile("" : "+v"(tid_));
    const int tid = tid_, lane = tid & 63, wave = tid >> 6, i = lane & 15, q = lane >> 4;
    const int g = unit & 3, bn = unit >> 2;
    const size_t row0 = (size_t)bn * 128;
    unsigned char* ws = p.ws;
    bf16_t* cols = (bf16_t*)(ws + WS_COLS);
    LAS float* rstd = (LAS float*)lds;
    LAS bf16_t* vT = (LAS bf16_t*)(lds + 512);
    {   u32x4 rv[16];
#pragma unroll
        for (int tt = 0; tt < 16; ++tt) rv[tt] = *(const u32x4*)(cols + (row0 + 16 * wave + tt) * NC + C_GMV + lane * 8);
#pragma unroll
        for (int tt = 0; tt < 16; ++tt) { const u32x4 v = rv[tt];
            float ss = lo_bf(v.x) * lo_bf(v.x) + hi_bf(v.x) * hi_bf(v.x) + lo_bf(v.y) * lo_bf(v.y) + hi_bf(v.y) * hi_bf(v.y) + lo_bf(v.z) * lo_bf(v.z) + hi_bf(v.z) * hi_bf(v.z) + lo_bf(v.w) * lo_bf(v.w) + hi_bf(v.w) * hi_bf(v.w);
            ss = wave_sum(ss); if (lane == 0) rstd[16 * wave + tt] = rsqrtf(ss * (1.f / 512.f) + EPS); } }
    __syncthreads();
#pragma unroll
    for (int it = 0; it < 4; ++it) { const int pc = tid + 512 * it, qrow = pc >> 4, cp = pc & 15;
        const u32x4 v = *(const u32x4*)(cols + (row0 + qrow) * NC + C_GMV + g * 128 + cp * 8);
        const float* gp = p.gm_norm + l * 512 + g * 128 + cp * 8; const float rs = rstd[qrow];
        const float f[8] = {lo_bf(v.x), hi_bf(v.x), lo_bf(v.y), hi_bf(v.y), lo_bf(v.z), hi_bf(v.z), lo_bf(v.w), hi_bf(v.w)};
#pragma unroll
        for (int e = 0; e < 8; ++e) vT[(cp * 8 + e) * 136 + qrow] = (bf16_t)f2bf(f[e] * rs * gp[e]); }
    __syncthreads();
    {
        const int pt = wave; const int nks = (pt >> 1) + 1;
        const bf16_t* spw = (const bf16_t*)(ws + WS_SPW) + (size_t)g * 16384 + (16 * pt + i) * 128 + 8 * q;
        bf16x8 Bf[4];
#pragma unroll
        for (int ks = 0; ks < 4; ++ks) Bf[ks] = *(const bf16x8*)(spw + 32 * ks);
        const float bias = p.spatial_b[l * 512 + g * 128 + 16 * pt + i];
        const size_t prow = row0 + 16 * pt + i;
        u32x2 uu8[8], zz8[8];
#pragma unroll
        for (int ct = 0; ct < 8; ++ct) { const int ch = g * 128 + 16 * ct + 4 * q; uu8[ct] = *(const u32x2*)(cols + prow * NC + C_GMU + ch); zz8[ct] = *(const u32x2*)(cols + prow * NC + C_GMZ + ch); }
#pragma unroll
        for (int ct = 0; ct < 8; ++ct) { f32x4 acc = {0.f, 0.f, 0.f, 0.f};
#pragma unroll
            for (int ks = 0; ks < 4; ++ks) if (ks < nks) acc = MFMA16(*(const LAS bf16x8*)(vT + (16 * ct + i) * 136 + 32 * ks + 8 * q), Bf[ks], acc);
            const int ch = g * 128 + 16 * ct + 4 * q;
            u32x2* up = (u32x2*)(cols + prow * NC + C_GMU + ch); const u32x2 uu = uu8[ct]; const u32x2 zz = zz8[ct];
            u32x2 w; w.x = cvt_pk_bf16(lo_bf(uu.x) * (acc[0] + bias) * lo_bf(zz.x), hi_bf(uu.x) * (acc[1] + bias) * hi_bf(zz.x));
            w.y = cvt_pk_bf16(lo_bf(uu.y) * (acc[2] + bias) * lo_bf(zz.y), hi_bf(uu.y) * (acc[3] + bias) * hi_bf(zz.y));
            *up = w; }
    }
    __syncthreads();
}

template <int HD, int NK, bool SWA>
__device__ __forceinline__ void attn_tile16(bf16_t* qp, const bf16_t* zp, const LAS bf16_t* Kl, const LAS bf16_t* VTl, int kp_lo, int kp_hi, float scale, float m0, float l0, int qi0, bool blk0, int lane) {
    const int i = lane & 15, q = lane >> 4;
    bf16x8 Qf[HD / 32];
#pragma unroll
    for (int kd = 0; kd < HD / 32; ++kd) Qf[kd] = *(const bf16x8*)(qp + (size_t)i * NC + 32 * kd + 8 * q);
    float m = m0, lsum = l0;
    f32x4 O[HD / 16];
#pragma unroll
    for (int dt = 0; dt < HD / 16; ++dt) O[dt] = (f32x4){0.f, 0.f, 0.f, 0.f};
    const int qi = qi0 + i;
    for (int kp = kp_lo; kp <= kp_hi; ++kp) {
        f32x4 s0 = {0.f, 0.f, 0.f, 0.f}, s1 = {0.f, 0.f, 0.f, 0.f};
#pragma unroll
        for (int kd = 0; kd < HD / 32; ++kd) {
            s0 = MFMA16(*(const LAS bf16x8*)(Kl + (32 * kp + i) * (HD + 8) + 32 * kd + 8 * q), Qf[kd], s0);
            s1 = MFMA16(*(const LAS bf16x8*)(Kl + (32 * kp + 16 + i) * (HD + 8) + 32 * kd + 8 * q), Qf[kd], s1);
        }
        float mx = -1e30f;
#pragma unroll
        for (int r = 0; r < 4; ++r) {
            float a = s0[r] * scale, b = s1[r] * scale;
            if (SWA) { const int k0 = 32 * kp + 4 * q + r, k1 = k0 + 16;
                if (!(k0 >= qi + 1 && k0 <= qi + 128 && (!blk0 || k0 >= 128))) a = -1e30f;
                if (!(k1 >= qi + 1 && k1 <= qi + 128 && (!blk0 || k1 >= 128))) b = -1e30f; }
            s0[r] = a; s1[r] = b; mx = fmaxf(mx, fmaxf(a, b));
        }
        mx = fmaxf(mx, __shfl_xor(mx, 16)); mx = fmaxf(mx, __shfl_xor(mx, 32));
        const float mn = fmaxf(m, mx), alpha = __expf(m - mn);
        float ps = 0.f;
#pragma unroll
        for (int r = 0; r < 4; ++r) { s0[r] = __expf(s0[r] - mn); s1[r] = __expf(s1[r] - mn); ps += s0[r] + s1[r]; }
        ps += __shfl_xor(ps, 16); ps += __shfl_xor(ps, 32);
        lsum = lsum * alpha + ps; m = mn;
        const bf16x8 Pb = pack8(s0, s1);
#pragma unroll
        for (int dt = 0; dt < HD / 16; ++dt) { O[dt] = O[dt] * alpha;
            O[dt] = MFMA16(lds_ld2x8((const LAS unsigned char*)(VTl + (16 * dt + i) * (NK + 8) + 32 * kp + 4 * q)), Pb, O[dt]); }
    }
    const float inv = 1.f / lsum;
#pragma unroll
    for (int dt = 0; dt < HD / 16; ++dt) { const int d = 16 * dt + 4 * q;
        const u32x2 zz = *(const u32x2*)(zp + (size_t)i * NC + d);
        u32x2 w; w.x = cvt_pk_bf16(O[dt][0] * inv * lo_bf(zz.x), O[dt][1] * inv * hi_bf(zz.x)); w.y = cvt_pk_bf16(O[dt][2] * inv * lo_bf(zz.y), O[dt][3] * inv * hi_bf(zz.y));
        *(u32x2*)(qp + (size_t)i * NC + d) = w; }
}

__device__ __forceinline__ void swa_unit(const Params& p, int l, int unit, LAS unsigned char* lds) {
    int tid_ = threadIdx.x; asm volatile("" : "+v"(tid_));
    const int tid = tid_, lane = tid & 63, wave = tid >> 6;
    const int kvh = unit & 1, bn = unit >> 1, n = bn & 15, b = bn >> 4;
    unsigned char* ws = p.ws; bf16_t* cols = (bf16_t*)(ws + WS_COLS);
    LAS bf16_t* Kl = (LAS bf16_t*)lds;
    LAS bf16_t* VTl = Kl + 256 * 72;
    const long krow0 = (long)b * T + (long)(n - 1) * 128;
#pragma unroll
    for (int it = 0; it < 4; ++it) { const int pc = tid + 512 * it, kj = pc >> 3, cp = pc & 7;
        u32x4 kv = {0u, 0u, 0u, 0u}, vv = {0u, 0u, 0u, 0u};
        if (n > 0 || kj >= 128) { const bf16_t* rp = cols + (size_t)(krow0 + kj) * NC; kv = *(const u32x4*)(rp + C_SWK + kvh * 64 + cp * 8); vv = *(const u32x4*)(rp + C_SWV + kvh * 64 + cp * 8); }
        *(LAS u32x4*)(Kl + kj * 72 + cp * 8) = kv;
        const unsigned vw[4] = {vv.x, vv.y, vv.z, vv.w};
#pragma unroll
        for (int e = 0; e < 4; ++e) { VTl[(cp * 8 + 2 * e) * 264 + kj] = (bf16_t)(vw[e] & 0xffffu); VTl[(cp * 8 + 2 * e + 1) * 264 + kj] = (bf16_t)(vw[e] >> 16); } }
    __syncthreads();
    {
        const int g = wave >> 1, hq = kvh * 4 + g;
        const float sink = p.sinks[l * 8 + hq];
        for (int qt = 0; qt < 4; ++qt) {
            const int qi0 = (wave & 1) * 64 + 16 * qt;
            const size_t qrow = (size_t)b * T + n * 128 + qi0;
            int kp_lo = (qi0 + 1) >> 5, kp_hi = (qi0 + 143) >> 5; if (kp_hi > 7) kp_hi = 7; if (n == 0 && kp_lo < 4) kp_lo = 4;
            attn_tile16<64, 256, true>(cols + qrow * NC + C_SWQ + hq * 64, cols + qrow * NC + C_SWZ + hq * 64, Kl, VTl, kp_lo, kp_hi, 0.125f, sink, 1.f, qi0, n == 0, lane);
        }
    }
    __syncthreads();
}

__device__ __forceinline__ void xmem_unit(const Params& p, int l, int unit, LAS unsigned char* lds) {
    int tid_ = threadIdx.x; asm volatile("" : "+v"(tid_));
    const int tid = tid_, lane = tid & 63, wave = tid >> 6;
    const int qb = unit & 7, hm = (unit >> 3) & 3, b = unit >> 5;
    unsigned char* ws = p.ws; bf16_t* cols = (bf16_t*)(ws + WS_COLS);
    const bf16_t* mkv = (const bf16_t*)(ws + WS_MEMKV) + (size_t)b * 256 * 1024;
    LAS bf16_t* Kl = (LAS bf16_t*)lds;
    LAS bf16_t* VTl = Kl + 256 * 136;
#pragma unroll
    for (int it = 0; it < 8; ++it) { const int pc = tid + 512 * it, kj = pc >> 4, cp = pc & 15;
        const bf16_t* rp = mkv + (size_t)kj * 1024 + hm * 128 + cp * 8;
        const u32x4 kv = *(const u32x4*)rp, vv = *(const u32x4*)(rp + 512);
        *(LAS u32x4*)(Kl + kj * 136 + cp * 8) = kv;
        const unsigned vw[4] = {vv.x, vv.y, vv.z, vv.w};
#pragma unroll
        for (int e = 0; e < 4; ++e) { VTl[(cp * 8 + 2 * e) * 264 + kj] = (bf16_t)(vw[e] & 0xffffu); VTl[(cp * 8 + 2 * e + 1) * 264 + kj] = (bf16_t)(vw[e] >> 16); } }
    __syncthreads();
    for (int qt = 0; qt < 2; ++qt) {
        const size_t qrow = (size_t)b * T + qb * 256 + 32 * wave + 16 * qt;
        attn_tile16<128, 256, false>(cols + qrow * NC + C_XMQ + hm * 128, cols + qrow * NC + C_XMZ + hm * 128, Kl, VTl, 0, 7, 0.08838834764831845f, -1e30f, 0.f, 0, false, lane);
    }
    __syncthreads();
}

__global__ void __launch_bounds__(512) mega_fwd(Params p) {
    extern __shared__ __attribute__((aligned(16))) unsigned char lds_raw[];
    LAS unsigned char* lds = (LAS unsigned char*)lds_raw;
    cg::grid_group grid = cg::this_grid();
    const int G = gridDim.x, bx = blockIdx.x;
    const int vcu = (G % 8 == 0) ? (bx % 8) * (G / 8) + bx / 8 : bx;
    const Epi E{p.ws};
#pragma unroll 1
    for (int l = 0; l < 2; ++l) {
        p0_stage(p, l, lds);
        grid.sync();
#ifndef PROBE_REP
#define PROBE_REP 0
#endif
        for (int rep = 0; rep < ((PROBE_REP == 1 || PROBE_REP == 2) ? 2 : 1); ++rep) {
        { SchedA S{p.ws, G, bx}; pg8::gemm_phase<Epi, SchedA>(lds, S, E); }
        grid.sync();
        if (PROBE_REP == 1 && rep == 0) continue;
        for (int u = bx; u < 1024; u += G) delta_pre_unit(p, l, u, lds);
        grid.sync();
        if (G >= 64) {
            if (bx < 32) delta_scan_unit(p, l, bx, lds);
            else for (int u = bx - 32; u < 1024; u += G - 32) { if (u < 256) swa_unit(p, l, u, lds); else if (u < 512) xmem_unit(p, l, u - 256, lds); else gmlp_unit(p, l, u - 512, lds); }
        } else {
            for (int u = bx; u < 32 + 1024; u += G) { if (u < 32) delta_scan_unit(p, l, u, lds); else if (u < 288) swa_unit(p, l, u - 32, lds); else if (u < 544) xmem_unit(p, l, u - 288, lds); else gmlp_unit(p, l, u - 544, lds); }
        }
        grid.sync();
        }
        for (int rep = 0; rep < ((PROBE_REP == 3 || PROBE_REP == 4) ? 2 : 1); ++rep) {
        { SchedD S{p.ws, G, vcu}; pg8::gemm_phase<Epi, SchedD>(lds, S, E); }
        grid.sync();
        if (PROBE_REP == 3 && rep == 0) continue;
        { SchedE S{p.ws, G, vcu}; pg8::gemm_phase<Epi, SchedE>(lds, S, E); }
        grid.sync();
        }
    }
    p0_stage(p, 2, lds);
}

extern "C" void kernel_launch(void* const* d_in, const int* in_sizes, int n_in, void* d_out, int out_size, void* d_ws, size_t ws_size, hipStream_t stream) {
    static int grid = 0;
    if (grid == 0) {
        if (n_in != 17 || out_size != M * D || ws_size < WS_END) { fprintf(stderr, "kernel_launch: unexpected shapes / workspace (%d inputs, out %d, ws %zu)\n", n_in, out_size, ws_size); grid = -1; return; }
        int dev = 0, cus = 0, per_cu = 0;
        hipGetDevice(&dev);
        hipDeviceGetAttribute(&cus, hipDeviceAttributeMultiprocessorCount, dev);
        hipFuncSetAttribute((const void*)mega_fwd, hipFuncAttributeMaxDynamicSharedMemorySize, LDS_BYTES);
        hipOccupancyMaxActiveBlocksPerMultiprocessor(&per_cu, (const void*)mega_fwd, 512, LDS_BYTES);
        if (per_cu < 1) { fprintf(stderr, "kernel_launch: occupancy query reports %d blocks per CU\n", per_cu); (void)hipGetLastError(); per_cu = 1; }
        grid = cus * 1;
    }
    if (grid < 0) return;
    Params p{};
    p.x = (const float*)d_in[0]; p.mem = (const float*)d_in[1]; p.norm_pre = (const float*)d_in[2]; p.norm_post = (const float*)d_in[3]; p.norm_mem = (const float*)d_in[4];
    p.w_in = (const float*)d_in[5]; p.conv_w = (const float*)d_in[6]; p.a_log = (const float*)d_in[7]; p.dt_bias = (const float*)d_in[8]; p.dn_norm = (const float*)d_in[9];
    p.gm_norm = (const float*)d_in[10]; p.spatial_w = (const float*)d_in[11]; p.spatial_b = (const float*)d_in[12]; p.sinks = (const float*)d_in[13];
    p.w_mem_kv = (const float*)d_in[14]; p.w_up = (const float*)d_in[15]; p.w_out = (const float*)d_in[16];
    p.out = (float*)d_out; p.ws = (unsigned char*)d_ws;
    void* args[] = {&p};
    hipError_t e = hipLaunchCooperativeKernel((const void*)mega_fwd, dim3(grid), dim3(512), args, LDS_BYTES, stream);
    if (e != hipSuccess) fprintf(stderr, "cooperative launch failed: %s (grid %d)\n", hipGetErrorString(e), grid);
}
```

```cpp
#include <hip/hip_runtime.h>
#include <hip/hip_cooperative_groups.h>
#include <cstdio>
#include <cstdint>
namespace cg = cooperative_groups;

#define LAS __attribute__((address_space(3)))
typedef unsigned short bf16_t;
typedef short bf16x8 __attribute__((ext_vector_type(8)));
typedef float f32x4 __attribute__((ext_vector_type(4)));
typedef unsigned u32x4 __attribute__((ext_vector_type(4)));
typedef unsigned u32x2 __attribute__((ext_vector_type(2)));

constexpr int NB = 8, T = 2048, M = NB * T, D = 1024, NC = 5888, DIN = 9992;
constexpr int C_DNQ = 0, C_DNK = 512, C_DNV = 1024, C_DNZ = 1536, C_GMU = 2048, C_GMV = 2560, C_GMZ = 3072, C_SWQ = 3584, C_SWK = 4096, C_SWV = 4224,
              C_SWZ = 4352, C_XMQ = 4864, C_XMZ = 5376;
constexpr float EPS = 1e-6f;
constexpr size_t MiB = 1u << 20;
constexpr size_t WS_WINT = 1 * MiB, WS_WGT = WS_WINT + 12058624, WS_WUPT = WS_WGT + 8 * MiB, WS_WOUTT = WS_WUPT + 4 * MiB, WS_WMKVT = WS_WOUTT + 2 * MiB,
                 WS_SPW = WS_WMKVT + 2 * MiB;
constexpr size_t WS_H = 29 * MiB, WS_COLS = 61 * MiB, WS_OUT = WS_COLS, WS_X = 245 * MiB;
constexpr size_t WS_WA_W = WS_X, WS_WA_A = WS_X + 16 * MiB, WS_HALO = WS_X + 24 * MiB, WS_SM = WS_X + 27 * MiB, WS_DL = WS_SM + 512 * 1024,
                 WS_MEMN = WS_X + 28 * MiB, WS_MEMKV = WS_X + 32 * MiB, WS_GSCR = WS_X, WS_MERGED = WS_X + 32 * MiB, WS_END = 309 * MiB;
constexpr int LDS_BYTES = 155648;

struct Params {
    const float *x, *mem, *norm_pre, *norm_post, *norm_mem, *w_in, *conv_w, *a_log, *dt_bias, *dn_norm, *gm_norm, *spatial_w, *spatial_b, *sinks, *w_mem_kv,
        *w_up, *w_out;
    float* out;
    unsigned char* ws;
};

__device__ __forceinline__ unsigned f2bf(float f) { unsigned u = __float_as_uint(f); return (u + 0x7fffu + ((u >> 16) & 1u)) >> 16; }
__device__ __forceinline__ float bf2f(unsigned b) { return __uint_as_float(b << 16); }
__device__ __forceinline__ unsigned cvt_pk_bf16(float lo, float hi) { unsigned r; asm volatile("v_cvt_pk_bf16_f32 %0, %1, %2" : "=v"(r) : "v"(lo), "v"(hi)); return r; }
__device__ __forceinline__ float lo_bf(unsigned w) { return __uint_as_float(w << 16); }
__device__ __forceinline__ float hi_bf(unsigned w) { return __uint_as_float(w & 0xffff0000u); }
__device__ __forceinline__ float wave_sum(float v) {
#pragma unroll
    for (int o = 1; o < 64; o <<= 1) v += __shfl_xor(v, o);
    return v;
}
__device__ __forceinline__ float silu_f(float y) { return y / (1.f + __expf(-y)); }
__device__ __forceinline__ float sigmoid_f(float y) { return 1.f / (1.f + __expf(-y)); }
__device__ __forceinline__ float gelu_tanh_f(float x) {
    const float u = 0.7978845608f * (x + 0.044715f * x * x * x);
    const float t = 1.f - 2.f / (__expf(2.f * u) + 1.f);
    return 0.5f * x * (1.f + t);
}
__device__ __forceinline__ bf16x8 pack8(const f32x4 a, const f32x4 b) {
    u32x4 w; w.x = cvt_pk_bf16(a[0], a[1]); w.y = cvt_pk_bf16(a[2], a[3]); w.z = cvt_pk_bf16(b[0], b[1]); w.w = cvt_pk_bf16(b[2], b[3]);
    return __builtin_bit_cast(bf16x8, w);
}
__device__ __forceinline__ bf16x8 lds_ld2x8(const LAS unsigned char* pl) {
    const u32x2 lo = *(const LAS u32x2*)pl, hi = *(const LAS u32x2*)(pl + 32);
    u32x4 w; w.x = lo.x; w.y = lo.y; w.z = hi.x; w.w = hi.y; return __builtin_bit_cast(bf16x8, w);
}
#define MFMA16(a, b, c) __builtin_amdgcn_mfma_f32_16x16x32_bf16((a), (b), (c), 0, 0, 0)

namespace pg8 {
constexpr int BM = 256, BK = 64, HALF = 128, HTB = HALF * BK * 2, STAGE_BYTES = 8 * HTB;
__device__ __forceinline__ int lds_byte(int r, int c) { const int st = (r >> 4) * 2 + (c >> 5), rr = r & 15, cc = c & 31, ob = rr * 64 + cc * 2; return st * 1024 + (ob ^ (((ob >> 9) & 1) << 5)); }
__device__ __forceinline__ void stage_rc(int b, int& R, int& C) { const int st = b / 1024, sb = b % 1024, swz = sb ^ (((sb >> 9) & 1) << 5); R = (st >> 1) * 16 + swz / 64; C = (st & 1) * 32 + (swz % 64) / 2; }
__device__ __forceinline__ int perm32(int rho) { const int n = rho >> 4, i = rho & 15; return 8 * (i >> 2) + 4 * n + (i & 3); }

struct Unit { const char* a; const char* b; unsigned lda, ldb; int nt; int pm, pn, kind, sub; };

__device__ __forceinline__ void mkoff(const Unit& u, int tid, unsigned (&vA)[2], unsigned (&vB)[2]) {
#pragma unroll
    for (int i = 0; i < 2; ++i) { int R, C; stage_rc(tid * 16 + i * 8192, R, C); const int Rb = (R & ~31) + perm32(R & 31);
        vA[i] = (unsigned)(R * u.lda + C) * 2u; vB[i] = (unsigned)(Rb * u.ldb + C) * 2u; }
}

template <class Epi, class Sched>
__device__ __forceinline__ void gemm_phase(LAS unsigned char* lds, const Sched& S, const Epi& E) {
    int tid_ = threadIdx.x; asm volatile("" : "+v"(tid_));
    const int tid = tid_, wid = __builtin_amdgcn_readfirstlane(tid >> 6), lane = tid & 63, wr = wid >> 2, wc = wid & 3, fr = lane & 15, fq = lane >> 4;
    const size_t kstep = (size_t)(BK * 2);
    const unsigned ldsw = (unsigned)wid * 1024u;
    const int aoff = lds_byte(wr * 64 + fr, fq * 8), boff = lds_byte(wc * 32 + fr, fq * 8);
#define PG8_SA(b, h) (((b) * 2 + (h)) * HTB)
#define PG8_SB(b, h) ((4 + (b) * 2 + (h)) * HTB)
#define PG8_STAGE(bufoff, gbase, voff) do { _Pragma("unroll") for (int _i = 0; _i < 2; ++_i) \
        __builtin_amdgcn_global_load_lds((const unsigned*)((const char*)(gbase) + (voff)[_i]), (LAS unsigned*)(lds + (bufoff) + ldsw + _i * 8192), 16, 0, 0); } while (0)
#define PG8_LDA(dst, b, h) do { _Pragma("unroll") for (int m = 0; m < 4; ++m) _Pragma("unroll") for (int k = 0; k < 2; ++k) dst[m][k] = *(const LAS bf16x8*)(lds + PG8_SA(b, h) + aoff + m * 2048 + k * 1024); } while (0)
#define PG8_LDB(dst, b, h) do { _Pragma("unroll") for (int n = 0; n < 2; ++n) _Pragma("unroll") for (int k = 0; k < 2; ++k) dst[n][k] = *(const LAS bf16x8*)(lds + PG8_SB(b, h) + boff + n * 2048 + k * 1024); } while (0)
#define PG8_MMA(ai, bj, At, Bt) do { __builtin_amdgcn_s_setprio(1); _Pragma("unroll") for (int m = 0; m < 4; ++m) _Pragma("unroll") for (int n = 0; n < 2; ++n) _Pragma("unroll") for (int k = 0; k < 2; ++k) \
        acc[ai][bj][m][n] = __builtin_amdgcn_mfma_f32_16x16x32_bf16(Bt[n][k], At[m][k], acc[ai][bj][m][n], 0, 0, 0); __builtin_amdgcn_s_setprio(0); } while (0)
#define PG8_WAIT_V(n) asm volatile("s_waitcnt vmcnt(" #n ")" ::: "memory")
#define PG8_WAIT_L(n) asm volatile("s_waitcnt lgkmcnt(" #n ")" ::: "memory")
#define PG8_BAR __builtin_amdgcn_s_barrier()
#define PG8_SCHED __builtin_amdgcn_sched_barrier(0)
    Unit cur, nxt; int ui = 0;
    if (!S.next(0, cur)) return;
    f32x4 acc[2][2][4][2];
#pragma unroll
    for (int a = 0; a < 2; ++a)
#pragma unroll
        for (int b = 0; b < 2; ++b)
#pragma unroll
            for (int m = 0; m < 4; ++m)
#pragma unroll
                for (int n = 0; n < 2; ++n) acc[a][b][m][n] = (f32x4){0.f, 0.f, 0.f, 0.f};
    bf16x8 At[4][2], B0[2][2], B1[2][2];
    unsigned vAc[2], vBc[2], vAn[2], vBn[2];
    mkoff(cur, tid, vAc, vBc);
    const char* cA = cur.a; const char* cB = cur.b;
    size_t hAc = (size_t)HALF * cur.lda * 2, hBc = (size_t)HALF * cur.ldb * 2;
    PG8_STAGE(PG8_SB(0, 0), cB, vBc); PG8_STAGE(PG8_SB(0, 1), cB + hBc, vBc); PG8_STAGE(PG8_SA(0, 0), cA, vAc); PG8_STAGE(PG8_SA(0, 1), cA + hAc, vAc);
    if (wr == 1) PG8_BAR;
    PG8_WAIT_V(2); PG8_BAR;
    PG8_STAGE(PG8_SB(1, 0), cB + kstep, vBc); PG8_STAGE(PG8_SA(1, 0), cA + kstep, vAc); PG8_STAGE(PG8_SB(1, 1), cB + hBc + kstep, vBc);
    PG8_WAIT_V(6); PG8_BAR;
    for (;;) {
        const bool has_next = S.next(ui + 1, nxt);
        const char* nA = cA; const char* nB = cB; size_t hAn = hAc, hBn = hBc;
        vAn[0] = vAc[0]; vAn[1] = vAc[1]; vBn[0] = vBc[0]; vBn[1] = vBc[1];
        if (has_next) { nA = nxt.a; nB = nxt.b; mkoff(nxt, tid, vAn, vBn); hAn = (size_t)HALF * nxt.lda * 2; hBn = (size_t)HALF * nxt.ldb * 2; }
        const int nt = cur.nt;
        for (int t = 0; t < nt; t += 2) {
            const bool last = (t == nt - 2);
            const char* a1 = cA + (size_t)(t + 1) * kstep;
            const char* a2 = last ? nA : cA + (size_t)(t + 2) * kstep; const char* b2 = last ? nB : cB + (size_t)(t + 2) * kstep;
            const char* a3 = a2 + kstep; const char* b3 = b2 + kstep;
            unsigned vA2[2], vB2[2];
            vA2[0] = last ? vAn[0] : vAc[0]; vA2[1] = last ? vAn[1] : vAc[1]; vB2[0] = last ? vBn[0] : vBc[0]; vB2[1] = last ? vBn[1] : vBc[1];
            const size_t hA2 = last ? hAn : hAc, hB2 = last ? hBn : hBc;
            PG8_LDB(B0, 0, 0); PG8_LDB(B1, 0, 1); PG8_SCHED; PG8_LDA(At, 0, 0); PG8_STAGE(PG8_SA(1, 1), a1 + hAc, vAc);
            PG8_WAIT_V(8); PG8_WAIT_L(0); PG8_BAR; PG8_MMA(0, 0, At, B0); PG8_MMA(0, 1, At, B1); PG8_BAR; PG8_SCHED;
            PG8_LDA(At, 0, 1); PG8_STAGE(PG8_SB(0, 0), b2, vB2); PG8_STAGE(PG8_SB(0, 1), b2 + hB2, vB2); PG8_STAGE(PG8_SA(0, 0), a2, vA2);
            PG8_WAIT_V(8); PG8_WAIT_L(0); PG8_BAR; PG8_MMA(1, 0, At, B0); PG8_MMA(1, 1, At, B1); PG8_BAR; PG8_SCHED;
            PG8_LDB(B0, 1, 0); PG8_LDB(B1, 1, 1); PG8_SCHED; PG8_LDA(At, 1, 0); PG8_STAGE(PG8_SA(0, 1), a2 + hA2, vA2);
            PG8_WAIT_V(8); PG8_WAIT_L(0); PG8_BAR; PG8_MMA(0, 0, At, B0); PG8_MMA(0, 1, At, B1); PG8_BAR; PG8_SCHED;
            PG8_LDA(At, 1, 1); PG8_STAGE(PG8_SB(1, 0), b3, vB2); PG8_STAGE(PG8_SB(1, 1), b3 + hB2, vB2); PG8_STAGE(PG8_SA(1, 0), a3, vA2);
            PG8_WAIT_V(8); PG8_WAIT_L(0); PG8_BAR; PG8_MMA(1, 0, At, B0); PG8_MMA(1, 1, At, B1); PG8_BAR; PG8_SCHED;
        }
        if (wr == 0) PG8_BAR;
        E(acc, cur, wr, wc, fr, fq, tid);
        if (!has_next) break;
#pragma unroll
        for (int a = 0; a < 2; ++a)
#pragma unroll
            for (int b = 0; b < 2; ++b)
#pragma unroll
                for (int m = 0; m < 4; ++m)
#pragma unroll
                    for (int n = 0; n < 2; ++n) acc[a][b][m][n] = (f32x4){0.f, 0.f, 0.f, 0.f};
        cur = nxt; cA = nA; cB = nB; hAc = hAn; hBc = hBn; vAc[0] = vAn[0]; vAc[1] = vAn[1]; vBc[0] = vBn[0]; vBc[1] = vBn[1]; ++ui;
        if (wr == 1) PG8_BAR;
    }
    PG8_WAIT_V(0);
    PG8_BAR;
#undef PG8_SA
#undef PG8_SB
#undef PG8_STAGE
#undef PG8_LDA
#undef PG8_LDB
#undef PG8_MMA
#undef PG8_WAIT_V
#undef PG8_WAIT_L
#undef PG8_BAR
#undef PG8_SCHED
}
}
using pg8::Unit;

struct Epi {
    unsigned char* ws;
    __device__ __forceinline__ void operator()(const f32x4 (&acc)[2][2][4][2], const Unit& u, int wr, int wc, int fr, int fq, int tid) const {
        asm volatile("" : "+v"(tid), "+v"(fr), "+v"(fq));
        const int row0 = u.pm * 256 + wr * 64 + fr, col0 = u.pn * 256 + wc * 32 + 8 * fq;
        if (u.kind == 0) {
            bf16_t* cols = (bf16_t*)(ws + WS_COLS); bf16_t* halo = (bf16_t*)(ws + WS_HALO);
            const int pn = u.pn;
            const int act = (pn == 6 || pn == 7 || pn == 12 || pn == 13 || pn == 17 || pn == 18 || pn >= 21) ? 1 : ((pn >= 8 && pn <= 11) ? 2 : 0);
#pragma unroll
            for (int ai = 0; ai < 2; ++ai)
#pragma unroll
                for (int m = 0; m < 4; ++m) {
                    const int r = row0 + ai * 128 + m * 16;
                    bf16_t* rowp = cols + (size_t)r * NC + col0;
#pragma unroll
                    for (int bj = 0; bj < 2; ++bj) {
                        f32x4 v0 = acc[ai][bj][m][0], v1 = acc[ai][bj][m][1];
                        if (act == 1) {
#pragma unroll
                            for (int e = 0; e < 4; ++e) { v0[e] = silu_f(v0[e]); v1[e] = silu_f(v1[e]); }
                        } else if (act == 2) {
#pragma unroll
                            for (int e = 0; e < 4; ++e) { v0[e] = gelu_tanh_f(v0[e]); v1[e] = gelu_tanh_f(v1[e]); }
                        }
                        u32x4 w; w.x = cvt_pk_bf16(v0[0], v0[1]); w.y = cvt_pk_bf16(v0[2], v0[3]); w.z = cvt_pk_bf16(v1[0], v1[1]); w.w = cvt_pk_bf16(v1[2], v1[3]);
                        *(u32x4*)(rowp + bj * 128) = w;
                        if (pn < 6 && (r & 63) >= 61) *(u32x4*)(halo + ((size_t)(r >> 6) * 3 + ((r & 63) - 61)) * 1536 + col0 + bj * 128) = w;
                    }
                }
        } else if (u.kind == 1) {
            bf16_t* o = (bf16_t*)(ws + WS_MEMKV);
#pragma unroll
            for (int ai = 0; ai < 2; ++ai)
#pragma unroll
                for (int m = 0; m < 4; ++m) {
                    bf16_t* rowp = o + (size_t)(row0 + ai * 128 + m * 16) * 1024 + col0;
#pragma unroll
                    for (int bj = 0; bj < 2; ++bj) {
                        const f32x4 v0 = acc[ai][bj][m][0], v1 = acc[ai][bj][m][1];
                        u32x4 w; w.x = cvt_pk_bf16(v0[0], v0[1]); w.y = cvt_pk_bf16(v0[2], v0[3]); w.z = cvt_pk_bf16(v1[0], v1[1]); w.w = cvt_pk_bf16(v1[2], v1[3]);
                        *(u32x4*)(rowp + bj * 128) = w;
                    }
                }
        } else if (u.kind == 2) {
            u32x4* g = (u32x4*)(ws + WS_GSCR) + (size_t)(u.pm * 4 + u.pn) * 16 * 512 + tid;
#pragma unroll
            for (int ai = 0; ai < 2; ++ai)
#pragma unroll
                for (int m = 0; m < 4; ++m)
#pragma unroll
                    for (int bj = 0; bj < 2; ++bj) {
                        const f32x4 v0 = acc[ai][bj][m][0], v1 = acc[ai][bj][m][1];
                        u32x4 w; w.x = cvt_pk_bf16(sigmoid_f(v0[0]), sigmoid_f(v0[1])); w.y = cvt_pk_bf16(sigmoid_f(v0[2]), sigmoid_f(v0[3]));
                        w.z = cvt_pk_bf16(sigmoid_f(v1[0]), sigmoid_f(v1[1])); w.w = cvt_pk_bf16(sigmoid_f(v1[2]), sigmoid_f(v1[3]));
                        g[(size_t)((ai * 4 + m) * 2 + bj) * 512] = w;
                    }
        } else if (u.kind == 3) {
            const u32x4* g = (const u32x4*)(ws + WS_GSCR) + (size_t)(u.pm * 4 + u.pn) * 16 * 512 + tid;
            bf16_t* mg = (bf16_t*)(ws + WS_MERGED);
#pragma unroll
            for (int ai = 0; ai < 2; ++ai)
#pragma unroll
                for (int m = 0; m < 4; ++m) {
                    bf16_t* rowp = mg + (size_t)(row0 + ai * 128 + m * 16) * 1024 + col0;
#pragma unroll
                    for (int bj = 0; bj < 2; ++bj) {
                        const f32x4 v0 = acc[ai][bj][m][0], v1 = acc[ai][bj][m][1];
                        const u32x4 gw = g[(size_t)((ai * 4 + m) * 2 + bj) * 512];
                        float r0 = lo_bf(gw.x) * v0[0], r1 = hi_bf(gw.x) * v0[1], r2 = lo_bf(gw.y) * v0[2], r3 = hi_bf(gw.y) * v0[3];
                        float r4 = lo_bf(gw.z) * v1[0], r5 = hi_bf(gw.z) * v1[1], r6 = lo_bf(gw.w) * v1[2], r7 = hi_bf(gw.w) * v1[3];
                        if (u.sub > 0) { const u32x4 pw = *(const u32x4*)(rowp + bj * 128);
                            r0 += lo_bf(pw.x); r1 += hi_bf(pw.x); r2 += lo_bf(pw.y); r3 += hi_bf(pw.y); r4 += lo_bf(pw.z); r5 += hi_bf(pw.z); r6 += lo_bf(pw.w); r7 += hi_bf(pw.w); }
                        u32x4 w; w.x = cvt_pk_bf16(r0, r1); w.y = cvt_pk_bf16(r2, r3); w.z = cvt_pk_bf16(r4, r5); w.w = cvt_pk_bf16(r6, r7);
                        *(u32x4*)(rowp + bj * 128) = w;
                        asm volatile("" ::: "memory");
                    }
                }
        } else {
            float* o = (float*)(ws + WS_OUT);
#pragma unroll
            for (int ai = 0; ai < 2; ++ai)
#pragma unroll
                for (int m = 0; m < 4; ++m) {
                    float* rowp = o + (size_t)(row0 + ai * 128 + m * 16) * 1024 + col0;
#pragma unroll
                    for (int bj = 0; bj < 2; ++bj) { *(f32x4*)(rowp + bj * 128) = acc[ai][bj][m][0]; *(f32x4*)(rowp + bj * 128 + 4) = acc[ai][bj][m][1]; }
                }
        }
    }
};

struct SchedA {
    const unsigned char* ws; int G, c;
    __device__ __forceinline__ bool next(int i, Unit& u) const {
        const int L = i * G + c;
        constexpr int nN = 23, nwg = 64 * nN;
        if (L < nwg) {
            int wgid = L; { const int q = nwg / 8, xcd = wgid % 8, off = wgid / 8; wgid = xcd * q + off; }
            const int nig = 8 * nN, gid = wgid / nig, fm = gid * 8;
            u.pm = fm + ((wgid % nig) % 8); u.pn = (wgid % nig) / 8; u.kind = 0; u.sub = 0; u.lda = 1024; u.ldb = 1024; u.nt = 16;
            u.a = (const char*)(ws + WS_H) + (size_t)u.pm * 256 * 1024 * 2; u.b = (const char*)(ws + WS_WINT) + (size_t)u.pn * 256 * 1024 * 2;
            return true;
        }
        const int r = L - nwg; if (r >= 32) return false;
        u.pm = r >> 2; u.pn = r & 3; u.kind = 1; u.sub = 0; u.lda = 1024; u.ldb = 1024; u.nt = 16;
        u.a = (const char*)(ws + WS_MEMN) + (size_t)u.pm * 256 * 1024 * 2; u.b = (const char*)(ws + WS_WMKVT) + (size_t)u.pn * 256 * 1024 * 2;
        return true;
    }
};
struct SchedD {
    const unsigned char* ws; int G, vcu;
    __device__ __forceinline__ bool next(int i, Unit& u) const {
        const int tile = vcu + (i >> 3) * G; if (tile >= 256) return false;
        const int sub = i & 7, n = sub >> 1;
        u.pm = tile >> 2; u.pn = tile & 3; u.sub = n;
        if ((sub & 1) == 0) { u.kind = 2; u.lda = 1024; u.ldb = 1024; u.nt = 16;
            u.a = (const char*)(ws + WS_H) + (size_t)u.pm * 256 * 1024 * 2; u.b = (const char*)(ws + WS_WGT) + (size_t)(n * 1024 + u.pn * 256) * 1024 * 2;
        } else { u.kind = 3; u.lda = NC; u.ldb = 512; u.nt = 8;
            const int yoff = n == 0 ? C_DNZ : (n == 1 ? C_GMU : (n == 2 ? C_SWQ : C_XMQ));
            u.a = (const char*)(ws + WS_COLS) + ((size_t)u.pm * 256 * NC + yoff) * 2; u.b = (const char*)(ws + WS_WUPT) + (size_t)(n * 1024 + u.pn * 256) * 512 * 2; }
        return true;
    }
};
struct SchedE {
    const unsigned char* ws; int G, vcu;
    __device__ __forceinline__ bool next(int i, Unit& u) const {
        const int tile = vcu + i * G; if (tile >= 256) return false;
        u.pm = tile >> 2; u.pn = tile & 3; u.kind = 4; u.sub = 0; u.lda = 1024; u.ldb = 1024; u.nt = 16;
        u.a = (const char*)(ws + WS_MERGED) + (size_t)u.pm * 256 * 1024 * 2; u.b = (const char*)(ws + WS_WOUTT) + (size_t)u.pn * 256 * 1024 * 2;
        return true;
    }
};

__device__ __forceinline__ void tr_item(const float* W, int ldw, int k0, bf16_t* WT, int Kdst, LAS float* scr, int lane) {
    float tv[32];
#pragma unroll
    for (int i = 0; i < 32; ++i) tv[i] = W[(size_t)(k0 + 2 * i + (lane >> 5)) * ldw + (lane & 31)];
#pragma unroll
    for (int i = 0; i < 32; ++i) scr[(2 * i + (lane >> 5)) * 33 + (lane & 31)] = tv[i];
    asm volatile("s_waitcnt lgkmcnt(0)" ::: "memory");
    const int c = lane & 7;
#pragma unroll
    for (int j = 0; j < 4; ++j) { const int n = (lane >> 3) + 8 * j; const LAS float* s = scr + (8 * c) * 33 + n;
        u32x4 o; o.x = cvt_pk_bf16(s[0 * 33], s[1 * 33]); o.y = cvt_pk_bf16(s[2 * 33], s[3 * 33]); o.z = cvt_pk_bf16(s[4 * 33], s[5 * 33]); o.w = cvt_pk_bf16(s[6 * 33], s[7 * 33]);
        *(u32x4*)(WT + (size_t)n * Kdst + k0 + 8 * c) = o; }
    asm volatile("s_waitcnt lgkmcnt(0)" ::: "memory");
}

__device__ __forceinline__ void p0_stage(const Params& p, int rk, LAS unsigned char* lds) {
    int tid_ = threadIdx.x; asm volatile("" : "+v"(tid_));
    const int tid = tid_, lane = tid & 63, wave = tid >> 6;
    const int gw = blockIdx.x * 8 + wave, NGW = gridDim.x * 8;
    unsigned char* ws = p.ws;
    LAS float* W8T = (LAS float*)(lds + 8 * 8448);
    if (rk <= 1) {
        const int l = rk;
        const float* win = p.w_in + (size_t)l * 1024 * DIN;
        {   f32x4 wv[4];
#pragma unroll
            for (int t2 = 0; t2 < 2; ++t2) { const float* wp = win + (size_t)(tid + 512 * t2) * DIN + 2048; wv[2 * t2] = *(const f32x4*)wp; wv[2 * t2 + 1] = *(const f32x4*)(wp + 4); }
#pragma unroll
            for (int t2 = 0; t2 < 2; ++t2)
#pragma unroll
                for (int j = 0; j < 8; ++j) W8T[j * 1024 + tid + 512 * t2] = wv[2 * t2 + (j >> 2)][j & 3]; }
        LAS float* scr = (LAS float*)(lds + wave * 8448);
        for (int it = gw; it < 7040; it += NGW) {
            if (it < 2944) { const int kb = it / 184, nb = it % 184, n0 = 32 * nb, sc = n0 < 2048 ? n0 : n0 + 8;
                tr_item(win + sc, DIN, 64 * kb, (bf16_t*)(ws + WS_WINT) + (size_t)n0 * 1024, 1024, scr, lane);
            } else if (it < 4992) { const int r = it - 2944, kb = r / 128, nb = r % 128;
                tr_item(win + 5896 + 32 * nb, DIN, 64 * kb, (bf16_t*)(ws + WS_WGT) + (size_t)(32 * nb) * 1024, 1024, scr, lane);
            } else if (it < 6016) { const int r = it - 4992, n = r / 256, r2 = r % 256, kb = r2 / 32, nb = r2 % 32;
                tr_item(p.w_up + (size_t)(l * 4 + n) * 512 * 1024 + 32 * nb, 1024, 64 * kb, (bf16_t*)(ws + WS_WUPT) + (size_t)(n * 1024 + 32 * nb) * 512, 512, scr, lane);
            } else if (it < 6528) { const int r = it - 6016, kb = r / 32, nb = r % 32;
                tr_item(p.w_out + (size_t)l * 1024 * 1024 + 32 * nb, 1024, 64 * kb, (bf16_t*)(ws + WS_WOUTT) + (size_t)(32 * nb) * 1024, 1024, scr, lane);
            } else { const int r = it - 6528, kb = r / 32, nb = r % 32;
                tr_item(p.w_mem_kv + (size_t)l * 1024 * 1024 + 32 * nb, 1024, 64 * kb, (bf16_t*)(ws + WS_WMKVT) + (size_t)(32 * nb) * 1024, 1024, scr, lane);
            }
        }
        for (int e = blockIdx.x * 512 + tid; e < 65536; e += gridDim.x * 512) { const int pp = (e >> 7) & 127, qq = e & 127;
            ((bf16_t*)(ws + WS_SPW))[e] = (bf16_t)(qq <= pp ? f2bf(p.spatial_w[(size_t)l * 65536 + e]) : 0u); }
        for (int r = gw; r < 2048; r += NGW) {
            const f32x4* xr = (const f32x4*)(p.mem + (size_t)r * D) + lane; const f32x4* gr = (const f32x4*)(p.norm_mem + l * D) + lane;
            f32x4 v[4]; float ss = 0.f;
#pragma unroll
            for (int j = 0; j < 4; ++j) { v[j] = xr[64 * j]; ss += v[j][0] * v[j][0] + v[j][1] * v[j][1] + v[j][2] * v[j][2] + v[j][3] * v[j][3]; }
            const float rstd = rsqrtf(wave_sum(ss) * (1.f / D) + EPS);
            u32x2* o = (u32x2*)((bf16_t*)(ws + WS_MEMN) + (size_t)r * D) + lane;
#pragma unroll
            for (int j = 0; j < 4; ++j) { const f32x4 g = gr[64 * j]; u32x2 w; w.x = cvt_pk_bf16(v[j][0] * rstd * g[0], v[j][1] * rstd * g[1]); w.y = cvt_pk_bf16(v[j][2] * rstd * g[2], v[j][3] * rstd * g[3]); o[64 * j] = w; }
        }
    }
    __syncthreads();
    const float* xin = rk == 2 ? p.out : p.x;
    for (int row = gw; row < M; row += NGW) {
        const f32x4* xr = (const f32x4*)(xin + (size_t)row * D) + lane;
        f32x4 v[4];
#pragma unroll
        for (int j = 0; j < 4; ++j) v[j] = xr[64 * j];
        if (rk >= 1) {
            const f32x4* orow = (const f32x4*)((const float*)(ws + WS_OUT) + (size_t)row * D) + lane; const f32x4* gr = (const f32x4*)(p.norm_post + (rk - 1) * D) + lane;
            f32x4 o[4]; float ss = 0.f;
#pragma unroll
            for (int j = 0; j < 4; ++j) { o[j] = orow[64 * j]; ss += o[j][0] * o[j][0] + o[j][1] * o[j][1] + o[j][2] * o[j][2] + o[j][3] * o[j][3]; }
            const float rstd = rsqrtf(wave_sum(ss) * (1.f / D) + EPS);
            f32x4* dst = (f32x4*)(p.out + (size_t)row * D) + lane;
#pragma unroll
            for (int j = 0; j < 4; ++j) { const f32x4 g = gr[64 * j]; v[j] = v[j] + o[j] * rstd * g; dst[64 * j] = v[j]; }
        }
        if (rk <= 1) {
            const f32x4* gr = (const f32x4*)(p.norm_pre + rk * D) + lane;
            float ss = 0.f;
#pragma unroll
            for (int j = 0; j < 4; ++j) ss += v[j][0] * v[j][0] + v[j][1] * v[j][1] + v[j][2] * v[j][2] + v[j][3] * v[j][3];
            const float rstd = rsqrtf(wave_sum(ss) * (1.f / D) + EPS);
            u32x2* o = (u32x2*)((bf16_t*)(ws + WS_H) + (size_t)row * D) + lane;
#pragma unroll
            for (int j = 0; j < 4; ++j) { const f32x4 g = gr[64 * j]; v[j] = v[j] * rstd * g; u32x2 w; w.x = cvt_pk_bf16(v[j][0], v[j][1]); w.y = cvt_pk_bf16(v[j][2], v[j][3]); o[64 * j] = w; }
            float* sm = (float*)(ws + WS_SM) + (size_t)row * 8;
            LAS float* red = (LAS float*)(lds + 8 * 8448 + 32768) + wave * 512;
#pragma unroll
            for (int jj = 0; jj < 8; ++jj) { float a = 0.f;
#pragma unroll
                for (int j = 0; j < 4; ++j) { const f32x4 w = *(const LAS f32x4*)(W8T + jj * 1024 + 256 * j + 4 * lane); a += v[j][0] * w[0] + v[j][1] * w[1] + v[j][2] * w[2] + v[j][3] * w[3]; }
                red[jj * 64 + lane] = a; }
            asm volatile("s_waitcnt lgkmcnt(0)" ::: "memory");
            { const f32x4 r0 = *(const LAS f32x4*)(red + lane * 8), r1 = *(const LAS f32x4*)(red + lane * 8 + 4);
              float a = (r0[0] + r0[1]) + (r0[2] + r0[3]) + (r1[0] + r1[1]) + (r1[2] + r1[3]);
              a += __shfl_xor(a, 1); a += __shfl_xor(a, 2); a += __shfl_xor(a, 4);
              if ((lane & 7) == 0) sm[lane >> 3] = a; }
            asm volatile("s_waitcnt lgkmcnt(0)" ::: "memory");
        }
    }
    __syncthreads();
}

__device__ __forceinline__ void delta_pre_unit(const Params& p, int l, int unit, LAS unsigned char* lds) {
    int tid_ = threadIdx.x; asm volatile("" : "+v"(tid_));
    const int tid = tid_, lane = tid & 63, wave = tid >> 6;
    const int h = unit & 3, gch = unit >> 2, c = gch & 31;
    const size_t row0 = (size_t)gch * 64;
    unsigned char* ws = p.ws;
    bf16_t* cols = (bf16_t*)(ws + WS_COLS);
    LAS float* Qf = (LAS float*)lds; LAS float* Kf = Qf + 64 * 129; LAS float* Vf = Kf + 64 * 129; LAS float* Lf = Vf + 64 * 129;
    LAS bf16_t* Qb = (LAS bf16_t*)(Lf + 64 * 68); LAS bf16_t* Kb = Qb + 64 * 136;
    LAS float* gcs = (LAS float*)(Kb + 64 * 136); LAS float* betas = gcs + 64; LAS float* facs = betas + 64;
    LAS bf16_t* Rw = (LAS bf16_t*)Lf;
    {
#pragma unroll
        for (int it = 0; it < 6; ++it) { const int pc = tid + 512 * it, r = pc / 48, rem = pc % 48, part = rem >> 4, cp = rem & 15;
            const u32x4 v = *(const u32x4*)(cols + (row0 + r) * NC + part * 512 + h * 128 + cp * 8);
            *(LAS u32x4*)(Rw + (r + 3) * 384 + part * 128 + cp * 8) = v; }
        if (tid < 144) { const int r = tid / 48, rem = tid % 48, part = rem >> 4, cp = rem & 15;
            u32x4 v = {0u, 0u, 0u, 0u};
            if (c > 0) v = *(const u32x4*)((const bf16_t*)(ws + WS_HALO) + ((size_t)(gch - 1) * 3 + r) * 1536 + part * 512 + h * 128 + cp * 8);
            *(LAS u32x4*)(Rw + r * 384 + part * 128 + cp * 8) = v; }
        if (wave == 6) {
            const float* sm = (const float*)(ws + WS_SM) + (row0 + lane) * 8;
            const float a = sm[4 + h] + p.dt_bias[l * 4 + h];
            const float sp = a > 20.f ? a : log1pf(__expf(a));
            float g = -__expf(p.a_log[l * 4 + h]) * sp;
#pragma unroll
            for (int o = 1; o < 64; o <<= 1) { const float t = __shfl_up(g, o); if (lane >= o) g += t; }
            gcs[lane] = g;
        } else if (wave == 7) {
            const float* sm = (const float*)(ws + WS_SM) + (row0 + lane) * 8;
            betas[lane] = sigmoid_f(sm[h]);
        }
    }
    __syncthreads();
    if (tid < 384) {
        const int part = tid >> 7, cc = tid & 127, col = part * 512 + h * 128 + cc;
        const float* cw = p.conv_w + (size_t)l * 4 * 1536 + col;
        const float w0 = cw[0], w1 = cw[1536], w2 = cw[2 * 1536], w3 = cw[3 * 1536];
        const LAS bf16_t* src = Rw + tid;
        float x3 = bf2f(src[0]), x2 = bf2f(src[384]), x1 = bf2f(src[2 * 384]);
        LAS float* dst = (part == 0 ? Qf : (part == 1 ? Kf : Vf)) + cc;
#pragma unroll 8
        for (int r = 0; r < 64; ++r) { const float x0 = bf2f(src[(r + 3) * 384]); const float y = w0 * x3 + w1 * x2 + w2 * x1 + w3 * x0; dst[r * 129] = silu_f(y); x3 = x2; x2 = x1; x1 = x0; }
    }
    __syncthreads();
    if (tid < 64) { facs[tid] = betas[tid]; facs[64 + tid] = betas[tid] * __expf(gcs[tid]); }
    {
        const int r = tid >> 3, sub = tid & 7; float sq = 0.f, sk = 0.f;
#pragma unroll
        for (int e = 0; e < 16; ++e) { const float a = Qf[r * 129 + sub * 16 + e]; sq += a * a; const float b = Kf[r * 129 + sub * 16 + e]; sk += b * b; }
        sq += __shfl_xor(sq, 1); sq += __shfl_xor(sq, 2); sq += __shfl_xor(sq, 4);
        sk += __shfl_xor(sk, 1); sk += __shfl_xor(sk, 2); sk += __shfl_xor(sk, 4);
        const float rq = rsqrtf(sq + EPS) * 0.08838834764831845f, rkk = rsqrtf(sk + EPS);
#pragma unroll
        for (int e = 0; e < 16; ++e) { const int o = sub * 16 + e; const float a = Qf[r * 129 + o] * rq; Qb[r * 136 + o] = (bf16_t)f2bf(a);
            const float b = Kf[r * 129 + o] * rkk; Kf[r * 129 + o] = b; Kb[r * 136 + o] = (bf16_t)f2bf(b); }
    }
    __syncthreads();
    LAS bf16_t* Al = (LAS bf16_t*)Qf;
    LAS bf16_t* Wl = Al + 64 * 72;
    {
        const int i = lane & 15, q = lane >> 4;
        for (int job = wave; job < 26; job += 8) {
            int kind, ct, st;
            if (job < 10) { kind = 0; ct = job >= 6 ? 3 : (job >= 3 ? 2 : (job >= 1 ? 1 : 0)); st = job - ct * (ct + 1) / 2; }
            else { kind = 1; ct = (job - 10) >> 2; st = (job - 10) & 3; }
            f32x4 acc = {0.f, 0.f, 0.f, 0.f};
            if (st <= ct) {
                const LAS bf16_t* Ab = kind == 0 ? Kb : Qb;
#pragma unroll
                for (int ks = 0; ks < 4; ++ks) { const bf16x8 a = *(const LAS bf16x8*)(Ab + (16 * ct + i) * 136 + 32 * ks + 8 * q); const bf16x8 b = *(const LAS bf16x8*)(Kb + (16 * st + i) * 136 + 32 * ks + 8 * q);
                    acc = MFMA16(a, b, acc); }
            }
            const int s = 16 * st + i; const float gs = gcs[s];
#pragma unroll
            for (int r = 0; r < 4; ++r) { const int cr = 16 * ct + 4 * q + r; const float e = __expf(fminf(gcs[cr] - gs, 0.f));
                if (kind == 0) Lf[cr * 68 + s] = (cr > s) ? acc[r] * betas[cr] * e : 0.f;
                else Al[cr * 72 + s] = (bf16_t)f2bf(cr >= s ? acc[r] * e : 0.f); }
        }
    }
    __syncthreads();
    if (tid < 256) {
        const int j = tid; const bool isv = j < 128; const int jj = j & 127;
        const LAS float* src = (isv ? Vf : Kf) + jj;
        const LAS float* fac = facs + (isv ? 0 : 64);
        float x[64];
#pragma unroll
        for (int i = 0; i < 64; ++i) {
            const int Lrow = __float_as_int(Lf[i * 68 + lane]);
            float sa[4] = {src[i * 129] * fac[i], 0.f, 0.f, 0.f};
#pragma unroll
            for (int jx = 0; jx < i; ++jx) sa[jx & 3] -= __int_as_float(__builtin_amdgcn_readlane(Lrow, jx)) * x[jx];
            x[i] = (sa[0] + sa[1]) + (sa[2] + sa[3]);
        }
        if (isv) { bf16_t* dst = cols + (row0 + (jj >> 1)) * NC + C_DNV + h * 128 + (jj & 1) * 64;
#pragma unroll
            for (int g8 = 0; g8 < 8; ++g8) { u32x4 w; w.x = cvt_pk_bf16(x[8 * g8], x[8 * g8 + 1]); w.y = cvt_pk_bf16(x[8 * g8 + 2], x[8 * g8 + 3]); w.z = cvt_pk_bf16(x[8 * g8 + 4], x[8 * g8 + 5]); w.w = cvt_pk_bf16(x[8 * g8 + 6], x[8 * g8 + 7]);
                *(u32x4*)(dst + 8 * g8) = w; }
        } else {
#pragma unroll
            for (int i = 0; i < 64; ++i) Wl[i * 136 + jj] = (bf16_t)f2bf(x[i]); }
    } else {
        const int t2 = tid - 256;
        { const int cr = t2 >> 2, d0 = (t2 & 3) * 32; const float e = __expf(gcs[cr]);
            bf16_t* dst = cols + (row0 + cr) * NC + C_DNQ + h * 128 + d0;
#pragma unroll
            for (int g4 = 0; g4 < 4; ++g4) { const u32x4 v = *(const LAS u32x4*)(Qb + cr * 136 + d0 + 8 * g4); u32x4 w;
                w.x = cvt_pk_bf16(lo_bf(v.x) * e, hi_bf(v.x) * e); w.y = cvt_pk_bf16(lo_bf(v.y) * e, hi_bf(v.y) * e); w.z = cvt_pk_bf16(lo_bf(v.z) * e, hi_bf(v.z) * e); w.w = cvt_pk_bf16(lo_bf(v.w) * e, hi_bf(v.w) * e);
                *(u32x4*)(dst + 8 * g4) = w; } }
        { const int dk = t2 & 127, c0 = (t2 >> 7) * 32; const float gl = gcs[63];
            bf16_t* dst = cols + (row0 + (dk >> 1)) * NC + C_DNK + h * 128 + (dk & 1) * 64 + c0;
#pragma unroll
            for (int g4 = 0; g4 < 4; ++g4) { float v[8];
#pragma unroll
                for (int e = 0; e < 8; ++e) { const int cr = c0 + 8 * g4 + e; v[e] = Kf[cr * 129 + dk] * __expf(gl - gcs[cr]); }
                u32x4 w; w.x = cvt_pk_bf16(v[0], v[1]); w.y = cvt_pk_bf16(v[2], v[3]); w.z = cvt_pk_bf16(v[4], v[5]); w.w = cvt_pk_bf16(v[6], v[7]);
                *(u32x4*)(dst + 8 * g4) = w; } }
        if (t2 == 0) ((float*)(ws + WS_DL))[unit] = __expf(gcs[63]);
    }
    __syncthreads();
    {
        unsigned char* wo = ws + WS_WA_W + (size_t)unit * 16384; unsigned char* ao = ws + WS_WA_A + (size_t)unit * 8192;
#pragma unroll
        for (int it = 0; it < 2; ++it) { const int pc = tid + 512 * it; *(u32x4*)(wo + pc * 16) = *(const LAS u32x4*)(Wl + (pc >> 4) * 136 + (pc & 15) * 8); }
        *(u32x4*)(ao + tid * 16) = *(const LAS u32x4*)(Al + (tid >> 3) * 72 + (tid & 7) * 8);
    }
    __syncthreads();
}

__device__ __forceinline__ void delta_scan_unit(const Params& p, int l, int bh, LAS unsigned char* lds) {
    int tid_ = threadIdx.x; asm volatile("" : "+v"(tid_));
    const int tid = tid_, lane = tid & 63, wave = tid >> 6, i = lane & 15, q = lane >> 4;
    const int b = bh >> 2, h = bh & 3;
    unsigned char* ws = p.ws;
    unsigned char* colsb = ws + WS_COLS;
    constexpr int BUFB = 62464, O_W = 0, O_QG = 17408, O_KD = 34816, O_A = 53248;
    LAS bf16_t* Ot = (LAS bf16_t*)(lds + 2 * BUFB);
    if (wave < 4) {
        f32x4 S[2][8];
#pragma unroll
        for (int s2 = 0; s2 < 2; ++s2)
#pragma unroll
            for (int t = 0; t < 8; ++t) S[s2][t] = (f32x4){0.f, 0.f, 0.f, 0.f};
        u32x2 uraw[2][4]; float dl;
#define SCAN_ULOAD(cidx, dstu, dstd) do { const int gch_ = b * 32 + (cidx); const size_t r0_ = (size_t)gch_ * 64; \
            _Pragma("unroll") for (int s2 = 0; s2 < 2; ++s2) { const int dv_ = 32 * wave + 16 * s2 + i; \
                const unsigned char* ub_ = colsb + ((r0_ + (dv_ >> 1)) * NC + C_DNV + h * 128 + (dv_ & 1) * 64 + 4 * q) * 2; \
                _Pragma("unroll") for (int mt = 0; mt < 4; ++mt) dstu[s2][mt] = *(const u32x2*)(ub_ + mt * 32); } \
            dstd = ((const float*)(ws + WS_DL))[gch_ * 4 + h]; } while (0)
#define SCAN_FRAG(f) ( (f) < 16 ? lds_ld2x8(buf + O_W + (16 * ((f) >> 2) + i) * 272 + (32 * ((f) & 3) + 4 * q) * 2) \
                     : (f) < 32 ? lds_ld2x8(buf + O_QG + (16 * (((f) - 16) >> 2) + i) * 272 + (32 * (((f) - 16) & 3) + 4 * q) * 2) \
                     : (f) < 38 ? lds_ld2x8(buf + O_A + (16 * ((f) == 32 ? 0 : (f) == 33 ? 1 : (f) <= 35 ? 2 : 3) + i) * 144 + (32 * (((f) == 35 || (f) == 37) ? 1 : 0) + 4 * q) * 2) \
                     : lds_ld2x8(buf + O_KD + (16 * (((f) - 38) >> 1) + i) * 144 + (32 * (((f) - 38) & 1) + 4 * q) * 2) )
        float dln;
        SCAN_ULOAD(0, uraw, dl);
        __syncthreads();
#pragma unroll 1
        for (int c = 0; c < 32; ++c) {
            const LAS unsigned char* buf = lds + (c & 1) * BUFB;
            bf16x8 Sb[2][4];
#pragma unroll
            for (int s2 = 0; s2 < 2; ++s2)
#pragma unroll
                for (int ks = 0; ks < 4; ++ks) Sb[s2][ks] = pack8(S[s2][2 * ks], S[s2][2 * ks + 1]);
            f32x4 aw[2][4], o[2][4];
            bf16x8 Vb[2][2];
            bf16x8 Fq[4];
            constexpr int DEPTH = 3;
            Fq[0] = SCAN_FRAG(0); Fq[1] = SCAN_FRAG(1); Fq[2] = SCAN_FRAG(2);
#define SCAN_STEP(f) { \
                if ((f) + DEPTH < 54) Fq[((f) + DEPTH) & 3] = SCAN_FRAG(((f) + DEPTH < 54 ? (f) + DEPTH : 53)); \
                const bf16x8 A = Fq[(f) & 3]; \
                if ((f) < 16) { constexpr int mt = ((f) >> 2) & 3, ks = (f) & 3; \
                    if (ks == 0) { aw[0][mt] = (f32x4){0.f, 0.f, 0.f, 0.f}; aw[1][mt] = (f32x4){0.f, 0.f, 0.f, 0.f}; } \
                    aw[0][mt] = MFMA16(A, Sb[0][ks], aw[0][mt]); aw[1][mt] = MFMA16(A, Sb[1][ks], aw[1][mt]); \
                } else if ((f) < 32) { constexpr int mt = (((f) - 16) >> 2) & 3, ks = (f) & 3; \
                    if (ks == 0) { o[0][mt] = (f32x4){0.f, 0.f, 0.f, 0.f}; o[1][mt] = (f32x4){0.f, 0.f, 0.f, 0.f}; } \
                    o[0][mt] = MFMA16(A, Sb[0][ks], o[0][mt]); o[1][mt] = MFMA16(A, Sb[1][ks], o[1][mt]); \
                } else if ((f) < 38) { constexpr int mt = (f) == 32 ? 0 : ((f) == 33 ? 1 : ((f) <= 35 ? 2 : 3)), k2 = ((f) == 35 || (f) == 37) ? 1 : 0; \
                    o[0][mt] = MFMA16(A, Vb[0][k2], o[0][mt]); o[1][mt] = MFMA16(A, Vb[1][k2], o[1][mt]); \
                } else { constexpr int t = (((f) - 38) >> 1) & 7, k2 = (f) & 1; \
                    if (k2 == 0) { S[0][t] = S[0][t] * dl; S[1][t] = S[1][t] * dl; } \
                    S[0][t] = MFMA16(A, Vb[0][k2], S[0][t]); S[1][t] = MFMA16(A, Vb[1][k2], S[1][t]); } \
                if ((f) == 19) { \
                    f32x4 vn[2][4]; \
                    _Pragma("unroll") for (int s2 = 0; s2 < 2; ++s2) \
                    _Pragma("unroll") for (int mt = 0; mt < 4; ++mt) vn[s2][mt] = (f32x4){lo_bf(uraw[s2][mt].x) - aw[s2][mt][0], hi_bf(uraw[s2][mt].x) - aw[s2][mt][1], lo_bf(uraw[s2][mt].y) - aw[s2][mt][2], hi_bf(uraw[s2][mt].y) - aw[s2][mt][3]}; \
                    _Pragma("unroll") for (int s2 = 0; s2 < 2; ++s2) { Vb[s2][0] = pack8(vn[s2][0], vn[s2][1]); Vb[s2][1] = pack8(vn[s2][2], vn[s2][3]); } \
                    if (c + 1 < 32) SCAN_ULOAD(c + 1, uraw, dln); \
                } \
                __builtin_amdgcn_sched_barrier(0); }
#define SCAN_STEP6(f) SCAN_STEP(f) SCAN_STEP((f) + 1) SCAN_STEP((f) + 2) SCAN_STEP((f) + 3) SCAN_STEP((f) + 4) SCAN_STEP((f) + 5)
            SCAN_STEP6(0) SCAN_STEP6(6) SCAN_STEP6(12) SCAN_STEP6(18) SCAN_STEP6(24) SCAN_STEP6(30) SCAN_STEP6(36) SCAN_STEP6(42) SCAN_STEP6(48)
#undef SCAN_STEP6
#undef SCAN_STEP
            __syncthreads();
#pragma unroll
            for (int s2 = 0; s2 < 2; ++s2)
#pragma unroll
                for (int mt = 0; mt < 4; ++mt)
#pragma unroll
                    for (int r = 0; r < 4; ++r) Ot[(16 * mt + 4 * q + r) * 136 + 32 * wave + 16 * s2 + i] = (bf16_t)f2bf(o[s2][mt][r]);
            __syncthreads();
            dl = dln;
        }
#undef SCAN_FRAG
#undef SCAN_ULOAD
        __syncthreads();
    } else {
        const int t2 = tid - 256, fr_ = t2 >> 2, fs_ = t2 & 3;
        float gn[32];
#pragma unroll
        for (int e = 0; e < 32; ++e) gn[e] = p.dn_norm[l * 128 + fs_ * 32 + e];
        u32x4 pre[14], zc[4], zn[4];
#define SCAN_LOAD(cidx) do { const int gch_ = b * 32 + (cidx); const size_t r0_ = (size_t)gch_ * 64; const int un2_ = gch_ * 4 + h; \
            const unsigned char* wsrc_ = ws + WS_WA_W + (size_t)un2_ * 16384; const unsigned char* asrc_ = ws + WS_WA_A + (size_t)un2_ * 8192; \
            _Pragma("unroll") for (int k = 0; k < 4; ++k) { const int pc_ = t2 + 256 * k; \
                pre[k] = *(const u32x4*)(wsrc_ + pc_ * 16); \
                pre[4 + k] = *(const u32x4*)(colsb + ((r0_ + (pc_ >> 4)) * NC + C_DNQ + h * 128) * 2 + (pc_ & 15) * 16); \
                pre[8 + k] = *(const u32x4*)(colsb + ((r0_ + (pc_ >> 4)) * NC + C_DNK + h * 128) * 2 + (pc_ & 15) * 16); } \
            pre[12] = *(const u32x4*)(asrc_ + t2 * 16); pre[13] = *(const u32x4*)(asrc_ + (t2 + 256) * 16); } while (0)
#define SCAN_ZLOAD(cidx, dst) do { const unsigned char* zb_ = colsb + (((size_t)(b * 32 + (cidx)) * 64 + fr_) * NC + C_DNZ + h * 128 + fs_ * 32) * 2; \
            _Pragma("unroll") for (int k = 0; k < 4; ++k) dst[k] = *(const u32x4*)(zb_ + 16 * k); } while (0)
#define SCAN_STORE(bufp) do { LAS unsigned char* b_ = (bufp); \
            _Pragma("unroll") for (int k = 0; k < 4; ++k) { const int pc_ = t2 + 256 * k; \
                *(LAS u32x4*)(b_ + O_W + (pc_ >> 4) * 272 + (pc_ & 15) * 16) = pre[k]; \
                *(LAS u32x4*)(b_ + O_QG + (pc_ >> 4) * 272 + (pc_ & 15) * 16) = pre[4 + k]; \
                *(LAS u32x4*)(b_ + O_KD + (pc_ >> 3) * 144 + (pc_ & 7) * 16) = pre[8 + k]; } \
            *(LAS u32x4*)(b_ + O_A + (t2 >> 3) * 144 + (t2 & 7) * 16) = pre[12]; *(LAS u32x4*)(b_ + O_A + ((t2 + 256) >> 3) * 144 + (t2 & 7) * 16) = pre[13]; } while (0)
#define SCAN_FINAL(cidx) do { \
            float ss_ = 0.f; u32x4 ov_[4]; \
            _Pragma("unroll") for (int k = 0; k < 4; ++k) { ov_[k] = *(const LAS u32x4*)(Ot + fr_ * 136 + fs_ * 32 + 8 * k); \
                ss_ += lo_bf(ov_[k].x) * lo_bf(ov_[k].x) + hi_bf(ov_[k].x) * hi_bf(ov_[k].x) + lo_bf(ov_[k].y) * lo_bf(ov_[k].y) + hi_bf(ov_[k].y) * hi_bf(ov_[k].y) \
                     + lo_bf(ov_[k].z) * lo_bf(ov_[k].z) + hi_bf(ov_[k].z) * hi_bf(ov_[k].z) + lo_bf(ov_[k].w) * lo_bf(ov_[k].w) + hi_bf(ov_[k].w) * hi_bf(ov_[k].w); } \
            ss_ += __shfl_xor(ss_, 1); ss_ += __shfl_xor(ss_, 2); \
            const float rstd_ = rsqrtf(ss_ * (1.f / 128.f) + EPS); \
            unsigned char* yb_ = colsb + (((size_t)(b * 32 + (cidx)) * 64 + fr_) * NC + C_DNZ + h * 128 + fs_ * 32) * 2; \
            _Pragma("unroll") for (int k = 0; k < 4; ++k) { u32x4 w_; \
                w_.x = cvt_pk_bf16(lo_bf(ov_[k].x) * rstd_ * gn[8 * k + 0] * lo_bf(zc[k].x), hi_bf(ov_[k].x) * rstd_ * gn[8 * k + 1] * hi_bf(zc[k].x)); \
                w_.y = cvt_pk_bf16(lo_bf(ov_[k].y) * rstd_ * gn[8 * k + 2] * lo_bf(zc[k].y), hi_bf(ov_[k].y) * rstd_ * gn[8 * k + 3] * hi_bf(zc[k].y)); \
                w_.z = cvt_pk_bf16(lo_bf(ov_[k].z) * rstd_ * gn[8 * k + 4] * lo_bf(zc[k].z), hi_bf(ov_[k].z) * rstd_ * gn[8 * k + 5] * hi_bf(zc[k].z)); \
                w_.w = cvt_pk_bf16(lo_bf(ov_[k].w) * rstd_ * gn[8 * k + 6] * lo_bf(zc[k].w), hi_bf(ov_[k].w) * rstd_ * gn[8 * k + 7] * hi_bf(zc[k].w)); \
                *(u32x4*)(yb_ + 16 * k) = w_; } } while (0)
        SCAN_LOAD(0); SCAN_STORE(lds);
        __syncthreads();
#pragma unroll 1
        for (int c = 0; c < 32; ++c) {
            if (c + 1 < 32) SCAN_LOAD(c + 1);
            SCAN_ZLOAD(c, zn);
            if (c > 0) SCAN_FINAL(c - 1);
            __syncthreads();
            if (c + 1 < 32) SCAN_STORE(lds + ((c + 1) & 1) * BUFB);
            __syncthreads();
#pragma unroll
            for (int k = 0; k < 4; ++k) zc[k] = zn[k];
        }
        SCAN_FINAL(31);
#undef SCAN_LOAD
#undef SCAN_ZLOAD
#undef SCAN_STORE
#undef SCAN_FINAL
        __syncthreads();
    }
}

__device__ __forceinline__ void gmlp_unit(const Params& p, int l, int unit, LAS unsigned char* lds) {
    int tid_ = threadIdx.x; asm volatile("" : "+v"(tid_));
    const int tid = tid_, lane = tid & 63, wave = tid >> 6, i = lane & 15, q = lane >> 4;
    const int g = unit & 3, bn = unit >> 2;
    const size_t row0 = (size_t)bn * 128;
    unsigned char* ws = p.ws;
    bf16_t* cols = (bf16_t*)(ws + WS_COLS);
    LAS float* rstd = (LAS float*)lds;
    LAS bf16_t* vT = (LAS bf16_t*)(lds + 512);
    {   u32x4 rv[16];
#pragma unroll
        for (int tt = 0; tt < 16; ++tt) rv[tt] = *(const u32x4*)(cols + (row0 + 16 * wave + tt) * NC + C_GMV + lane * 8);
#pragma unroll
        for (int tt = 0; tt < 16; ++tt) { const u32x4 v = rv[tt];
            float ss = lo_bf(v.x) * lo_bf(v.x) + hi_bf(v.x) * hi_bf(v.x) + lo_bf(v.y) * lo_bf(v.y) + hi_bf(v.y) * hi_bf(v.y) + lo_bf(v.z) * lo_bf(v.z) + hi_bf(v.z) * hi_bf(v.z) + lo_bf(v.w) * lo_bf(v.w) + hi_bf(v.w) * hi_bf(v.w);
            ss = wave_sum(ss); if (lane == 0) rstd[16 * wave + tt] = rsqrtf(ss * (1.f / 512.f) + EPS); } }
    __syncthreads();
#pragma unroll
    for (int it = 0; it < 4; ++it) { const int pc = tid + 512 * it, qrow = pc >> 4, cp = pc & 15;
        const u32x4 v = *(const u32x4*)(cols + (row0 + qrow) * NC + C_GMV + g * 128 + cp * 8);
        const float* gp = p.gm_norm + l * 512 + g * 128 + cp * 8; const float rs = rstd[qrow];
        const float f[8] = {lo_bf(v.x), hi_bf(v.x), lo_bf(v.y), hi_bf(v.y), lo_bf(v.z), hi_bf(v.z), lo_bf(v.w), hi_bf(v.w)};
#pragma unroll
        for (int e = 0; e < 8; ++e) vT[(cp * 8 + e) * 136 + qrow] = (bf16_t)f2bf(f[e] * rs * gp[e]); }
    __syncthreads();
    {
        const int pt = wave; const int nks = (pt >> 1) + 1;
        const bf16_t* spw = (const bf16_t*)(ws + WS_SPW) + (size_t)g * 16384 + (16 * pt + i) * 128 + 8 * q;
        bf16x8 Bf[4];
#pragma unroll
        for (int ks = 0; ks < 4; ++ks) Bf[ks] = *(const bf16x8*)(spw + 32 * ks);
        const float bias = p.spatial_b[l * 512 + g * 128 + 16 * pt + i];
        const size_t prow = row0 + 16 * pt + i;
        u32x2 uu8[8], zz8[8];
#pragma unroll
        for (int ct = 0; ct < 8; ++ct) { const int ch = g * 128 + 16 * ct + 4 * q; uu8[ct] = *(const u32x2*)(cols + prow * NC + C_GMU + ch); zz8[ct] = *(const u32x2*)(cols + prow * NC + C_GMZ + ch); }
#pragma unroll
        for (int ct = 0; ct < 8; ++ct) { f32x4 acc = {0.f, 0.f, 0.f, 0.f};
#pragma unroll
            for (int ks = 0; ks < 4; ++ks) if (ks < nks) acc = MFMA16(*(const LAS bf16x8*)(vT + (16 * ct + i) * 136 + 32 * ks + 8 * q), Bf[ks], acc);
            const int ch = g * 128 + 16 * ct + 4 * q;
            u32x2* up = (u32x2*)(cols + prow * NC + C_GMU + ch); const u32x2 uu = uu8[ct]; const u32x2 zz = zz8[ct];
            u32x2 w; w.x = cvt_pk_bf16(lo_bf(uu.x) * (acc[0] + bias) * lo_bf(zz.x), hi_bf(uu.x) * (acc[1] + bias) * hi_bf(zz.x));
            w.y = cvt_pk_bf16(lo_bf(uu.y) * (acc[2] + bias) * lo_bf(zz.y), hi_bf(uu.y) * (acc[3] + bias) * hi_bf(zz.y));
            *up = w; }
    }
    __syncthreads();
}

template <int HD, int NK, bool SWA>
__device__ __forceinline__ void attn_tile16(bf16_t* qp, const bf16_t* zp, const LAS bf16_t* Kl, const LAS bf16_t* VTl, int kp_lo, int kp_hi, float scale, float m0, float l0, int qi0, bool blk0, int lane) {
    const int i = lane & 15, q = lane >> 4;
    bf16x8 Qf[HD / 32];
#pragma unroll
    for (int kd = 0; kd < HD / 32; ++kd) Qf[kd] = *(const bf16x8*)(qp + (size_t)i * NC + 32 * kd + 8 * q);
    float m = m0, lsum = l0;
    f32x4 O[HD / 16];
#pragma unroll
    for (int dt = 0; dt < HD / 16; ++dt) O[dt] = (f32x4){0.f, 0.f, 0.f, 0.f};
    const int qi = qi0 + i;
    for (int kp = kp_lo; kp <= kp_hi; ++kp) {
        f32x4 s0 = {0.f, 0.f, 0.f, 0.f}, s1 = {0.f, 0.f, 0.f, 0.f};
#pragma unroll
        for (int kd = 0; kd < HD / 32; ++kd) {
            s0 = MFMA16(*(const LAS bf16x8*)(Kl + (32 * kp + i) * (HD + 8) + 32 * kd + 8 * q), Qf[kd], s0);
            s1 = MFMA16(*(const LAS bf16x8*)(Kl + (32 * kp + 16 + i) * (HD + 8) + 32 * kd + 8 * q), Qf[kd], s1);
        }
        float mx = -1e30f;
#pragma unroll
        for (int r = 0; r < 4; ++r) {
            float a = s0[r] * scale, b = s1[r] * scale;
            if (SWA) { const int k0 = 32 * kp + 4 * q + r, k1 = k0 + 16;
                if (!(k0 >= qi + 1 && k0 <= qi + 128 && (!blk0 || k0 >= 128))) a = -1e30f;
                if (!(k1 >= qi + 1 && k1 <= qi + 128 && (!blk0 || k1 >= 128))) b = -1e30f; }
            s0[r] = a; s1[r] = b; mx = fmaxf(mx, fmaxf(a, b));
        }
        mx = fmaxf(mx, __shfl_xor(mx, 16)); mx = fmaxf(mx, __shfl_xor(mx, 32));
        const float mn = fmaxf(m, mx), alpha = __expf(m - mn);
        float ps = 0.f;
#pragma unroll
        for (int r = 0; r < 4; ++r) { s0[r] = __expf(s0[r] - mn); s1[r] = __expf(s1[r] - mn); ps += s0[r] + s1[r]; }
        ps += __shfl_xor(ps, 16); ps += __shfl_xor(ps, 32);
        lsum = lsum * alpha + ps; m = mn;
        const bf16x8 Pb = pack8(s0, s1);
#pragma unroll
        for (int dt = 0; dt < HD / 16; ++dt) { O[dt] = O[dt] * alpha;
            O[dt] = MFMA16(lds_ld2x8((const LAS unsigned char*)(VTl + (16 * dt + i) * (NK + 8) + 32 * kp + 4 * q)), Pb, O[dt]); }
    }
    const float inv = 1.f / lsum;
#pragma unroll
    for (int dt = 0; dt < HD / 16; ++dt) { const int d = 16 * dt + 4 * q;
        const u32x2 zz = *(const u32x2*)(zp + (size_t)i * NC + d);
        u32x2 w; w.x = cvt_pk_bf16(O[dt][0] * inv * lo_bf(zz.x), O[dt][1] * inv * hi_bf(zz.x)); w.y = cvt_pk_bf16(O[dt][2] * inv * lo_bf(zz.y), O[dt][3] * inv * hi_bf(zz.y));
        *(u32x2*)(qp + (size_t)i * NC + d) = w; }
}

__device__ __forceinline__ void swa_unit(const Params& p, int l, int unit, LAS unsigned char* lds) {
    int tid_ = threadIdx.x; asm volatile("" : "+v"(tid_));
    const int tid = tid_, lane = tid & 63, wave = tid >> 6;
    const int kvh = unit & 1, bn = unit >> 1, n = bn & 15, b = bn >> 4;
    unsigned char* ws = p.ws; bf16_t* cols = (bf16_t*)(ws + WS_COLS);
    LAS bf16_t* Kl = (LAS bf16_t*)lds;
    LAS bf16_t* VTl = Kl + 256 * 72;
    const long krow0 = (long)b * T + (long)(n - 1) * 128;
#pragma unroll
    for (int it = 0; it < 4; ++it) { const int pc = tid + 512 * it, kj = pc >> 3, cp = pc & 7;
        u32x4 kv = {0u, 0u, 0u, 0u}, vv = {0u, 0u, 0u, 0u};
        if (n > 0 || kj >= 128) { const bf16_t* rp = cols + (size_t)(krow0 + kj) * NC; kv = *(const u32x4*)(rp + C_SWK + kvh * 64 + cp * 8); vv = *(const u32x4*)(rp + C_SWV + kvh * 64 + cp * 8); }
        *(LAS u32x4*)(Kl + kj * 72 + cp * 8) = kv;
        const unsigned vw[4] = {vv.x, vv.y, vv.z, vv.w};
#pragma unroll
        for (int e = 0; e < 4; ++e) { VTl[(cp * 8 + 2 * e) * 264 + kj] = (bf16_t)(vw[e] & 0xffffu); VTl[(cp * 8 + 2 * e + 1) * 264 + kj] = (bf16_t)(vw[e] >> 16); } }
    __syncthreads();
    {
        const int g = wave >> 1, hq = kvh * 4 + g;
        const float sink = p.sinks[l * 8 + hq];
        for (int qt = 0; qt < 4; ++qt) {
            const int qi0 = (wave & 1) * 64 + 16 * qt;
            const size_t qrow = (size_t)b * T + n * 128 + qi0;
            int kp_lo = (qi0 + 1) >> 5, kp_hi = (qi0 + 143) >> 5; if (kp_hi > 7) kp_hi = 7; if (n == 0 && kp_lo < 4) kp_lo = 4;
            attn_tile16<64, 256, true>(cols + qrow * NC + C_SWQ + hq * 64, cols + qrow * NC + C_SWZ + hq * 64, Kl, VTl, kp_lo, kp_hi, 0.125f, sink, 1.f, qi0, n == 0, lane);
        }
    }
    __syncthreads();
}

__device__ __forceinline__ void xmem_unit(const Params& p, int l, int unit, LAS unsigned char* lds) {
    int tid_ = threadIdx.x; asm volatile("" : "+v"(tid_));
    const int tid = tid_, lane = tid & 63, wave = tid >> 6;
    const int qb = unit & 7, hm = (unit >> 3) & 3, b = unit >> 5;
    unsigned char* ws = p.ws; bf16_t* cols = (bf16_t*)(ws + WS_COLS);
    const bf16_t* mkv = (const bf16_t*)(ws + WS_MEMKV) + (size_t)b * 256 * 1024;
    LAS bf16_t* Kl = (LAS bf16_t*)lds;
    LAS bf16_t* VTl = Kl + 256 * 136;
#pragma unroll
    for (int it = 0; it < 8; ++it) { const int pc = tid + 512 * it, kj = pc >> 4, cp = pc & 15;
        const bf16_t* rp = mkv + (size_t)kj * 1024 + hm * 128 + cp * 8;
        const u32x4 kv = *(const u32x4*)rp, vv = *(const u32x4*)(rp + 512);
        *(LAS u32x4*)(Kl + kj * 136 + cp * 8) = kv;
        const unsigned vw[4] = {vv.x, vv.y, vv.z, vv.w};
#pragma unroll
        for (int e = 0; e < 4; ++e) { VTl[(cp * 8 + 2 * e) * 264 + kj] = (bf16_t)(vw[e] & 0xffffu); VTl[(cp * 8 + 2 * e + 1) * 264 + kj] = (bf16_t)(vw[e] >> 16); } }
    __syncthreads();
    for (int qt = 0; qt < 2; ++qt) {
        const size_t qrow = (size_t)b * T + qb * 256 + 32 * wave + 16 * qt;
        attn_tile16<128, 256, false>(cols + qrow * NC + C_XMQ + hm * 128, cols + qrow * NC + C_XMZ + hm * 128, Kl, VTl, 0, 7, 0.08838834764831845f, -1e30f, 0.f, 0, false, lane);
    }
    __syncthreads();
}

#define XB_TMO      128
#define XB_XCNT(j)  (256  + 64 * (j))
#define XB_XSUB(j)  (1280 + 64 * (j))
#define XB_XGEN(j)  (2304 + 64 * (j))
#define XB_TOP      3328
#define XB_TOPGEN   3392
#define XCD_BAR_WORDS 3456
#define XB_SPIN_CAP (1u << 18)

__device__ __forceinline__ unsigned xb_ld(unsigned* p)              { return __hip_atomic_load(p, __ATOMIC_RELAXED, __HIP_MEMORY_SCOPE_AGENT); }
__device__ __forceinline__ unsigned xb_add(unsigned* p, unsigned v) { return __hip_atomic_fetch_add(p, v, __ATOMIC_RELAXED, __HIP_MEMORY_SCOPE_AGENT); }
__device__ __forceinline__ unsigned xb_xcc_id() { return (unsigned)__builtin_amdgcn_s_getreg((3 << 11) | 20) & 0xFu; }
#define XB_SPIN(cond, bar) do { unsigned _sp = 0; while (cond) { __builtin_amdgcn_s_sleep(1); \
    if ((++_sp & 255u) == 0u) { if (xb_ld(&(bar)[XB_TMO])) break; if (_sp > XB_SPIN_CAP) { atomicAdd(&(bar)[XB_TMO], 1u); break; } } } } while (0)

struct XcdBarrier {
    unsigned* bar; unsigned x;
    volatile LAS unsigned* st;
};

__device__ __forceinline__ XcdBarrier xcd_barrier_post(unsigned* bar, volatile LAS unsigned* st) {
    XcdBarrier b; b.bar = bar; b.x = xb_xcc_id(); b.st = st;
    if (threadIdx.x == 0) (void)xb_add(&bar[XB_XCNT(b.x)], 1u);
    return b;
}
__device__ __forceinline__ void xcd_barrier_complete(unsigned* bar, unsigned x, unsigned& nloc, unsigned& nx) {
    const unsigned G = gridDim.x * gridDim.y * gridDim.z;
    unsigned sum, cnt, mine, sp = 0u;
    for (;;) {
        sum = 0u; cnt = 0u; mine = 0u;
#pragma unroll
        for (unsigned j = 0; j < 16; ++j) { const unsigned c = xb_ld(&bar[XB_XCNT(j)]); sum += c; cnt += (c > 0u) ? 1u : 0u; mine = (j == x) ? c : mine; }
        if (sum == G) break;
        __builtin_amdgcn_s_sleep(1);
        if ((++sp & 255u) == 0u) { if (xb_ld(&bar[XB_TMO])) break; if (sp > XB_SPIN_CAP) { atomicAdd(&bar[XB_TMO], 1u); break; } }
    }
    nloc = mine > 0u ? mine : 1u; nx = cnt > 0u ? cnt : 1u;
}

__device__ __forceinline__ void xcd_barrier(const XcdBarrier& b) {
    asm volatile("s_waitcnt vmcnt(0)" ::: "memory");
    __syncthreads();
    if (threadIdx.x == 0) {
        unsigned* bar = b.bar;
        __builtin_amdgcn_s_waitcnt(0);
        unsigned nloc = b.st[0], nx = b.st[1];
        if (nloc == 0u) { xcd_barrier_complete(bar, b.x, nloc, nx); b.st[0] = nloc; b.st[1] = nx; }
        const unsigned old = xb_add(&bar[XB_XSUB(b.x)], 1u);
        const unsigned gen = old / nloc;
        if (old + 1u == (gen + 1u) * nloc) {
            __builtin_amdgcn_fence(__ATOMIC_RELEASE, "agent");
            asm volatile("s_waitcnt vmcnt(0)" ::: "memory");
            const unsigned og = xb_add(&bar[XB_TOP], 1u);
            const unsigned tg = og / nx;
            if (og + 1u == (tg + 1u) * nx) xb_add(&bar[XB_TOPGEN], 1u);
            else XB_SPIN(xb_ld(&bar[XB_TOPGEN]) == tg, bar);
            __builtin_amdgcn_fence(__ATOMIC_ACQUIRE, "agent");
            xb_add(&bar[XB_XGEN(b.x)], 1u);
            asm volatile("s_waitcnt vmcnt(0)" ::: "memory");
        } else {
            XB_SPIN(xb_ld(&bar[XB_XGEN(b.x)]) == gen, bar);
            __builtin_amdgcn_fence(__ATOMIC_ACQUIRE, "agent");
            asm volatile("s_waitcnt vmcnt(0)" ::: "memory");
        }
    }
    __syncthreads();
}


__global__ void __launch_bounds__(512) mega_fwd(Params p) {
    extern __shared__ __attribute__((aligned(16))) unsigned char lds_raw[];
    LAS unsigned char* lds = (LAS unsigned char*)lds_raw;
    cg::grid_group grid = cg::this_grid();
    const int G = gridDim.x, bx = blockIdx.x;
    const int vcu = (G % 8 == 0) ? (bx % 8) * (G / 8) + bx / 8 : bx;
    const Epi E{p.ws};
    unsigned* barw = (unsigned*)p.ws + 4096;
    volatile LAS unsigned* bst = (volatile LAS unsigned*)(lds + LDS_BYTES - 16);
    if (threadIdx.x == 0) { bst[0] = 0u; bst[1] = 0u; }
    if (bx == 0) for (int e = threadIdx.x; e < XCD_BAR_WORDS; e += 512) barw[e] = 0u;
    XcdBarrier bar; bar.bar = barw; bar.x = 0; bar.st = bst;
#define GRID_BAR() xcd_barrier(bar)
#pragma unroll 1
    for (int l = 0; l < 2; ++l) {
        p0_stage(p, l, lds);
        if (l == 0) { grid.sync(); bar = xcd_barrier_post(barw, bst); }
        else GRID_BAR();
#ifndef PROBE_REP
#define PROBE_REP 0
#endif
        for (int rep = 0; rep < ((PROBE_REP == 1 || PROBE_REP == 2) ? 2 : 1); ++rep) {
        { SchedA S{p.ws, G, bx}; pg8::gemm_phase<Epi, SchedA>(lds, S, E); }
        GRID_BAR();
        if (PROBE_REP == 1 && rep == 0) continue;
        for (int u = bx; u < 1024; u += G) delta_pre_unit(p, l, u, lds);
        GRID_BAR();
        if (G >= 64) {
            if (bx < 32) delta_scan_unit(p, l, bx, lds);
            else for (int u = bx - 32; u < 1024; u += G - 32) { if (u < 256) swa_unit(p, l, u, lds); else if (u < 512) xmem_unit(p, l, u - 256, lds); else gmlp_unit(p, l, u - 512, lds); }
        } else {
            for (int u = bx; u < 32 + 1024; u += G) { if (u < 32) delta_scan_unit(p, l, u, lds); else if (u < 288) swa_unit(p, l, u - 32, lds); else if (u < 544) xmem_unit(p, l, u - 288, lds); else gmlp_unit(p, l, u - 544, lds); }
        }
        GRID_BAR();
        }
        for (int rep = 0; rep < ((PROBE_REP == 3 || PROBE_REP == 4) ? 2 : 1); ++rep) {
        { SchedD S{p.ws, G, vcu}; pg8::gemm_phase<Epi, SchedD>(lds, S, E); }
        GRID_BAR();
        if (PROBE_REP == 3 && rep == 0) continue;
        { SchedE S{p.ws, G, vcu}; pg8::gemm_phase<Epi, SchedE>(lds, S, E); }
        GRID_BAR();
        }
    }
    p0_stage(p, 2, lds);
}

extern "C" void kernel_launch(void* const* d_in, const int* in_sizes, int n_in, void* d_out, int out_size, void* d_ws, size_t ws_size, hipStream_t stream) {
    static int grid = 0;
    if (grid == 0) {
        if (n_in != 17 || out_size != M * D || ws_size < WS_END) { fprintf(stderr, "kernel_launch: unexpected shapes / workspace (%d inputs, out %d, ws %zu)\n", n_in, out_size, ws_size); grid = -1; return; }
        int dev = 0, cus = 0, per_cu = 0;
        hipGetDevice(&dev);
        hipDeviceGetAttribute(&cus, hipDeviceAttributeMultiprocessorCount, dev);
        hipFuncSetAttribute((const void*)mega_fwd, hipFuncAttributeMaxDynamicSharedMemorySize, LDS_BYTES);
        hipOccupancyMaxActiveBlocksPerMultiprocessor(&per_cu, (const void*)mega_fwd, 512, LDS_BYTES);
        if (per_cu < 1) { fprintf(stderr, "kernel_launch: occupancy query reports %d blocks per CU\n", per_cu); (void)hipGetLastError(); per_cu = 1; }
        grid = cus * 1;
    }
    if (grid < 0) return;
    Params p{};
    p.x = (const float*)d_in[0]; p.mem = (const float*)d_in[1]; p.norm_pre = (const float*)d_in[2]; p.norm_post = (const float*)d_in[3]; p.norm_mem = (const float*)d_in[4];
    p.w_in = (const float*)d_in[5]; p.conv_w = (const float*)d_in[6]; p.a_log = (const float*)d_in[7]; p.dt_bias = (const float*)d_in[8]; p.dn_norm = (const float*)d_in[9];
    p.gm_norm = (const float*)d_in[10]; p.spatial_w = (const float*)d_in[11]; p.spatial_b = (const float*)d_in[12]; p.sinks = (const float*)d_in[13];
    p.w_mem_kv = (const float*)d_in[14]; p.w_up = (const float*)d_in[15]; p.w_out = (const float*)d_in[16];
    p.out = (float*)d_out; p.ws = (unsigned char*)d_ws;
    void* args[] = {&p};
    hipError_t e = hipLaunchCooperativeKernel((const void*)mega_fwd, dim3(grid), dim3(512), args, LDS_BYTES, stream);
    if (e != hipSuccess) fprintf(stderr, "cooperative launch failed: %s (grid %d)\n", hipGetErrorString(e), grid);
}
```

```cpp
#include <hip/hip_runtime.h>
#include <hip/hip_cooperative_groups.h>
#include <cstdio>
#include <cstdint>
namespace cg = cooperative_groups;

#define LAS __attribute__((address_space(3)))
typedef unsigned short bf16_t;
typedef short bf16x8 __attribute__((ext_vector_type(8)));
typedef float f32x4 __attribute__((ext_vector_type(4)));
typedef unsigned u32x4 __attribute__((ext_vector_type(4)));
typedef unsigned u32x2 __attribute__((ext_vector_type(2)));

constexpr int NB = 8, T = 2048, M = NB * T, D = 1024, NC = 5888, DIN = 9992;
constexpr int C_DNQ = 0, C_DNK = 512, C_DNV = 1024, C_DNZ = 1536, C_GMU = 2048, C_GMV = 2560, C_GMZ = 3072, C_SWQ = 3584, C_SWK = 4096, C_SWV = 4224,
              C_SWZ = 4352, C_XMQ = 4864, C_XMZ = 5376;
constexpr float EPS = 1e-6f;
constexpr size_t MiB = 1u << 20;
constexpr size_t WS_WINT = 1 * MiB, WS_WGT = WS_WINT + 12058624, WS_WUPT = WS_WGT + 8 * MiB, WS_WOUTT = WS_WUPT + 4 * MiB, WS_WMKVT = WS_WOUTT + 2 * MiB,
                 WS_SPW = WS_WMKVT + 2 * MiB;
constexpr size_t WS_H = 29 * MiB, WS_COLS = 61 * MiB, WS_OUT = WS_COLS, WS_X = 245 * MiB;
constexpr size_t WS_WA_W = WS_X, WS_WA_A = WS_X + 16 * MiB, WS_HALO = WS_X + 24 * MiB, WS_SM = WS_X + 27 * MiB, WS_DL = WS_SM + 512 * 1024,
                 WS_MEMN = WS_X + 28 * MiB, WS_MEMKV = WS_X + 32 * MiB, WS_GSCR = WS_X, WS_MERGED = WS_X + 32 * MiB, WS_END = 309 * MiB;
constexpr int LDS_BYTES = 155648;

struct Params {
    const float *x, *mem, *norm_pre, *norm_post, *norm_mem, *w_in, *conv_w, *a_log, *dt_bias, *dn_norm, *gm_norm, *spatial_w, *spatial_b, *sinks, *w_mem_kv,
        *w_up, *w_out;
    float* out;
    unsigned char* ws;
};

__device__ __forceinline__ float bf2f(unsigned b) { return __uint_as_float(b << 16); }
typedef float f32x2_t __attribute__((ext_vector_type(2)));
typedef __bf16 bf16x2_t __attribute__((ext_vector_type(2)));
__device__ __forceinline__ unsigned cvt_pk_bf16(float lo, float hi) { const f32x2_t v = {lo, hi}; return __builtin_bit_cast(unsigned, __builtin_convertvector(v, bf16x2_t)); }
__device__ __forceinline__ unsigned f2bf(float f) { return cvt_pk_bf16(f, 0.f) & 0xffffu; }
__device__ __forceinline__ float lo_bf(unsigned w) { return __uint_as_float(w << 16); }
__device__ __forceinline__ float hi_bf(unsigned w) { return __uint_as_float(w & 0xffff0000u); }
__device__ __forceinline__ float wave_sum(float v) {
#pragma unroll
    for (int o = 1; o < 64; o <<= 1) v += __shfl_xor(v, o);
    return v;
}
__device__ __forceinline__ float silu_f(float y) { return y * __builtin_amdgcn_rcpf(1.f + __expf(-y)); }
__device__ __forceinline__ float sigmoid_f(float y) { return __builtin_amdgcn_rcpf(1.f + __expf(-y)); }
__device__ __forceinline__ float gelu_tanh_f(float x) {
    const float u = 0.7978845608f * (x + 0.044715f * x * x * x);
    return x * __builtin_amdgcn_rcpf(1.f + __expf(-2.f * u));
}
__device__ __forceinline__ float silu_fast(float y) { return y * __builtin_amdgcn_rcpf(1.f + __expf(-y)); }
__device__ __forceinline__ float sigmoid_fast(float y) { return __builtin_amdgcn_rcpf(1.f + __expf(-y)); }
__device__ __forceinline__ float gelu_fast(float x) { const float u = 0.7978845608f * (x + 0.044715f * x * x * x); return x * __builtin_amdgcn_rcpf(1.f + __expf(-2.f * u)); }
__device__ __forceinline__ bf16x8 pack8(const f32x4 a, const f32x4 b) {
    u32x4 w; w.x = cvt_pk_bf16(a[0], a[1]); w.y = cvt_pk_bf16(a[2], a[3]); w.z = cvt_pk_bf16(b[0], b[1]); w.w = cvt_pk_bf16(b[2], b[3]);
    return __builtin_bit_cast(bf16x8, w);
}
__device__ __forceinline__ bf16x8 lds_ld2x8(const LAS unsigned char* pl) {
    const u32x2 lo = *(const LAS u32x2*)pl, hi = *(const LAS u32x2*)(pl + 32);
    u32x4 w; w.x = lo.x; w.y = lo.y; w.z = hi.x; w.w = hi.y; return __builtin_bit_cast(bf16x8, w);
}
#define LDS_BAR() asm volatile("s_waitcnt lgkmcnt(0)\n\ts_barrier" ::: "memory")
__device__ __forceinline__ int kperm32(int o) { return (o < 16) ? (8 * (o >> 2) + (o & 3)) : (8 * ((o - 16) >> 2) + 4 + (o & 3)); }
#define MFMA16(a, b, c) __builtin_amdgcn_mfma_f32_16x16x32_bf16((a), (b), (c), 0, 0, 0)

namespace pg8 {
constexpr int BM = 256, BK = 64, HALF = 128, HTB = HALF * BK * 2, STAGE_BYTES = 8 * HTB;
__device__ __forceinline__ int lds_byte(int r, int c) { const int st = (r >> 4) * 2 + (c >> 5), rr = r & 15, cc = c & 31, ob = rr * 64 + cc * 2; return st * 1024 + (ob ^ (((ob >> 9) & 1) << 5)); }
__device__ __forceinline__ void stage_rc(int b, int& R, int& C) { const int st = b / 1024, sb = b % 1024, swz = sb ^ (((sb >> 9) & 1) << 5); R = (st >> 1) * 16 + swz / 64; C = (st & 1) * 32 + (swz % 64) / 2; }
__device__ __forceinline__ int perm32(int rho) { const int n = rho >> 4, i = rho & 15; return 8 * (i >> 2) + 4 * n + (i & 3); }

struct Unit { const char* a; const char* b; unsigned lda, ldb; int nt; int pm, pn, kind, sub; };

__device__ __forceinline__ void mkoff(const Unit& u, int tid, unsigned (&vA)[2], unsigned (&vB)[2]) {
#pragma unroll
    for (int i = 0; i < 2; ++i) { int R, C; stage_rc(tid * 16 + i * 8192, R, C); const int Rb = (R & ~31) + perm32(R & 31);
        vA[i] = (unsigned)(R * u.lda + C) * 2u; vB[i] = (unsigned)(Rb * u.ldb + C) * 2u; }
}

template <class Epi, class Sched>
__device__ __forceinline__ void gemm_phase(LAS unsigned char* lds, const Sched& S, const Epi& E) {
    int tid_ = threadIdx.x; asm volatile("" : "+v"(tid_));
    const int tid = tid_, wid = __builtin_amdgcn_readfirstlane(tid >> 6), lane = tid & 63, wr = wid >> 2, wc = wid & 3, fr = lane & 15, fq = lane >> 4;
    const size_t kstep = (size_t)(BK * 2);
    const unsigned ldsw = (unsigned)wid * 1024u;
    const int aoff = lds_byte(wr * 64 + fr, fq * 8), boff = lds_byte(wc * 32 + fr, fq * 8);
#define PG8_SA(b, h) (((b) * 2 + (h)) * HTB)
#define PG8_SB(b, h) ((4 + (b) * 2 + (h)) * HTB)
#define PG8_STAGE(bufoff, gbase, voff) do { _Pragma("unroll") for (int _i = 0; _i < 2; ++_i) \
        __builtin_amdgcn_global_load_lds((const unsigned*)((const char*)(gbase) + (voff)[_i]), (LAS unsigned*)(lds + (bufoff) + ldsw + _i * 8192), 16, 0, 0); } while (0)
#define PG8_LDA(dst, b, h) do { _Pragma("unroll") for (int m = 0; m < 4; ++m) _Pragma("unroll") for (int k = 0; k < 2; ++k) dst[m][k] = *(const LAS bf16x8*)(lds + PG8_SA(b, h) + aoff + m * 2048 + k * 1024); } while (0)
#define PG8_LDB(dst, b, h) do { _Pragma("unroll") for (int n = 0; n < 2; ++n) _Pragma("unroll") for (int k = 0; k < 2; ++k) dst[n][k] = *(const LAS bf16x8*)(lds + PG8_SB(b, h) + boff + n * 2048 + k * 1024); } while (0)
#define PG8_MMA(ai, bj, At, Bt) do { __builtin_amdgcn_s_setprio(1); _Pragma("unroll") for (int m = 0; m < 4; ++m) _Pragma("unroll") for (int n = 0; n < 2; ++n) _Pragma("unroll") for (int k = 0; k < 2; ++k) \
        acc[ai][bj][m][n] = __builtin_amdgcn_mfma_f32_16x16x32_bf16(Bt[n][k], At[m][k], acc[ai][bj][m][n], 0, 0, 0); __builtin_amdgcn_s_setprio(0); } while (0)
#define PG8_WAIT_V(n) asm volatile("s_waitcnt vmcnt(" #n ")" ::: "memory")
#define PG8_WAIT_L(n) asm volatile("s_waitcnt lgkmcnt(" #n ")" ::: "memory")
#define PG8_BAR __builtin_amdgcn_s_barrier()
#define PG8_SCHED __builtin_amdgcn_sched_barrier(0)
    Unit cur, nxt; int ui = 0;
    if (!S.next(0, cur)) return;
    f32x4 acc[2][2][4][2];
#pragma unroll
    for (int a = 0; a < 2; ++a)
#pragma unroll
        for (int b = 0; b < 2; ++b)
#pragma unroll
            for (int m = 0; m < 4; ++m)
#pragma unroll
                for (int n = 0; n < 2; ++n) acc[a][b][m][n] = (f32x4){0.f, 0.f, 0.f, 0.f};
    bf16x8 At[4][2], B0[2][2], B1[2][2];
    unsigned vAc[2], vBc[2], vAn[2], vBn[2];
    mkoff(cur, tid, vAc, vBc);
    const char* cA = cur.a; const char* cB = cur.b;
    size_t hAc = (size_t)HALF * cur.lda * 2, hBc = (size_t)HALF * cur.ldb * 2;
    PG8_STAGE(PG8_SB(0, 0), cB, vBc); PG8_STAGE(PG8_SB(0, 1), cB + hBc, vBc); PG8_STAGE(PG8_SA(0, 0), cA, vAc); PG8_STAGE(PG8_SA(0, 1), cA + hAc, vAc);
    if (wr == 1) PG8_BAR;
    PG8_WAIT_V(2); PG8_BAR;
    PG8_STAGE(PG8_SB(1, 0), cB + kstep, vBc); PG8_STAGE(PG8_SA(1, 0), cA + kstep, vAc); PG8_STAGE(PG8_SB(1, 1), cB + hBc + kstep, vBc);
    PG8_WAIT_V(6); PG8_BAR;
    for (;;) {
        const bool has_next = S.next(ui + 1, nxt);
        const char* nA = cA; const char* nB = cB; size_t hAn = hAc, hBn = hBc;
        vAn[0] = vAc[0]; vAn[1] = vAc[1]; vBn[0] = vBc[0]; vBn[1] = vBc[1];
        if (has_next) { nA = nxt.a; nB = nxt.b; mkoff(nxt, tid, vAn, vBn); hAn = (size_t)HALF * nxt.lda * 2; hBn = (size_t)HALF * nxt.ldb * 2; }
        const int nt = cur.nt;
        for (int t = 0; t < nt; t += 2) {
            const bool last = (t == nt - 2);
            const char* a1 = cA + (size_t)(t + 1) * kstep;
            const char* a2 = last ? nA : cA + (size_t)(t + 2) * kstep; const char* b2 = last ? nB : cB + (size_t)(t + 2) * kstep;
            const char* a3 = a2 + kstep; const char* b3 = b2 + kstep;
            unsigned vA2[2], vB2[2];
            vA2[0] = last ? vAn[0] : vAc[0]; vA2[1] = last ? vAn[1] : vAc[1]; vB2[0] = last ? vBn[0] : vBc[0]; vB2[1] = last ? vBn[1] : vBc[1];
            const size_t hA2 = last ? hAn : hAc, hB2 = last ? hBn : hBc;
            PG8_LDB(B0, 0, 0); PG8_LDB(B1, 0, 1); PG8_SCHED; PG8_LDA(At, 0, 0); PG8_STAGE(PG8_SA(1, 1), a1 + hAc, vAc);
            PG8_WAIT_V(8); PG8_WAIT_L(0); PG8_BAR; PG8_MMA(0, 0, At, B0); PG8_MMA(0, 1, At, B1); PG8_BAR; PG8_SCHED;
            PG8_LDA(At, 0, 1); PG8_STAGE(PG8_SB(0, 0), b2, vB2); PG8_STAGE(PG8_SB(0, 1), b2 + hB2, vB2); PG8_STAGE(PG8_SA(0, 0), a2, vA2);
            PG8_WAIT_V(8); PG8_WAIT_L(0); PG8_BAR; PG8_MMA(1, 0, At, B0); PG8_MMA(1, 1, At, B1); PG8_BAR; PG8_SCHED;
            PG8_LDB(B0, 1, 0); PG8_LDB(B1, 1, 1); PG8_SCHED; PG8_LDA(At, 1, 0); PG8_STAGE(PG8_SA(0, 1), a2 + hA2, vA2);
            PG8_WAIT_V(8); PG8_WAIT_L(0); PG8_BAR; PG8_MMA(0, 0, At, B0); PG8_MMA(0, 1, At, B1); PG8_BAR; PG8_SCHED;
            PG8_LDA(At, 1, 1); PG8_STAGE(PG8_SB(1, 0), b3, vB2); PG8_STAGE(PG8_SB(1, 1), b3 + hB2, vB2); PG8_STAGE(PG8_SA(1, 0), a3, vA2);
            PG8_WAIT_V(8); PG8_WAIT_L(0); PG8_BAR; PG8_MMA(1, 0, At, B0); PG8_MMA(1, 1, At, B1); PG8_BAR; PG8_SCHED;
        }
        if (wr == 0) PG8_BAR;
        E(acc, cur, wr, wc, fr, fq, tid);
        if (!has_next) break;
#pragma unroll
        for (int a = 0; a < 2; ++a)
#pragma unroll
            for (int b = 0; b < 2; ++b)
#pragma unroll
                for (int m = 0; m < 4; ++m)
#pragma unroll
                    for (int n = 0; n < 2; ++n) acc[a][b][m][n] = (f32x4){0.f, 0.f, 0.f, 0.f};
        cur = nxt; cA = nA; cB = nB; hAc = hAn; hBc = hBn; vAc[0] = vAn[0]; vAc[1] = vAn[1]; vBc[0] = vBn[0]; vBc[1] = vBn[1]; ++ui;
        if (wr == 1) PG8_BAR;
    }
    PG8_WAIT_V(0);
    PG8_BAR;
#undef PG8_SA
#undef PG8_SB
#undef PG8_STAGE
#undef PG8_LDA
#undef PG8_LDB
#undef PG8_MMA
#undef PG8_WAIT_V
#undef PG8_WAIT_L
#undef PG8_BAR
#undef PG8_SCHED
}
}
using pg8::Unit;

struct Epi {
    unsigned char* ws;
    __device__ __forceinline__ void operator()(const f32x4 (&acc)[2][2][4][2], const Unit& u, int wr, int wc, int fr, int fq, int tid) const {
        asm volatile("" : "+v"(tid), "+v"(fr), "+v"(fq));
        const int row0 = u.pm * 256 + wr * 64 + fr, col0 = u.pn * 256 + wc * 32 + 8 * fq;
        if (u.kind == 0) {
            bf16_t* cols = (bf16_t*)(ws + WS_COLS); bf16_t* halo = (bf16_t*)(ws + WS_HALO);
            const int pn = u.pn;
            const int act = (pn == 6 || pn == 7 || pn == 12 || pn == 13 || pn == 17 || pn == 18 || pn >= 21) ? 1 : ((pn >= 8 && pn <= 11) ? 2 : 0);
#pragma unroll
            for (int ai = 0; ai < 2; ++ai)
#pragma unroll
                for (int m = 0; m < 4; ++m) {
                    const int r = row0 + ai * 128 + m * 16;
                    bf16_t* rowp = cols + (size_t)r * NC + col0;
#pragma unroll
                    for (int bj = 0; bj < 2; ++bj) {
                        f32x4 v0 = acc[ai][bj][m][0], v1 = acc[ai][bj][m][1];
                        if (act == 1) {
#pragma unroll
                            for (int e = 0; e < 4; ++e) { v0[e] = silu_fast(v0[e]); v1[e] = silu_fast(v1[e]); }
                        } else if (act == 2) {
#pragma unroll
                            for (int e = 0; e < 4; ++e) { v0[e] = gelu_fast(v0[e]); v1[e] = gelu_fast(v1[e]); }
                        }
                        u32x4 w; w.x = cvt_pk_bf16(v0[0], v0[1]); w.y = cvt_pk_bf16(v0[2], v0[3]); w.z = cvt_pk_bf16(v1[0], v1[1]); w.w = cvt_pk_bf16(v1[2], v1[3]);
                        *(u32x4*)(rowp + bj * 128) = w;
                        if (pn < 6 && (r & 63) >= 61) *(u32x4*)(halo + ((size_t)(r >> 6) * 3 + ((r & 63) - 61)) * 1536 + col0 + bj * 128) = w;
                    }
                }
        } else if (u.kind == 1) {
            bf16_t* o = (bf16_t*)(ws + WS_MEMKV);
#pragma unroll
            for (int ai = 0; ai < 2; ++ai)
#pragma unroll
                for (int m = 0; m < 4; ++m) {
                    bf16_t* rowp = o + (size_t)(row0 + ai * 128 + m * 16) * 1024 + col0;
#pragma unroll
                    for (int bj = 0; bj < 2; ++bj) {
                        const f32x4 v0 = acc[ai][bj][m][0], v1 = acc[ai][bj][m][1];
                        u32x4 w; w.x = cvt_pk_bf16(v0[0], v0[1]); w.y = cvt_pk_bf16(v0[2], v0[3]); w.z = cvt_pk_bf16(v1[0], v1[1]); w.w = cvt_pk_bf16(v1[2], v1[3]);
                        *(u32x4*)(rowp + bj * 128) = w;
                    }
                }
        } else if (u.kind == 2) {
            u32x4* g = (u32x4*)(ws + WS_GSCR) + (size_t)(u.pm * 4 + u.pn) * 16 * 512 + tid;
#pragma unroll
            for (int ai = 0; ai < 2; ++ai)
#pragma unroll
                for (int m = 0; m < 4; ++m)
#pragma unroll
                    for (int bj = 0; bj < 2; ++bj) {
                        const f32x4 v0 = acc[ai][bj][m][0], v1 = acc[ai][bj][m][1];
                        u32x4 w; w.x = cvt_pk_bf16(v0[0], v0[1]); w.y = cvt_pk_bf16(v0[2], v0[3]);
                        w.z = cvt_pk_bf16(v1[0], v1[1]); w.w = cvt_pk_bf16(v1[2], v1[3]);
                        g[(size_t)((ai * 4 + m) * 2 + bj) * 512] = w;
                    }
        } else if (u.kind == 3) {
            const unsigned char* gb = ws + WS_GSCR + (size_t)(u.pm * 4 + u.pn) * 16 * 512 * 16;
            unsigned char* mb = ws + WS_MERGED + (size_t)u.pm * 256 * 2048 + (size_t)u.pn * 512;
            const unsigned gvo = (unsigned)tid * 16u, mvo = (unsigned)((wr * 64 + fr) * 2048 + (wc * 32 + 8 * fq) * 2);
            u32x4 gwn[2];
            gwn[0] = *(const u32x4*)(gb + gvo); gwn[1] = *(const u32x4*)(gb + 8192 + gvo);
#pragma unroll
            for (int sp = 0; sp < 8; ++sp) {
                const int ai = sp >> 2, m = sp & 3;
                u32x4 gw[2], pw[2];
                gw[0] = gwn[0]; gw[1] = gwn[1];
#pragma unroll
                for (int k = 0; k < 2; ++k) { pw[k] = (u32x4){0u, 0u, 0u, 0u};
                    if (u.sub > 0) pw[k] = *(const u32x4*)(mb + (size_t)(ai * 128 + m * 16) * 2048 + k * 256 + mvo); }
                if (sp + 1 < 8) { gwn[0] = *(const u32x4*)(gb + (size_t)(2 * (sp + 1)) * 8192 + gvo); gwn[1] = *(const u32x4*)(gb + (size_t)(2 * (sp + 1) + 1) * 8192 + gvo); }
#pragma unroll
                for (int k = 0; k < 2; ++k) { const int bj = k;
                    const f32x4 v0 = acc[ai][bj][m][0], v1 = acc[ai][bj][m][1];
                    const float r0 = sigmoid_fast(lo_bf(gw[k].x)) * v0[0] + lo_bf(pw[k].x), r1 = sigmoid_fast(hi_bf(gw[k].x)) * v0[1] + hi_bf(pw[k].x), r2 = sigmoid_fast(lo_bf(gw[k].y)) * v0[2] + lo_bf(pw[k].y), r3 = sigmoid_fast(hi_bf(gw[k].y)) * v0[3] + hi_bf(pw[k].y);
                    const float r4 = sigmoid_fast(lo_bf(gw[k].z)) * v1[0] + lo_bf(pw[k].z), r5 = sigmoid_fast(hi_bf(gw[k].z)) * v1[1] + hi_bf(pw[k].z), r6 = sigmoid_fast(lo_bf(gw[k].w)) * v1[2] + lo_bf(pw[k].w), r7 = sigmoid_fast(hi_bf(gw[k].w)) * v1[3] + hi_bf(pw[k].w);
                    u32x4 w; w.x = cvt_pk_bf16(r0, r1); w.y = cvt_pk_bf16(r2, r3); w.z = cvt_pk_bf16(r4, r5); w.w = cvt_pk_bf16(r6, r7);
                    *(u32x4*)(mb + (size_t)(ai * 128 + m * 16) * 2048 + bj * 256 + mvo) = w; }
                asm volatile("" ::: "memory");
            }
        } else {
            bf16_t* o = (bf16_t*)(ws + WS_OUT);
#pragma unroll
            for (int ai = 0; ai < 2; ++ai)
#pragma unroll
                for (int m = 0; m < 4; ++m) {
                    bf16_t* rowp = o + (size_t)(row0 + ai * 128 + m * 16) * 1024 + col0;
#pragma unroll
                    for (int bj = 0; bj < 2; ++bj) { const f32x4 v0 = acc[ai][bj][m][0], v1 = acc[ai][bj][m][1];
                        u32x4 w; w.x = cvt_pk_bf16(v0[0], v0[1]); w.y = cvt_pk_bf16(v0[2], v0[3]); w.z = cvt_pk_bf16(v1[0], v1[1]); w.w = cvt_pk_bf16(v1[2], v1[3]);
                        *(u32x4*)(rowp + bj * 128) = w; }
                }
        }
    }
};

struct SchedA {
    const unsigned char* ws; int G, c;
    __device__ __forceinline__ bool next(int i, Unit& u) const {
        const int L = i * G + c;
        constexpr int nN = 23, nwg = 64 * nN;
        if (L < nwg) {
            int wgid = L; { const int q = nwg / 8, xcd = wgid % 8, off = wgid / 8; wgid = xcd * q + off; }
            const int nig = 8 * nN, gid = wgid / nig, fm = gid * 8;
            u.pm = fm + ((wgid % nig) % 8); u.pn = (wgid % nig) / 8; u.kind = 0; u.sub = 0; u.lda = 1024; u.ldb = 1024; u.nt = 16;
            u.a = (const char*)(ws + WS_H) + (size_t)u.pm * 256 * 1024 * 2; u.b = (const char*)(ws + WS_WINT) + (size_t)u.pn * 256 * 1024 * 2;
            return true;
        }
        const int r = L - nwg; if (r >= 32) return false;
        u.pm = r >> 2; u.pn = r & 3; u.kind = 1; u.sub = 0; u.lda = 1024; u.ldb = 1024; u.nt = 16;
        u.a = (const char*)(ws + WS_MEMN) + (size_t)u.pm * 256 * 1024 * 2; u.b = (const char*)(ws + WS_WMKVT) + (size_t)u.pn * 256 * 1024 * 2;
        return true;
    }
};
struct SchedD {
    const unsigned char* ws; int G, vcu;
    __device__ __forceinline__ bool next(int i, Unit& u) const {
        const int tile = vcu + (i >> 3) * G; if (tile >= 256) return false;
        const int sub = i & 7, n = sub >> 1;
        u.pm = tile >> 2; u.pn = tile & 3; u.sub = n;
        if ((sub & 1) == 0) { u.kind = 2; u.lda = 1024; u.ldb = 1024; u.nt = 16;
            u.a = (const char*)(ws + WS_H) + (size_t)u.pm * 256 * 1024 * 2; u.b = (const char*)(ws + WS_WGT) + (size_t)(n * 1024 + u.pn * 256) * 1024 * 2;
        } else { u.kind = 3; u.lda = NC; u.ldb = 512; u.nt = 8;
            const int yoff = n == 0 ? C_DNZ : (n == 1 ? C_GMU : (n == 2 ? C_SWQ : C_XMQ));
            u.a = (const char*)(ws + WS_COLS) + ((size_t)u.pm * 256 * NC + yoff) * 2; u.b = (const char*)(ws + WS_WUPT) + (size_t)(n * 1024 + u.pn * 256) * 512 * 2; }
        return true;
    }
};
struct SchedE {
    const unsigned char* ws; int G, vcu;
    __device__ __forceinline__ bool next(int i, Unit& u) const {
        const int tile = vcu + i * G; if (tile >= 256) return false;
        u.pm = tile >> 2; u.pn = tile & 3; u.kind = 4; u.sub = 0; u.lda = 1024; u.ldb = 1024; u.nt = 16;
        u.a = (const char*)(ws + WS_MERGED) + (size_t)u.pm * 256 * 1024 * 2; u.b = (const char*)(ws + WS_WOUTT) + (size_t)u.pn * 256 * 1024 * 2;
        return true;
    }
};

__device__ __forceinline__ void tr_item(const float* W, int ldw, int k0, bf16_t* WT, int Kdst, LAS float* scr, int lane) {
    float tv[32];
#pragma unroll
    for (int i = 0; i < 32; ++i) tv[i] = W[(size_t)(k0 + 2 * i + (lane >> 5)) * ldw + (lane & 31)];
#pragma unroll
    for (int i = 0; i < 32; ++i) scr[(2 * i + (lane >> 5)) * 33 + (lane & 31)] = tv[i];
    asm volatile("s_waitcnt lgkmcnt(0)" ::: "memory");
    const int c = lane & 7;
#pragma unroll
    for (int j = 0; j < 4; ++j) { const int n = (lane >> 3) + 8 * j; const LAS float* s = scr + (8 * c) * 33 + n;
        u32x4 o; o.x = cvt_pk_bf16(s[0 * 33], s[1 * 33]); o.y = cvt_pk_bf16(s[2 * 33], s[3 * 33]); o.z = cvt_pk_bf16(s[4 * 33], s[5 * 33]); o.w = cvt_pk_bf16(s[6 * 33], s[7 * 33]);
        *(u32x4*)(WT + (size_t)n * Kdst + k0 + 8 * c) = o; }
    asm volatile("s_waitcnt lgkmcnt(0)" ::: "memory");
}

__device__ __forceinline__ void p0_stage(const Params& p, int rk, LAS unsigned char* lds) {
    int tid_ = threadIdx.x; asm volatile("" : "+v"(tid_));
    const int tid = tid_, lane = tid & 63, wave = tid >> 6;
    const int gw = blockIdx.x * 8 + wave, NGW = gridDim.x * 8;
    unsigned char* ws = p.ws;
    LAS float* W8T = (LAS float*)(lds + 8 * 8448);
    if (rk <= 1) {
        const int l = rk;
        const float* win = p.w_in + (size_t)l * 1024 * DIN;
        {   f32x4 wv[4];
#pragma unroll
            for (int t2 = 0; t2 < 2; ++t2) { const float* wp = win + (size_t)(tid + 512 * t2) * DIN + 2048; wv[2 * t2] = *(const f32x4*)wp; wv[2 * t2 + 1] = *(const f32x4*)(wp + 4); }
#pragma unroll
            for (int t2 = 0; t2 < 2; ++t2)
#pragma unroll
                for (int j = 0; j < 8; ++j) W8T[j * 1024 + tid + 512 * t2] = wv[2 * t2 + (j >> 2)][j & 3]; }
        LAS float* scr = (LAS float*)(lds + wave * 8448);
        for (int it = gw; it < 7040; it += NGW) {
            if (it < 2944) { const int kb = it / 184, nb = it % 184, n0 = 32 * nb, sc = n0 < 2048 ? n0 : n0 + 8;
                tr_item(win + sc, DIN, 64 * kb, (bf16_t*)(ws + WS_WINT) + (size_t)n0 * 1024, 1024, scr, lane);
            } else if (it < 4992) { const int r = it - 2944, kb = r / 128, nb = r % 128;
                tr_item(win + 5896 + 32 * nb, DIN, 64 * kb, (bf16_t*)(ws + WS_WGT) + (size_t)(32 * nb) * 1024, 1024, scr, lane);
            } else if (it < 6016) { const int r = it - 4992, n = r / 256, r2 = r % 256, kb = r2 / 32, nb = r2 % 32;
                tr_item(p.w_up + (size_t)(l * 4 + n) * 512 * 1024 + 32 * nb, 1024, 64 * kb, (bf16_t*)(ws + WS_WUPT) + (size_t)(n * 1024 + 32 * nb) * 512, 512, scr, lane);
            } else if (it < 6528) { const int r = it - 6016, kb = r / 32, nb = r % 32;
                tr_item(p.w_out + (size_t)l * 1024 * 1024 + 32 * nb, 1024, 64 * kb, (bf16_t*)(ws + WS_WOUTT) + (size_t)(32 * nb) * 1024, 1024, scr, lane);
            } else { const int r = it - 6528, kb = r / 32, nb = r % 32;
                tr_item(p.w_mem_kv + (size_t)l * 1024 * 1024 + 32 * nb, 1024, 64 * kb, (bf16_t*)(ws + WS_WMKVT) + (size_t)(32 * nb) * 1024, 1024, scr, lane);
            }
        }
        for (int e = blockIdx.x * 512 + tid; e < 65536; e += gridDim.x * 512) { const int pp = (e >> 7) & 127, qq = e & 127;
            ((bf16_t*)(ws + WS_SPW))[e] = (bf16_t)(qq <= pp ? f2bf(p.spatial_w[(size_t)l * 65536 + e]) : 0u); }
        for (int r = gw; r < 2048; r += NGW) {
            const f32x4* xr = (const f32x4*)(p.mem + (size_t)r * D) + lane; const f32x4* gr = (const f32x4*)(p.norm_mem + l * D) + lane;
            f32x4 v[4]; float ss = 0.f;
#pragma unroll
            for (int j = 0; j < 4; ++j) { v[j] = xr[64 * j]; ss += v[j][0] * v[j][0] + v[j][1] * v[j][1] + v[j][2] * v[j][2] + v[j][3] * v[j][3]; }
            const float rstd = rsqrtf(wave_sum(ss) * (1.f / D) + EPS);
            u32x2* o = (u32x2*)((bf16_t*)(ws + WS_MEMN) + (size_t)r * D) + lane;
#pragma unroll
            for (int j = 0; j < 4; ++j) { const f32x4 g = gr[64 * j]; u32x2 w; w.x = cvt_pk_bf16(v[j][0] * rstd * g[0], v[j][1] * rstd * g[1]); w.y = cvt_pk_bf16(v[j][2] * rstd * g[2], v[j][3] * rstd * g[3]); o[64 * j] = w; }
        }
    }
    __syncthreads();
    const float* xin = rk == 2 ? p.out : p.x;
    for (int row0 = gw; row0 < M; row0 += 2 * NGW) {
        f32x4 v[2][4], o[2][4];
#pragma unroll
        for (int rr = 0; rr < 2; ++rr) { const int row = row0 + rr * NGW;
            const f32x4* xr = (const f32x4*)(xin + (size_t)row * D) + lane;
#pragma unroll
            for (int j = 0; j < 4; ++j) v[rr][j] = xr[64 * j];
            if (rk >= 1) { const u32x2* orow = (const u32x2*)((const bf16_t*)(ws + WS_OUT) + (size_t)row * D) + lane;
#pragma unroll
                for (int j = 0; j < 4; ++j) { const u32x2 ow = orow[64 * j]; o[rr][j] = (f32x4){lo_bf(ow.x), hi_bf(ow.x), lo_bf(ow.y), hi_bf(ow.y)}; } } }
        if (rk >= 1) {
            const f32x4* gr = (const f32x4*)(p.norm_post + (rk - 1) * D) + lane;
            float ss[2] = {0.f, 0.f};
#pragma unroll
            for (int rr = 0; rr < 2; ++rr)
#pragma unroll
                for (int j = 0; j < 4; ++j) ss[rr] += o[rr][j][0] * o[rr][j][0] + o[rr][j][1] * o[rr][j][1] + o[rr][j][2] * o[rr][j][2] + o[rr][j][3] * o[rr][j][3];
#pragma unroll
            for (int of = 1; of < 64; of <<= 1) { ss[0] += __shfl_xor(ss[0], of); ss[1] += __shfl_xor(ss[1], of); }
#pragma unroll
            for (int rr = 0; rr < 2; ++rr) { const float rstd = rsqrtf(ss[rr] * (1.f / D) + EPS);
                f32x4* dst = (f32x4*)(p.out + (size_t)(row0 + rr * NGW) * D) + lane;
#pragma unroll
                for (int j = 0; j < 4; ++j) { const f32x4 g = gr[64 * j]; v[rr][j] = v[rr][j] + o[rr][j] * rstd * g; dst[64 * j] = v[rr][j]; } }
        }
        if (rk <= 1) {
            const f32x4* gr = (const f32x4*)(p.norm_pre + rk * D) + lane;
            float ss[2] = {0.f, 0.f};
#pragma unroll
            for (int rr = 0; rr < 2; ++rr)
#pragma unroll
                for (int j = 0; j < 4; ++j) ss[rr] += v[rr][j][0] * v[rr][j][0] + v[rr][j][1] * v[rr][j][1] + v[rr][j][2] * v[rr][j][2] + v[rr][j][3] * v[rr][j][3];
#pragma unroll
            for (int of = 1; of < 64; of <<= 1) { ss[0] += __shfl_xor(ss[0], of); ss[1] += __shfl_xor(ss[1], of); }
            LAS float* red = (LAS float*)(lds + 8 * 8448 + 32768) + wave * 1024;
#pragma unroll
            for (int rr = 0; rr < 2; ++rr) { const float rstd = rsqrtf(ss[rr] * (1.f / D) + EPS);
                u32x2* oh = (u32x2*)((bf16_t*)(ws + WS_H) + (size_t)(row0 + rr * NGW) * D) + lane;
#pragma unroll
                for (int j = 0; j < 4; ++j) { const f32x4 g = gr[64 * j]; v[rr][j] = v[rr][j] * rstd * g; u32x2 w; w.x = cvt_pk_bf16(v[rr][j][0], v[rr][j][1]); w.y = cvt_pk_bf16(v[rr][j][2], v[rr][j][3]); oh[64 * j] = w; }
#pragma unroll
                for (int jj = 0; jj < 8; ++jj) { float a = 0.f;
#pragma unroll
                    for (int j = 0; j < 4; ++j) { const f32x4 w = *(const LAS f32x4*)(W8T + jj * 1024 + 256 * j + 4 * lane); a += v[rr][j][0] * w[0] + v[rr][j][1] * w[1] + v[rr][j][2] * w[2] + v[rr][j][3] * w[3]; }
                    red[rr * 512 + jj * 64 + lane] = a; } }
            asm volatile("s_waitcnt lgkmcnt(0)" ::: "memory");
#pragma unroll
            for (int rr = 0; rr < 2; ++rr) { const f32x4 r0 = *(const LAS f32x4*)(red + rr * 512 + lane * 8), r1 = *(const LAS f32x4*)(red + rr * 512 + lane * 8 + 4);
                float a = (r0[0] + r0[1]) + (r0[2] + r0[3]) + (r1[0] + r1[1]) + (r1[2] + r1[3]);
                a += __shfl_xor(a, 1); a += __shfl_xor(a, 2); a += __shfl_xor(a, 4);
                if ((lane & 7) == 0) ((float*)(ws + WS_SM) + (size_t)(row0 + rr * NGW) * 8)[lane >> 3] = a; }
            asm volatile("s_waitcnt lgkmcnt(0)" ::: "memory");
        }
    }
    __syncthreads();
}

__device__ __forceinline__ void delta_pre_unit(const Params& p, int l, int unit, LAS unsigned char* lds) {
    int tid_ = threadIdx.x; asm volatile("" : "+v"(tid_));
    const int tid = tid_, lane = tid & 63, wave = tid >> 6;
    const int h = unit & 3, gch = unit >> 2, c = gch & 31;
    const size_t row0 = (size_t)gch * 64;
    unsigned char* ws = p.ws;
    bf16_t* cols = (bf16_t*)(ws + WS_COLS);
    LAS float* Qf = (LAS float*)lds; LAS float* Kf = Qf + 64 * 129; LAS float* Vf = Kf + 64 * 129; LAS float* Lf = Vf + 64 * 129;
    LAS bf16_t* Qb = (LAS bf16_t*)(Lf + 64 * 68); LAS bf16_t* Kb = Qb + 64 * 136;
    LAS float* gcs = (LAS float*)(lds + 154112); LAS float* betas = gcs + 64; LAS float* facs = betas + 64;
    LAS bf16_t* Rw = (LAS bf16_t*)Lf;
    {
#pragma unroll
        for (int it = 0; it < 6; ++it) { const int pc = tid + 512 * it, r = pc / 48, rem = pc % 48, part = rem >> 4, cp = rem & 15;
            const u32x4 v = *(const u32x4*)(cols + (row0 + r) * NC + part * 512 + h * 128 + cp * 8);
            *(LAS u32x4*)(Rw + (r + 3) * 384 + part * 128 + cp * 8) = v; }
        if (tid < 144) { const int r = tid / 48, rem = tid % 48, part = rem >> 4, cp = rem & 15;
            u32x4 v = {0u, 0u, 0u, 0u};
            if (c > 0) v = *(const u32x4*)((const bf16_t*)(ws + WS_HALO) + ((size_t)(gch - 1) * 3 + r) * 1536 + part * 512 + h * 128 + cp * 8);
            *(LAS u32x4*)(Rw + r * 384 + part * 128 + cp * 8) = v; }
        if (wave == 6) {
            const float* sm = (const float*)(ws + WS_SM) + (row0 + lane) * 8;
            const float a = sm[4 + h] + p.dt_bias[l * 4 + h];
            const float sp = a > 20.f ? a : __logf(1.f + __expf(a));
            float g = -__expf(p.a_log[l * 4 + h]) * sp;
#pragma unroll
            for (int o = 1; o < 64; o <<= 1) { const float t = __shfl_up(g, o); if (lane >= o) g += t; }
            gcs[lane] = g;
        } else if (wave == 7) {
            const float* sm = (const float*)(ws + WS_SM) + (row0 + lane) * 8;
            betas[lane] = sigmoid_f(sm[h]);
        }
    }
    LDS_BAR();
    if (tid < 384) {
        const int quad = tid % 96, seg = tid / 96, c4 = 4 * quad, part = c4 >> 7, cc = c4 & 127;
        const float* cw = p.conv_w + (size_t)l * 4 * 1536 + part * 512 + h * 128 + cc;
        const f32x4 w0 = *(const f32x4*)cw, w1 = *(const f32x4*)(cw + 1536), w2 = *(const f32x4*)(cw + 2 * 1536), w3 = *(const f32x4*)(cw + 3 * 1536);
        const LAS bf16_t* src = Rw + (16 * seg) * 384 + c4;
        u32x2 rv[19];
#pragma unroll
        for (int r = 0; r < 19; ++r) rv[r] = *(const LAS u32x2*)(src + r * 384);
        LAS float* dst = (part == 0 ? Qf : (part == 1 ? Kf : Vf)) + (16 * seg) * 129 + cc;
#pragma unroll
        for (int r = 0; r < 16; ++r) {
            const u32x2 a3 = rv[r], a2 = rv[r + 1], a1 = rv[r + 2], a0 = rv[r + 3];
            const float y0 = w0[0] * lo_bf(a3.x) + w1[0] * lo_bf(a2.x) + w2[0] * lo_bf(a1.x) + w3[0] * lo_bf(a0.x);
            const float y1 = w0[1] * hi_bf(a3.x) + w1[1] * hi_bf(a2.x) + w2[1] * hi_bf(a1.x) + w3[1] * hi_bf(a0.x);
            const float y2 = w0[2] * lo_bf(a3.y) + w1[2] * lo_bf(a2.y) + w2[2] * lo_bf(a1.y) + w3[2] * lo_bf(a0.y);
            const float y3 = w0[3] * hi_bf(a3.y) + w1[3] * hi_bf(a2.y) + w2[3] * hi_bf(a1.y) + w3[3] * hi_bf(a0.y);
            dst[r * 129 + 0] = silu_f(y0); dst[r * 129 + 1] = silu_f(y1); dst[r * 129 + 2] = silu_f(y2); dst[r * 129 + 3] = silu_f(y3);
        }
    }
    LDS_BAR();
    if (tid < 64) { facs[tid] = betas[tid]; facs[64 + tid] = betas[tid] * __expf(gcs[tid]); }
    {
        const int r = tid >> 3, sub = tid & 7; float sq = 0.f, sk = 0.f;
#pragma unroll
        for (int e = 0; e < 16; ++e) { const float a = Qf[r * 129 + sub * 16 + e]; sq += a * a; const float b = Kf[r * 129 + sub * 16 + e]; sk += b * b; }
        sq += __shfl_xor(sq, 1); sq += __shfl_xor(sq, 2); sq += __shfl_xor(sq, 4);
        sk += __shfl_xor(sk, 1); sk += __shfl_xor(sk, 2); sk += __shfl_xor(sk, 4);
        const float rq = rsqrtf(sq + EPS) * 0.08838834764831845f, rkk = rsqrtf(sk + EPS);
#pragma unroll
        for (int e = 0; e < 16; ++e) { const int o = sub * 16 + e; const float a = Qf[r * 129 + o] * rq; Qb[r * 136 + o] = (bf16_t)f2bf(a);
            const float b = Kf[r * 129 + o] * rkk; Kf[r * 129 + o] = b; Kb[r * 136 + o] = (bf16_t)f2bf(b); }
    }
    LDS_BAR();
    LAS bf16_t* Al = (LAS bf16_t*)Qf;
    LAS float* Db = Qf;
    LAS bf16_t* Lb = (LAS bf16_t*)(lds + 16640);
    LAS bf16_t* XT = Qb;
    LAS bf16_t* Wl = (LAS bf16_t*)Vf;
    {
        const int i = lane & 15, q = lane >> 4;
#pragma unroll
        for (int jb = 0; jb < 4; ++jb) { const int job = wave + 8 * jb;
            const int kind = job >> 4, ct = (job >> 2) & 3, st = job & 3;
            f32x4 acc = {0.f, 0.f, 0.f, 0.f};
            if (st <= ct) {
                const LAS bf16_t* Ab = kind == 0 ? Kb : Qb;
#pragma unroll
                for (int ks = 0; ks < 4; ++ks) { const bf16x8 a = *(const LAS bf16x8*)(Ab + (16 * ct + i) * 136 + 32 * ks + 8 * q); const bf16x8 b = *(const LAS bf16x8*)(Kb + (16 * st + i) * 136 + 32 * ks + 8 * q);
                    acc = MFMA16(a, b, acc); }
            }
            const int s = 16 * st + i; const float gs = gcs[s];
#pragma unroll
            for (int r = 0; r < 4; ++r) { const int cr = 16 * ct + 4 * q + r; const float e = __expf(fminf(gcs[cr] - gs, 0.f));
                if (kind == 0) { const float v = (cr > s) ? acc[r] * betas[cr] * e : 0.f; Lf[cr * 68 + s] = v; Lb[cr * 72 + s] = (bf16_t)f2bf(v); }
                else Al[cr * 72 + (s & ~31) + kperm32(s & 31)] = (bf16_t)f2bf(cr >= s ? acc[r] * e : 0.f); }
        }
    }
    LDS_BAR();
    {
        *(u32x4*)(ws + WS_WA_A + (size_t)unit * 8192 + tid * 16) = *(const LAS u32x4*)(Al + (tid >> 3) * 72 + (tid & 7) * 8);
        { const int cr = tid >> 3, d0 = (tid & 7) * 16; const float e = __expf(gcs[cr]);
            bf16_t* dst = cols + (row0 + cr) * NC + C_DNQ + h * 128 + d0;
#pragma unroll
            for (int g4 = 0; g4 < 2; ++g4) { const u32x4 v = *(const LAS u32x4*)(Qb + cr * 136 + d0 + 8 * g4); u32x4 w;
                w.x = cvt_pk_bf16(lo_bf(v.x) * e, hi_bf(v.x) * e); w.y = cvt_pk_bf16(lo_bf(v.y) * e, hi_bf(v.y) * e); w.z = cvt_pk_bf16(lo_bf(v.z) * e, hi_bf(v.z) * e); w.w = cvt_pk_bf16(lo_bf(v.w) * e, hi_bf(v.w) * e);
                const int o0 = (d0 + 8 * g4) & 31, gb = (d0 + 8 * g4) & ~31;
                *(u32x2*)(dst - d0 + gb + kperm32(o0)) = (u32x2){w.x, w.y}; *(u32x2*)(dst - d0 + gb + kperm32(o0 + 4)) = (u32x2){w.z, w.w}; } }
        { const int dk = tid & 127, c0 = (tid >> 7) * 16; const float gl = gcs[63];
            bf16_t* dst = cols + (row0 + (dk >> 1)) * NC + C_DNK + h * 128 + (dk & 1) * 64 + c0;
#pragma unroll
            for (int g4 = 0; g4 < 2; ++g4) { float v[8];
#pragma unroll
                for (int e = 0; e < 8; ++e) { const int cr = c0 + 8 * g4 + e; v[e] = Kf[cr * 129 + dk] * __expf(gl - gcs[cr]); }
                u32x4 w; w.x = cvt_pk_bf16(v[0], v[1]); w.y = cvt_pk_bf16(v[2], v[3]); w.z = cvt_pk_bf16(v[4], v[5]); w.w = cvt_pk_bf16(v[6], v[7]);
                const int cc0 = c0 + 8 * g4, gb = cc0 & ~31, o0 = cc0 & 31;
                *(u32x2*)(dst - c0 + gb + kperm32(o0)) = (u32x2){w.x, w.y}; *(u32x2*)(dst - c0 + gb + kperm32(o0 + 4)) = (u32x2){w.z, w.w}; } }
        if (tid == 0) ((float*)(ws + WS_DL))[unit] = __expf(gcs[63]);
    }
    LDS_BAR();
    for (int e = tid; e < 2304; e += 512) ((LAS u32x4*)XT)[e] = (u32x4){0u, 0u, 0u, 0u};
    LDS_BAR();
    {
        const int j = tid & 255; const bool isv = j < 128; const int jj = j & 127;
        const LAS float* src = (isv ? Vf : Kf) + jj;
        const LAS float* fac = facs + (isv ? 0 : 64);
        const int i16 = lane & 15, q = lane >> 4;
        float x[64];
#pragma unroll
        for (int bb = 0; bb < 4; ++bb) {
            if (bb > 0) {
#pragma unroll
                for (int tt = 0; tt < 2; ++tt) { const int ct = 2 * wave + tt; f32x4 acc = {0.f, 0.f, 0.f, 0.f};
#pragma unroll
                    for (int ks = 0; ks < 2; ++ks) if (32 * ks < 16 * bb) acc = MFMA16(*(const LAS bf16x8*)(Lb + (16 * bb + i16) * 72 + 32 * ks + 8 * q), *(const LAS bf16x8*)(XT + (16 * ct + i16) * 72 + 32 * ks + 8 * q), acc);
#pragma unroll
                    for (int r = 0; r < 4; ++r) Db[(4 * q + r) * 260 + 16 * ct + i16] = acc[r]; }
                LDS_BAR();
            }
            if (tid < 256) {
                int Lr[16]; float rh[16];
#pragma unroll
                for (int i = 0; i < 16; ++i) { const int row = 16 * bb + i;
                    Lr[i] = __float_as_int(Lf[row * 68 + 16 * bb + i16]);
                    rh[i] = src[row * 129] * fac[row] - (bb > 0 ? Db[i * 260 + j] : 0.f); }
#pragma unroll
                for (int i = 0; i < 16; ++i) { const int row = 16 * bb + i;
                    float sa[4] = {rh[i], 0.f, 0.f, 0.f};
#pragma unroll
                    for (int jx = 0; jx < i; ++jx) sa[jx & 3] -= __int_as_float(__builtin_amdgcn_readlane(Lr[i], jx)) * x[16 * bb + jx];
                    x[row] = (sa[0] + sa[1]) + (sa[2] + sa[3]); }
                u32x4 w0, w1;
                w0.x = cvt_pk_bf16(x[16 * bb + 0], x[16 * bb + 1]); w0.y = cvt_pk_bf16(x[16 * bb + 2], x[16 * bb + 3]); w0.z = cvt_pk_bf16(x[16 * bb + 4], x[16 * bb + 5]); w0.w = cvt_pk_bf16(x[16 * bb + 6], x[16 * bb + 7]);
                w1.x = cvt_pk_bf16(x[16 * bb + 8], x[16 * bb + 9]); w1.y = cvt_pk_bf16(x[16 * bb + 10], x[16 * bb + 11]); w1.z = cvt_pk_bf16(x[16 * bb + 12], x[16 * bb + 13]); w1.w = cvt_pk_bf16(x[16 * bb + 14], x[16 * bb + 15]);
                *(LAS u32x4*)(XT + j * 72 + 16 * bb) = w0; *(LAS u32x4*)(XT + j * 72 + 16 * bb + 8) = w1;
            }
            LDS_BAR();
        }
#pragma unroll
        for (int it = 0; it < 2; ++it) { const int pc = tid + 512 * it, dv = pc >> 3, cp = pc & 7;
            *(u32x4*)(cols + (row0 + (dv >> 1)) * NC + C_DNV + h * 128 + (dv & 1) * 64 + cp * 8) = *(const LAS u32x4*)(XT + dv * 72 + cp * 8); }
        if (tid >= 128 && tid < 256) {
#pragma unroll
            for (int i = 0; i < 64; ++i) Wl[i * 136 + (jj & ~31) + kperm32(jj & 31)] = (bf16_t)f2bf(x[i]); }
    }
    LDS_BAR();
    {   unsigned char* wo = ws + WS_WA_W + (size_t)unit * 16384;
#pragma unroll
        for (int it = 0; it < 2; ++it) { const int pc = tid + 512 * it; *(u32x4*)(wo + pc * 16) = *(const LAS u32x4*)(Wl + (pc >> 4) * 136 + (pc & 15) * 8); }
    }
    LDS_BAR();
}

__device__ __forceinline__ void delta_scan_unit(const Params& p, int l, int bh, LAS unsigned char* lds) {
    int tid_ = threadIdx.x; asm volatile("" : "+v"(tid_));
    const int tid = tid_, lane = tid & 63, wave = tid >> 6, i = lane & 15, q = lane >> 4;
    const int b = bh >> 2, h = bh & 3;
    unsigned char* ws = p.ws;
    unsigned char* colsb = ws + WS_COLS;
    constexpr int BUFB = 62464, O_W = 0, O_QG = 17408, O_KD = 34816, O_A = 53248;
    LAS bf16_t* Ot = (LAS bf16_t*)(lds + 2 * BUFB);
    if (wave < 4) {
        __builtin_amdgcn_s_setprio(3);
        f32x4 S[2][8];
#pragma unroll
        for (int s2 = 0; s2 < 2; ++s2)
#pragma unroll
            for (int t = 0; t < 8; ++t) S[s2][t] = (f32x4){0.f, 0.f, 0.f, 0.f};
        u32x2 uraw[2][4]; float dl;
        const float dlv = ((const float*)(ws + WS_DL))[(b * 32 + (lane & 31)) * 4 + h];
#define SCAN_ULOAD(cidx, dstu, dstd) do { const int gch_ = b * 32 + (cidx); const size_t r0_ = (size_t)gch_ * 64; \
            _Pragma("unroll") for (int s2 = 0; s2 < 2; ++s2) { const int dv_ = 32 * wave + 16 * s2 + i; \
                const unsigned char* ub_ = colsb + ((r0_ + (dv_ >> 1)) * NC + C_DNV + h * 128 + (dv_ & 1) * 64 + 4 * q) * 2; \
                _Pragma("unroll") for (int mt = 0; mt < 4; ++mt) dstu[s2][mt] = *(const u32x2*)(ub_ + mt * 32); } } while (0)
#define SCAN_LD16(pp) (*(const LAS bf16x8*)(pp))
#define SCAN_FRAG(f) ( (f) < 16 ? SCAN_LD16(buf + O_W + (16 * ((f) >> 2) + i) * 272 + (32 * ((f) & 3) + 8 * q) * 2) \
                     : (f) < 32 ? SCAN_LD16(buf + O_QG + (16 * (((f) - 16) >> 2) + i) * 272 + (32 * (((f) - 16) & 3) + 8 * q) * 2) \
                     : (f) < 38 ? SCAN_LD16(buf + O_A + (16 * ((f) == 32 ? 0 : (f) == 33 ? 1 : (f) <= 35 ? 2 : 3) + i) * 144 + (32 * (((f) == 35 || (f) == 37) ? 1 : 0) + 8 * q) * 2) \
                     : SCAN_LD16(buf + O_KD + (16 * (((f) - 38) >> 1) + i) * 144 + (32 * (((f) - 38) & 1) + 8 * q) * 2) )
        SCAN_ULOAD(0, uraw, dl);
        __syncthreads();
#pragma unroll 1
        for (int c = 0; c < 32; ++c) {
            const LAS unsigned char* buf = lds + (c & 1) * BUFB;
            dl = __int_as_float(__builtin_amdgcn_readlane(__float_as_int(dlv), c));
            bf16x8 Sb[2][4];
#pragma unroll
            for (int s2 = 0; s2 < 2; ++s2)
#pragma unroll
                for (int ks = 0; ks < 4; ++ks) Sb[s2][ks] = pack8(S[s2][2 * ks], S[s2][2 * ks + 1]);
            f32x4 aw[2][4], o[2][4];
            bf16x8 Vb[2][2];
            bf16x8 Fq[8];
            constexpr int DEPTH = 6;
            Fq[0] = SCAN_FRAG(0); Fq[1] = SCAN_FRAG(1); Fq[2] = SCAN_FRAG(2); Fq[3] = SCAN_FRAG(3); Fq[4] = SCAN_FRAG(4); Fq[5] = SCAN_FRAG(5);
#define SCAN_STEP(f) { \
                if ((f) + DEPTH < 54) Fq[((f) + DEPTH) & 7] = SCAN_FRAG(((f) + DEPTH < 54 ? (f) + DEPTH : 53)); \
                const bf16x8 A = Fq[(f) & 7]; \
                if ((f) < 16) { constexpr int mt = ((f) >> 2) & 3, ks = (f) & 3; \
                    if (ks == 0) { aw[0][mt] = (f32x4){0.f, 0.f, 0.f, 0.f}; aw[1][mt] = (f32x4){0.f, 0.f, 0.f, 0.f}; } \
                    aw[0][mt] = MFMA16(A, Sb[0][ks], aw[0][mt]); aw[1][mt] = MFMA16(A, Sb[1][ks], aw[1][mt]); \
                } else if ((f) < 32) { constexpr int mt = (((f) - 16) >> 2) & 3, ks = (f) & 3; \
                    if (ks == 0) { o[0][mt] = (f32x4){0.f, 0.f, 0.f, 0.f}; o[1][mt] = (f32x4){0.f, 0.f, 0.f, 0.f}; } \
                    o[0][mt] = MFMA16(A, Sb[0][ks], o[0][mt]); o[1][mt] = MFMA16(A, Sb[1][ks], o[1][mt]); \
                } else if ((f) < 38) { constexpr int mt = (f) == 32 ? 0 : ((f) == 33 ? 1 : ((f) <= 35 ? 2 : 3)), k2 = ((f) == 35 || (f) == 37) ? 1 : 0; \
                    o[0][mt] = MFMA16(A, Vb[0][k2], o[0][mt]); o[1][mt] = MFMA16(A, Vb[1][k2], o[1][mt]); \
                } else { constexpr int t = (((f) - 38) >> 1) & 7, k2 = (f) & 1; \
                    if (k2 == 0) { S[0][t] = S[0][t] * dl; S[1][t] = S[1][t] * dl; } \
                    S[0][t] = MFMA16(A, Vb[0][k2], S[0][t]); S[1][t] = MFMA16(A, Vb[1][k2], S[1][t]); } \
                if ((f) == 19) { \
                    f32x4 vn[2][4]; \
                    _Pragma("unroll") for (int s2 = 0; s2 < 2; ++s2) \
                    _Pragma("unroll") for (int mt = 0; mt < 4; ++mt) vn[s2][mt] = (f32x4){lo_bf(uraw[s2][mt].x) - aw[s2][mt][0], hi_bf(uraw[s2][mt].x) - aw[s2][mt][1], lo_bf(uraw[s2][mt].y) - aw[s2][mt][2], hi_bf(uraw[s2][mt].y) - aw[s2][mt][3]}; \
                    _Pragma("unroll") for (int s2 = 0; s2 < 2; ++s2) { Vb[s2][0] = pack8(vn[s2][0], vn[s2][1]); Vb[s2][1] = pack8(vn[s2][2], vn[s2][3]); } \
                    if (c + 1 < 32) SCAN_ULOAD(c + 1, uraw, dl); \
                } \
                __builtin_amdgcn_sched_barrier(0); }
#define SCAN_STEP6(f) SCAN_STEP(f) SCAN_STEP((f) + 1) SCAN_STEP((f) + 2) SCAN_STEP((f) + 3) SCAN_STEP((f) + 4) SCAN_STEP((f) + 5)
            SCAN_STEP6(0) SCAN_STEP6(6) SCAN_STEP6(12) SCAN_STEP6(18) SCAN_STEP6(24) SCAN_STEP6(30) SCAN_STEP6(36) SCAN_STEP6(42) SCAN_STEP6(48)
#undef SCAN_STEP6
#undef SCAN_STEP
            __syncthreads();
#pragma unroll
            for (int s2 = 0; s2 < 2; ++s2)
#pragma unroll
                for (int mt = 0; mt < 4; ++mt)
#pragma unroll
                    for (int r = 0; r < 4; r += 2) { const unsigned pk = cvt_pk_bf16(o[s2][mt][r], o[s2][mt][r + 1]);
                        Ot[(16 * mt + 4 * q + r) * 136 + 32 * wave + 16 * s2 + i] = (bf16_t)(pk & 0xffffu); Ot[(16 * mt + 4 * q + r + 1) * 136 + 32 * wave + 16 * s2 + i] = (bf16_t)(pk >> 16); }
            __syncthreads();
        }
#undef SCAN_FRAG
#undef SCAN_LD16
#undef SCAN_ULOAD
        __builtin_amdgcn_s_setprio(0);
        __syncthreads();
    } else {
        const int t2 = tid - 256, fr_ = t2 >> 2, fs_ = t2 & 3;
        float gn[32];
#pragma unroll
        for (int e = 0; e < 32; ++e) gn[e] = p.dn_norm[l * 128 + fs_ * 32 + e];
        u32x4 pre[14], zc[4], zn[4];
#define SCAN_LOAD(cidx) do { const int gch_ = b * 32 + (cidx); const size_t r0_ = (size_t)gch_ * 64; const int un2_ = gch_ * 4 + h; \
            const unsigned char* wsrc_ = ws + WS_WA_W + (size_t)un2_ * 16384; const unsigned char* asrc_ = ws + WS_WA_A + (size_t)un2_ * 8192; \
            _Pragma("unroll") for (int k = 0; k < 4; ++k) { const int pc_ = t2 + 256 * k; \
                pre[k] = *(const u32x4*)(wsrc_ + pc_ * 16); \
                pre[4 + k] = *(const u32x4*)(colsb + ((r0_ + (pc_ >> 4)) * NC + C_DNQ + h * 128) * 2 + (pc_ & 15) * 16); \
                pre[8 + k] = *(const u32x4*)(colsb + ((r0_ + (pc_ >> 4)) * NC + C_DNK + h * 128) * 2 + (pc_ & 15) * 16); } \
            pre[12] = *(const u32x4*)(asrc_ + t2 * 16); pre[13] = *(const u32x4*)(asrc_ + (t2 + 256) * 16); } while (0)
#define SCAN_ZLOAD(cidx, dst) do { const unsigned char* zb_ = colsb + (((size_t)(b * 32 + (cidx)) * 64 + fr_) * NC + C_DNZ + h * 128 + fs_ * 32) * 2; \
            _Pragma("unroll") for (int k = 0; k < 4; ++k) dst[k] = *(const u32x4*)(zb_ + 16 * k); } while (0)
#define SCAN_STORE(bufp) do { LAS unsigned char* b_ = (bufp); \
            _Pragma("unroll") for (int k = 0; k < 4; ++k) { const int pc_ = t2 + 256 * k; \
                *(LAS u32x4*)(b_ + O_W + (pc_ >> 4) * 272 + (pc_ & 15) * 16) = pre[k]; \
                *(LAS u32x4*)(b_ + O_QG + (pc_ >> 4) * 272 + (pc_ & 15) * 16) = pre[4 + k]; \
                *(LAS u32x4*)(b_ + O_KD + (pc_ >> 3) * 144 + (pc_ & 7) * 16) = pre[8 + k]; } \
            *(LAS u32x4*)(b_ + O_A + (t2 >> 3) * 144 + (t2 & 7) * 16) = pre[12]; *(LAS u32x4*)(b_ + O_A + ((t2 + 256) >> 3) * 144 + (t2 & 7) * 16) = pre[13]; } while (0)
#define SCAN_FINAL(cidx) do { \
            float ss_ = 0.f; u32x4 ov_[4]; \
            _Pragma("unroll") for (int k = 0; k < 4; ++k) { ov_[k] = *(const LAS u32x4*)(Ot + fr_ * 136 + fs_ * 32 + 8 * k); \
                ss_ += lo_bf(ov_[k].x) * lo_bf(ov_[k].x) + hi_bf(ov_[k].x) * hi_bf(ov_[k].x) + lo_bf(ov_[k].y) * lo_bf(ov_[k].y) + hi_bf(ov_[k].y) * hi_bf(ov_[k].y) \
                     + lo_bf(ov_[k].z) * lo_bf(ov_[k].z) + hi_bf(ov_[k].z) * hi_bf(ov_[k].z) + lo_bf(ov_[k].w) * lo_bf(ov_[k].w) + hi_bf(ov_[k].w) * hi_bf(ov_[k].w); } \
            ss_ += __shfl_xor(ss_, 1); ss_ += __shfl_xor(ss_, 2); \
            const float rstd_ = rsqrtf(ss_ * (1.f / 128.f) + EPS); \
            unsigned char* yb_ = colsb + (((size_t)(b * 32 + (cidx)) * 64 + fr_) * NC + C_DNZ + h * 128 + fs_ * 32) * 2; \
            _Pragma("unroll") for (int k = 0; k < 4; ++k) { u32x4 w_; \
                w_.x = cvt_pk_bf16(lo_bf(ov_[k].x) * rstd_ * gn[8 * k + 0] * lo_bf(zc[k].x), hi_bf(ov_[k].x) * rstd_ * gn[8 * k + 1] * hi_bf(zc[k].x)); \
                w_.y = cvt_pk_bf16(lo_bf(ov_[k].y) * rstd_ * gn[8 * k + 2] * lo_bf(zc[k].y), hi_bf(ov_[k].y) * rstd_ * gn[8 * k + 3] * hi_bf(zc[k].y)); \
                w_.z = cvt_pk_bf16(lo_bf(ov_[k].z) * rstd_ * gn[8 * k + 4] * lo_bf(zc[k].z), hi_bf(ov_[k].z) * rstd_ * gn[8 * k + 5] * hi_bf(zc[k].z)); \
                w_.w = cvt_pk_bf16(lo_bf(ov_[k].w) * rstd_ * gn[8 * k + 6] * lo_bf(zc[k].w), hi_bf(ov_[k].w) * rstd_ * gn[8 * k + 7] * hi_bf(zc[k].w)); \
                *(u32x4*)(yb_ + 16 * k) = w_; } } while (0)
        SCAN_LOAD(0); SCAN_STORE(lds);
        __syncthreads();
#pragma unroll 1
        for (int c = 0; c < 32; ++c) {
            if (c + 1 < 32) SCAN_LOAD(c + 1);
            SCAN_ZLOAD(c, zn);
            if (c > 0) SCAN_FINAL(c - 1);
            __syncthreads();
            if (c + 1 < 32) SCAN_STORE(lds + ((c + 1) & 1) * BUFB);
            __syncthreads();
#pragma unroll
            for (int k = 0; k < 4; ++k) zc[k] = zn[k];
        }
        SCAN_FINAL(31);
#undef SCAN_LOAD
#undef SCAN_ZLOAD
#undef SCAN_STORE
#undef SCAN_FINAL
        __syncthreads();
    }
}

__device__ __forceinline__ void gmlp_unit(const Params& p, int l, int unit, LAS unsigned char* lds) {
    int tid_ = threadIdx.x; asm volatile("" : "+v"(tid_));
    const int tid = tid_, lane = tid & 63, wave = tid >> 6, i = lane & 15, q = lane >> 4;
    const int g = unit & 3, bn = unit >> 2;
    const size_t row0 = (size_t)bn * 128;
    unsigned char* ws = p.ws;
    bf16_t* cols = (bf16_t*)(ws + WS_COLS);
    LAS float* rstd = (LAS float*)lds;
    LAS bf16_t* vT = (LAS bf16_t*)(lds + 512);
    {   u32x4 rv[16];
#pragma unroll
        for (int tt = 0; tt < 16; ++tt) rv[tt] = *(const u32x4*)(cols + (row0 + 16 * wave + tt) * NC + C_GMV + lane * 8);
#pragma unroll
        for (int tt = 0; tt < 16; ++tt) { const u32x4 v = rv[tt];
            float ss = lo_bf(v.x) * lo_bf(v.x) + hi_bf(v.x) * hi_bf(v.x) + lo_bf(v.y) * lo_bf(v.y) + hi_bf(v.y) * hi_bf(v.y) + lo_bf(v.z) * lo_bf(v.z) + hi_bf(v.z) * hi_bf(v.z) + lo_bf(v.w) * lo_bf(v.w) + hi_bf(v.w) * hi_bf(v.w);
            ss = wave_sum(ss); if (lane == 0) rstd[16 * wave + tt] = rsqrtf(ss * (1.f / 512.f) + EPS); } }
    LDS_BAR();
#pragma unroll
    for (int it = 0; it < 4; ++it) { const int pc = tid + 512 * it, qrow = pc >> 4, cp = pc & 15;
        const u32x4 v = *(const u32x4*)(cols + (row0 + qrow) * NC + C_GMV + g * 128 + cp * 8);
        const float* gp = p.gm_norm + l * 512 + g * 128 + cp * 8; const float rs = rstd[qrow];
        const float f[8] = {lo_bf(v.x), hi_bf(v.x), lo_bf(v.y), hi_bf(v.y), lo_bf(v.z), hi_bf(v.z), lo_bf(v.w), hi_bf(v.w)};
#pragma unroll
        for (int e = 0; e < 8; ++e) vT[(cp * 8 + e) * 136 + qrow] = (bf16_t)f2bf(f[e] * rs * gp[e]); }
    LDS_BAR();
    {
        const int pt = wave; const int nks = (pt >> 1) + 1;
        const bf16_t* spw = (const bf16_t*)(ws + WS_SPW) + (size_t)g * 16384 + (16 * pt + i) * 128 + 8 * q;
        bf16x8 Bf[4];
#pragma unroll
        for (int ks = 0; ks < 4; ++ks) Bf[ks] = *(const bf16x8*)(spw + 32 * ks);
        const float bias = p.spatial_b[l * 512 + g * 128 + 16 * pt + i];
        const size_t prow = row0 + 16 * pt + i;
        u32x2 uu8[8], zz8[8];
#pragma unroll
        for (int ct = 0; ct < 8; ++ct) { const int ch = g * 128 + 16 * ct + 4 * q; uu8[ct] = *(const u32x2*)(cols + prow * NC + C_GMU + ch); zz8[ct] = *(const u32x2*)(cols + prow * NC + C_GMZ + ch); }
#pragma unroll
        for (int ct = 0; ct < 8; ++ct) { f32x4 acc = {0.f, 0.f, 0.f, 0.f};
#pragma unroll
            for (int ks = 0; ks < 4; ++ks) if (ks < nks) acc = MFMA16(*(const LAS bf16x8*)(vT + (16 * ct + i) * 136 + 32 * ks + 8 * q), Bf[ks], acc);
            const int ch = g * 128 + 16 * ct + 4 * q;
            u32x2* up = (u32x2*)(cols + prow * NC + C_GMU + ch); const u32x2 uu = uu8[ct]; const u32x2 zz = zz8[ct];
            u32x2 w; w.x = cvt_pk_bf16(lo_bf(uu.x) * (acc[0] + bias) * lo_bf(zz.x), hi_bf(uu.x) * (acc[1] + bias) * hi_bf(zz.x));
            w.y = cvt_pk_bf16(lo_bf(uu.y) * (acc[2] + bias) * lo_bf(zz.y), hi_bf(uu.y) * (acc[3] + bias) * hi_bf(zz.y));
            *up = w; }
    }
    LDS_BAR();
}

template <int HD, int NK, bool SWA>
__device__ __forceinline__ void attn_pair16(bf16_t* qpA, bf16_t* qpB, const bf16x8 (&QfA)[HD / 32], const bf16x8 (&QfB)[HD / 32], const u32x2 (&ZfA)[HD / 16], const u32x2 (&ZfB)[HD / 16],
                                            const LAS bf16_t* Kl, const LAS bf16_t* VTl, int kp_lo, int kp_hi, float scale, float m0, float l0, int qi0A, int qi0B, bool blk0, int lane) {
    const int i = lane & 15, q = lane >> 4;
    float m[2] = {m0, m0}, lsum[2] = {l0, l0};
    f32x4 O[2][HD / 16];
#pragma unroll
    for (int t = 0; t < 2; ++t)
#pragma unroll
        for (int dt = 0; dt < HD / 16; ++dt) O[t][dt] = (f32x4){0.f, 0.f, 0.f, 0.f};
    const int qi[2] = {qi0A + i, qi0B + i};
    for (int kp = kp_lo; kp <= kp_hi; ++kp) {
        f32x4 s0[2], s1[2];
#pragma unroll
        for (int t = 0; t < 2; ++t) { s0[t] = (f32x4){0.f, 0.f, 0.f, 0.f}; s1[t] = (f32x4){0.f, 0.f, 0.f, 0.f}; }
#pragma unroll
        for (int kd = 0; kd < HD / 32; ++kd) {
            const bf16x8 k0f = *(const LAS bf16x8*)(Kl + (32 * kp + i) * (HD + 8) + 32 * kd + 8 * q), k1f = *(const LAS bf16x8*)(Kl + (32 * kp + 16 + i) * (HD + 8) + 32 * kd + 8 * q);
            s0[0] = MFMA16(k0f, QfA[kd], s0[0]); s1[0] = MFMA16(k1f, QfA[kd], s1[0]);
            s0[1] = MFMA16(k0f, QfB[kd], s0[1]); s1[1] = MFMA16(k1f, QfB[kd], s1[1]);
        }
        bf16x8 Pb[2]; float alpha[2];
#pragma unroll
        for (int t = 0; t < 2; ++t) {
            float mx = -1e30f;
#pragma unroll
            for (int r = 0; r < 4; ++r) {
                float a = s0[t][r] * scale, b = s1[t][r] * scale;
                if (SWA) { const int k0 = 32 * kp + 4 * q + r, k1 = k0 + 16;
                    if (!(k0 >= qi[t] + 1 && k0 <= qi[t] + 128 && (!blk0 || k0 >= 128))) a = -1e30f;
                    if (!(k1 >= qi[t] + 1 && k1 <= qi[t] + 128 && (!blk0 || k1 >= 128))) b = -1e30f; }
                s0[t][r] = a; s1[t][r] = b; mx = fmaxf(mx, fmaxf(a, b));
            }
            mx = fmaxf(mx, __shfl_xor(mx, 16)); mx = fmaxf(mx, __shfl_xor(mx, 32));
            const float mn = fmaxf(m[t], mx); alpha[t] = __expf(m[t] - mn);
            float ps = 0.f;
#pragma unroll
            for (int r = 0; r < 4; ++r) { s0[t][r] = __expf(s0[t][r] - mn); s1[t][r] = __expf(s1[t][r] - mn); ps += s0[t][r] + s1[t][r]; }
            ps += __shfl_xor(ps, 16); ps += __shfl_xor(ps, 32);
            lsum[t] = lsum[t] * alpha[t] + ps; m[t] = mn;
            Pb[t] = pack8(s0[t], s1[t]);
        }
#pragma unroll
        for (int dt = 0; dt < HD / 16; ++dt) {
            const bf16x8 vf = lds_ld2x8((const LAS unsigned char*)(VTl + (16 * dt + i) * (NK + 8) + 32 * kp + 4 * q));
            O[0][dt] = MFMA16(vf, Pb[0], O[0][dt] * alpha[0]); O[1][dt] = MFMA16(vf, Pb[1], O[1][dt] * alpha[1]); }
    }
#pragma unroll
    for (int t = 0; t < 2; ++t) { const float inv = 1.f / lsum[t]; bf16_t* qp = t == 0 ? qpA : qpB;
#pragma unroll
        for (int dt = 0; dt < HD / 16; ++dt) { const int d = 16 * dt + 4 * q;
            const u32x2 zz = t == 0 ? ZfA[dt] : ZfB[dt];
            u32x2 w; w.x = cvt_pk_bf16(O[t][dt][0] * inv * lo_bf(zz.x), O[t][dt][1] * inv * hi_bf(zz.x)); w.y = cvt_pk_bf16(O[t][dt][2] * inv * lo_bf(zz.y), O[t][dt][3] * inv * hi_bf(zz.y));
            *(u32x2*)(qp + (size_t)i * NC + d) = w; } }
}

__device__ __forceinline__ void swa_unit(const Params& p, int l, int unit, LAS unsigned char* lds) {
    int tid_ = threadIdx.x; asm volatile("" : "+v"(tid_));
    const int tid = tid_, lane = tid & 63, wave = tid >> 6;
    const int kvh = unit & 1, bn = unit >> 1, n = bn & 15, b = bn >> 4;
    unsigned char* ws = p.ws; bf16_t* cols = (bf16_t*)(ws + WS_COLS);
    LAS bf16_t* Kl = (LAS bf16_t*)lds;
    LAS bf16_t* VTl = Kl + 256 * 72;
    const long krow0 = (long)b * T + (long)(n - 1) * 128;
    const int g = wave >> 1, hq = kvh * 4 + g;
    bf16x8 Qf[4][2]; u32x2 Zf[4][4];
#pragma unroll
    for (int qt = 0; qt < 4; ++qt) { const size_t qrow = (size_t)b * T + n * 128 + (wave & 1) * 64 + 16 * qt + (lane & 15);
#pragma unroll
        for (int kd = 0; kd < 2; ++kd) Qf[qt][kd] = *(const bf16x8*)(cols + qrow * NC + C_SWQ + hq * 64 + 32 * kd + 8 * (lane >> 4));
#pragma unroll
        for (int dt = 0; dt < 4; ++dt) Zf[qt][dt] = *(const u32x2*)(cols + qrow * NC + C_SWZ + hq * 64 + 16 * dt + 4 * (lane >> 4)); }
#pragma unroll
    for (int it = 0; it < 4; ++it) { const int pc = tid + 512 * it, kj = pc >> 3, cp = pc & 7;
        u32x4 kv = {0u, 0u, 0u, 0u}, vv = {0u, 0u, 0u, 0u};
        if (n > 0 || kj >= 128) { const bf16_t* rp = cols + (size_t)(krow0 + kj) * NC; kv = *(const u32x4*)(rp + C_SWK + kvh * 64 + cp * 8); vv = *(const u32x4*)(rp + C_SWV + kvh * 64 + cp * 8); }
        *(LAS u32x4*)(Kl + kj * 72 + cp * 8) = kv;
        const unsigned vw[4] = {vv.x, vv.y, vv.z, vv.w};
#pragma unroll
        for (int e = 0; e < 4; ++e) { VTl[(cp * 8 + 2 * e) * 264 + kj] = (bf16_t)(vw[e] & 0xffffu); VTl[(cp * 8 + 2 * e + 1) * 264 + kj] = (bf16_t)(vw[e] >> 16); } }
    LDS_BAR();
    {
        const float sink = p.sinks[l * 8 + hq];
#pragma unroll
        for (int qp2 = 0; qp2 < 2; ++qp2) {
            const int qi0 = (wave & 1) * 64 + 32 * qp2;
            const size_t qrow = (size_t)b * T + n * 128 + qi0;
            int kp_lo = (qi0 + 1) >> 5, kp_hi = (qi0 + 16 + 143) >> 5; if (kp_hi > 7) kp_hi = 7; if (n == 0 && kp_lo < 4) kp_lo = 4;
            attn_pair16<64, 256, true>(cols + qrow * NC + C_SWQ + hq * 64, cols + (qrow + 16) * NC + C_SWQ + hq * 64, Qf[2 * qp2], Qf[2 * qp2 + 1], Zf[2 * qp2], Zf[2 * qp2 + 1], Kl, VTl, kp_lo, kp_hi, 0.125f, sink, 1.f, qi0, qi0 + 16, n == 0, lane);
        }
    }
    LDS_BAR();
}

__device__ __forceinline__ void xmem_unit(const Params& p, int l, int unit, LAS unsigned char* lds) {
    int tid_ = threadIdx.x; asm volatile("" : "+v"(tid_));
    const int tid = tid_, lane = tid & 63, wave = tid >> 6;
    const int qb = unit & 7, hm = (unit >> 3) & 3, b = unit >> 5;
    unsigned char* ws = p.ws; bf16_t* cols = (bf16_t*)(ws + WS_COLS);
    const bf16_t* mkv = (const bf16_t*)(ws + WS_MEMKV) + (size_t)b * 256 * 1024;
    LAS bf16_t* Kl = (LAS bf16_t*)lds;
    LAS bf16_t* VTl = Kl + 256 * 136;
    bf16x8 Qf[2][4]; u32x2 Zf[2][8];
#pragma unroll
    for (int qt = 0; qt < 2; ++qt) { const size_t qrow = (size_t)b * T + qb * 256 + 32 * wave + 16 * qt + (lane & 15);
#pragma unroll
        for (int kd = 0; kd < 4; ++kd) Qf[qt][kd] = *(const bf16x8*)(cols + qrow * NC + C_XMQ + hm * 128 + 32 * kd + 8 * (lane >> 4));
#pragma unroll
        for (int dt = 0; dt < 8; ++dt) Zf[qt][dt] = *(const u32x2*)(cols + qrow * NC + C_XMZ + hm * 128 + 16 * dt + 4 * (lane >> 4)); }
#pragma unroll
    for (int it = 0; it < 8; ++it) { const int pc = tid + 512 * it, kj = pc >> 4, cp = pc & 15;
        const bf16_t* rp = mkv + (size_t)kj * 1024 + hm * 128 + cp * 8;
        const u32x4 kv = *(const u32x4*)rp, vv = *(const u32x4*)(rp + 512);
        *(LAS u32x4*)(Kl + kj * 136 + cp * 8) = kv;
        const unsigned vw[4] = {vv.x, vv.y, vv.z, vv.w};
#pragma unroll
        for (int e = 0; e < 4; ++e) { VTl[(cp * 8 + 2 * e) * 264 + kj] = (bf16_t)(vw[e] & 0xffffu); VTl[(cp * 8 + 2 * e + 1) * 264 + kj] = (bf16_t)(vw[e] >> 16); } }
    LDS_BAR();
    { const size_t qrow = (size_t)b * T + qb * 256 + 32 * wave;
      attn_pair16<128, 256, false>(cols + qrow * NC + C_XMQ + hm * 128, cols + (qrow + 16) * NC + C_XMQ + hm * 128, Qf[0], Qf[1], Zf[0], Zf[1], Kl, VTl, 0, 7, 0.08838834764831845f, -1e30f, 0.f, 0, 0, false, lane); }
    LDS_BAR();
}

#define XB_TMO      128
#define XB_XCNT(j)  (256  + 64 * (j))
#define XB_XSUB(j)  (1280 + 64 * (j))
#define XB_XGEN(j)  (2304 + 64 * (j))
#define XB_TOP      3328
#define XB_TOPGEN   3392
#define XCD_BAR_WORDS 3456
#define XB_SPIN_CAP (1u << 18)

__device__ __forceinline__ unsigned xb_ld(unsigned* p)              { return __hip_atomic_load(p, __ATOMIC_RELAXED, __HIP_MEMORY_SCOPE_AGENT); }
__device__ __forceinline__ unsigned xb_add(unsigned* p, unsigned v) { return __hip_atomic_fetch_add(p, v, __ATOMIC_RELAXED, __HIP_MEMORY_SCOPE_AGENT); }
__device__ __forceinline__ unsigned xb_xcc_id() { return (unsigned)__builtin_amdgcn_s_getreg((3 << 11) | 20) & 0xFu; }
#define XB_SPIN(cond, bar) do { unsigned _sp = 0; while (cond) { __builtin_amdgcn_s_sleep(1); \
    if ((++_sp & 255u) == 0u) { if (xb_ld(&(bar)[XB_TMO])) break; if (_sp > XB_SPIN_CAP) { atomicAdd(&(bar)[XB_TMO], 1u); break; } } } } while (0)

struct XcdBarrier {
    unsigned* bar; unsigned x;
    volatile LAS unsigned* st;
};

__device__ __forceinline__ XcdBarrier xcd_barrier_post(unsigned* bar, volatile LAS unsigned* st) {
    XcdBarrier b; b.bar = bar; b.x = xb_xcc_id(); b.st = st;
    if (threadIdx.x == 0) (void)xb_add(&bar[XB_XCNT(b.x)], 1u);
    return b;
}
__device__ __forceinline__ void xcd_barrier_complete(unsigned* bar, unsigned x, unsigned& nloc, unsigned& nx) {
    const unsigned G = gridDim.x * gridDim.y * gridDim.z;
    unsigned sum, cnt, mine, sp = 0u;
    for (;;) {
        sum = 0u; cnt = 0u; mine = 0u;
#pragma unroll
        for (unsigned j = 0; j < 16; ++j) { const unsigned c = xb_ld(&bar[XB_XCNT(j)]); sum += c; cnt += (c > 0u) ? 1u : 0u; mine = (j == x) ? c : mine; }
        if (sum == G) break;
        __builtin_amdgcn_s_sleep(1);
        if ((++sp & 255u) == 0u) { if (xb_ld(&bar[XB_TMO])) break; if (sp > XB_SPIN_CAP) { atomicAdd(&bar[XB_TMO], 1u); break; } }
    }
    nloc = mine > 0u ? mine : 1u; nx = cnt > 0u ? cnt : 1u;
}

__device__ __forceinline__ void xcd_barrier(const XcdBarrier& b) {
    asm volatile("s_waitcnt vmcnt(0)" ::: "memory");
    __syncthreads();
    if (threadIdx.x == 0) {
        unsigned* bar = b.bar;
        __builtin_amdgcn_s_waitcnt(0);
        unsigned nloc = b.st[0], nx = b.st[1];
        if (nloc == 0u) { xcd_barrier_complete(bar, b.x, nloc, nx); b.st[0] = nloc; b.st[1] = nx; }
        const unsigned old = xb_add(&bar[XB_XSUB(b.x)], 1u);
        const unsigned gen = old / nloc;
        if (old + 1u == (gen + 1u) * nloc) {
            __builtin_amdgcn_fence(__ATOMIC_RELEASE, "agent");
            asm volatile("s_waitcnt vmcnt(0)" ::: "memory");
            const unsigned og = xb_add(&bar[XB_TOP], 1u);
            const unsigned tg = og / nx;
            if (og + 1u == (tg + 1u) * nx) xb_add(&bar[XB_TOPGEN], 1u);
            else XB_SPIN(xb_ld(&bar[XB_TOPGEN]) == tg, bar);
            __builtin_amdgcn_fence(__ATOMIC_ACQUIRE, "agent");
            xb_add(&bar[XB_XGEN(b.x)], 1u);
            asm volatile("s_waitcnt vmcnt(0)" ::: "memory");
        } else {
            XB_SPIN(xb_ld(&bar[XB_XGEN(b.x)]) == gen, bar);
            __builtin_amdgcn_fence(__ATOMIC_ACQUIRE, "agent");
            asm volatile("s_waitcnt vmcnt(0)" ::: "memory");
        }
    }
    __syncthreads();
}


__global__ void __launch_bounds__(512) mega_fwd(Params p) {
    extern __shared__ __attribute__((aligned(16))) unsigned char lds_raw[];
    LAS unsigned char* lds = (LAS unsigned char*)lds_raw;
    const int G = gridDim.x, bx = blockIdx.x;
    const int vcu = (G % 8 == 0) ? (bx % 8) * (G / 8) + bx / 8 : bx;
    const Epi E{p.ws};
    unsigned* barw = (unsigned*)p.ws + 4096;
    volatile LAS unsigned* bst = (volatile LAS unsigned*)(lds + LDS_BYTES - 16);
    if (threadIdx.x == 0) { bst[0] = 0u; bst[1] = 0u; }
    __syncthreads();
    XcdBarrier bar = xcd_barrier_post(barw, bst);
#ifdef TSTAMP
    int nst = 0;
#define STAMP() do { if (bx == 0 && threadIdx.x == 0) ((unsigned long long*)p.ws)[nst] = __builtin_amdgcn_s_memrealtime(); ++nst; } while (0)
#else
#define STAMP() do {} while (0)
#endif
#define GRID_BAR() do { xcd_barrier(bar); STAMP(); } while (0)
    STAMP();
#pragma unroll 1
    for (int l = 0; l < 2; ++l) {
        p0_stage(p, l, lds);
        GRID_BAR();
#ifndef PROBE_REP
#define PROBE_REP 0
#endif
        for (int rep = 0; rep < ((PROBE_REP == 1 || PROBE_REP == 2) ? 2 : 1); ++rep) {
        { SchedA S{p.ws, G, bx}; pg8::gemm_phase<Epi, SchedA>(lds, S, E); }
        GRID_BAR();
        if (PROBE_REP == 1 && rep == 0) continue;
        for (int u = bx; u < 1024; u += G) delta_pre_unit(p, l, u, lds);
        GRID_BAR();
        if (G >= 64) {
            if (bx < 32) delta_scan_unit(p, l, bx, lds);
            else for (int u = bx - 32; u < 1024; u += G - 32) { if (u < 256) swa_unit(p, l, u, lds); else if (u < 512) xmem_unit(p, l, u - 256, lds); else gmlp_unit(p, l, u - 512, lds); }
        } else {
            for (int u = bx; u < 32 + 1024; u += G) { if (u < 32) delta_scan_unit(p, l, u, lds); else if (u < 288) swa_unit(p, l, u - 32, lds); else if (u < 544) xmem_unit(p, l, u - 288, lds); else gmlp_unit(p, l, u - 544, lds); }
        }
        GRID_BAR();
        }
        for (int rep = 0; rep < ((PROBE_REP == 3 || PROBE_REP == 4) ? 2 : 1); ++rep) {
        { SchedD S{p.ws, G, vcu}; pg8::gemm_phase<Epi, SchedD>(lds, S, E); }
        GRID_BAR();
        if (PROBE_REP == 3 && rep == 0) continue;
        { SchedE S{p.ws, G, vcu}; pg8::gemm_phase<Epi, SchedE>(lds, S, E); }
        GRID_BAR();
        }
    }
    p0_stage(p, 2, lds);
#ifdef TSTAMP
    __syncthreads();
    if (bx == 0 && threadIdx.x == 0) { const unsigned long long* st = (const unsigned long long*)p.ws; const float us = (float)(st[TS_B] - st[TS_A]) * 0.01f; p.out[0] += us * TS_SCALE; }
#endif
}

extern "C" void kernel_launch(void* const* d_in, const int* in_sizes, int n_in, void* d_out, int out_size, void* d_ws, size_t ws_size, hipStream_t stream) {
    static int grid = 0;
    if (grid == 0) {
        if (n_in != 17 || out_size != M * D || ws_size < WS_END) { fprintf(stderr, "kernel_launch: unexpected shapes / workspace (%d inputs, out %d, ws %zu)\n", n_in, out_size, ws_size); grid = -1; return; }
        int dev = 0, cus = 0, per_cu = 0;
        hipGetDevice(&dev);
        hipDeviceGetAttribute(&cus, hipDeviceAttributeMultiprocessorCount, dev);
        hipFuncSetAttribute((const void*)mega_fwd, hipFuncAttributeMaxDynamicSharedMemorySize, LDS_BYTES);
        hipOccupancyMaxActiveBlocksPerMultiprocessor(&per_cu, (const void*)mega_fwd, 512, LDS_BYTES);
        if (per_cu < 1) { fprintf(stderr, "kernel_launch: occupancy query reports %d blocks per CU\n", per_cu); (void)hipGetLastError(); per_cu = 1; }
        grid = cus * 1;
    }
    if (grid < 0) return;
    Params p{};
    p.x = (const float*)d_in[0]; p.mem = (const float*)d_in[1]; p.norm_pre = (const float*)d_in[2]; p.norm_post = (const float*)d_in[3]; p.norm_mem = (const float*)d_in[4];
    p.w_in = (const float*)d_in[5]; p.conv_w = (const float*)d_in[6]; p.a_log = (const float*)d_in[7]; p.dt_bias = (const float*)d_in[8]; p.dn_norm = (const float*)d_in[9];
    p.gm_norm = (const float*)d_in[10]; p.spatial_w = (const float*)d_in[11]; p.spatial_b = (const float*)d_in[12]; p.sinks = (const float*)d_in[13];
    p.w_mem_kv = (const float*)d_in[14]; p.w_up = (const float*)d_in[15]; p.w_out = (const float*)d_in[16];
    p.out = (float*)d_out; p.ws = (unsigned char*)d_ws;
    if (hipMemsetAsync((char*)d_ws + 16384, 0, XCD_BAR_WORDS * 4, stream) != hipSuccess) { fprintf(stderr, "kernel_launch: memset of the barrier words failed\n"); return; }
    void* args[] = {&p};
    hipError_t e = hipLaunchCooperativeKernel((const void*)mega_fwd, dim3(grid), dim3(512), args, LDS_BYTES, stream);
    if (e != hipSuccess) fprintf(stderr, "cooperative launch failed: %s (grid %d)\n", hipGetErrorString(e), grid);
}
```

```cpp
#include <hip/hip_runtime.h>
#include <hip/hip_cooperative_groups.h>
#include <cstdio>
#include <cstdint>
namespace cg = cooperative_groups;

#define LAS __attribute__((address_space(3)))
typedef unsigned short bf16_t;
typedef short bf16x8 __attribute__((ext_vector_type(8)));
typedef float f32x4 __attribute__((ext_vector_type(4)));
typedef unsigned u32x4 __attribute__((ext_vector_type(4)));
typedef unsigned u32x2 __attribute__((ext_vector_type(2)));

constexpr int NB = 8, T = 2048, M = NB * T, D = 1024, NC = 5888, DIN = 9992;
constexpr int C_DNQ = 0, C_DNK = 512, C_DNV = 1024, C_DNZ = 1536, C_GMU = 2048, C_GMV = 2560, C_GMZ = 3072, C_SWQ = 3584, C_SWK = 4096, C_SWV = 4224,
              C_SWZ = 4352, C_XMQ = 4864, C_XMZ = 5376;
constexpr float EPS = 1e-6f;
constexpr size_t MiB = 1u << 20;
constexpr size_t WS_WINT = 1 * MiB, WS_WGT = WS_WINT + 12058624, WS_WUPT = WS_WGT + 8 * MiB, WS_WOUTT = WS_WUPT + 4 * MiB, WS_WMKVT = WS_WOUTT + 2 * MiB,
                 WS_SPW = WS_WMKVT + 2 * MiB;
constexpr size_t WS_H = 29 * MiB, WS_COLS = 61 * MiB, WS_OUT = WS_COLS, WS_X = 245 * MiB;
constexpr size_t WS_WA_W = WS_X, WS_WA_A = WS_X + 16 * MiB, WS_HALO = WS_X + 24 * MiB, WS_SM = WS_X + 27 * MiB, WS_DL = WS_SM + 512 * 1024,
                 WS_MEMN = WS_X + 28 * MiB, WS_MEMKV = WS_X + 32 * MiB, WS_GSCR = WS_X, WS_MERGED = WS_X + 32 * MiB, WS_END = 309 * MiB;
constexpr int LDS_BYTES = 155648;

struct Params {
    const float *x, *mem, *norm_pre, *norm_post, *norm_mem, *w_in, *conv_w, *a_log, *dt_bias, *dn_norm, *gm_norm, *spatial_w, *spatial_b, *sinks, *w_mem_kv,
        *w_up, *w_out;
    float* out;
    unsigned char* ws;
};

__device__ __forceinline__ unsigned f2bf(float f) { unsigned u = __float_as_uint(f); return (u + 0x7fffu + ((u >> 16) & 1u)) >> 16; }
__device__ __forceinline__ float bf2f(unsigned b) { return __uint_as_float(b << 16); }
typedef float f32x2_t __attribute__((ext_vector_type(2)));
typedef __bf16 bf16x2_t __attribute__((ext_vector_type(2)));
__device__ __forceinline__ unsigned cvt_pk_bf16(float lo, float hi) { const f32x2_t v = {lo, hi}; return __builtin_bit_cast(unsigned, __builtin_convertvector(v, bf16x2_t)); }
__device__ __forceinline__ float lo_bf(unsigned w) { return __uint_as_float(w << 16); }
__device__ __forceinline__ float hi_bf(unsigned w) { return __uint_as_float(w & 0xffff0000u); }
__device__ __forceinline__ float wave_sum(float v) {
#pragma unroll
    for (int o = 1; o < 64; o <<= 1) v += __shfl_xor(v, o);
    return v;
}
__device__ __forceinline__ float silu_f(float y) { return y * __builtin_amdgcn_rcpf(1.f + __expf(-y)); }
__device__ __forceinline__ float sigmoid_f(float y) { return __builtin_amdgcn_rcpf(1.f + __expf(-y)); }
__device__ __forceinline__ float gelu_tanh_f(float x) {
    const float u = 0.7978845608f * (x + 0.044715f * x * x * x);
    return x * __builtin_amdgcn_rcpf(1.f + __expf(-2.f * u));
}
__device__ __forceinline__ float silu_fast(float y) { return y * __builtin_amdgcn_rcpf(1.f + __expf(-y)); }
__device__ __forceinline__ float sigmoid_fast(float y) { return __builtin_amdgcn_rcpf(1.f + __expf(-y)); }
__device__ __forceinline__ float gelu_fast(float x) { const float u = 0.7978845608f * (x + 0.044715f * x * x * x); return x * __builtin_amdgcn_rcpf(1.f + __expf(-2.f * u)); }
__device__ __forceinline__ bf16x8 pack8(const f32x4 a, const f32x4 b) {
    u32x4 w; w.x = cvt_pk_bf16(a[0], a[1]); w.y = cvt_pk_bf16(a[2], a[3]); w.z = cvt_pk_bf16(b[0], b[1]); w.w = cvt_pk_bf16(b[2], b[3]);
    return __builtin_bit_cast(bf16x8, w);
}
__device__ __forceinline__ bf16x8 lds_ld2x8(const LAS unsigned char* pl) {
    const u32x2 lo = *(const LAS u32x2*)pl, hi = *(const LAS u32x2*)(pl + 32);
    u32x4 w; w.x = lo.x; w.y = lo.y; w.z = hi.x; w.w = hi.y; return __builtin_bit_cast(bf16x8, w);
}
#define LDS_BAR() asm volatile("s_waitcnt lgkmcnt(0)\n\ts_barrier" ::: "memory")
__device__ __forceinline__ int kperm32(int o) { return (o < 16) ? (8 * (o >> 2) + (o & 3)) : (8 * ((o - 16) >> 2) + 4 + (o & 3)); }
#define MFMA16(a, b, c) __builtin_amdgcn_mfma_f32_16x16x32_bf16((a), (b), (c), 0, 0, 0)

namespace pg8 {
constexpr int BM = 256, BK = 64, HALF = 128, HTB = HALF * BK * 2, STAGE_BYTES = 8 * HTB;
__device__ __forceinline__ int lds_byte(int r, int c) { const int st = (r >> 4) * 2 + (c >> 5), rr = r & 15, cc = c & 31, ob = rr * 64 + cc * 2; return st * 1024 + (ob ^ (((ob >> 9) & 1) << 5)); }
__device__ __forceinline__ void stage_rc(int b, int& R, int& C) { const int st = b / 1024, sb = b % 1024, swz = sb ^ (((sb >> 9) & 1) << 5); R = (st >> 1) * 16 + swz / 64; C = (st & 1) * 32 + (swz % 64) / 2; }
__device__ __forceinline__ int perm32(int rho) { const int n = rho >> 4, i = rho & 15; return 8 * (i >> 2) + 4 * n + (i & 3); }

struct Unit { const char* a; const char* b; unsigned lda, ldb; int nt; int pm, pn, kind, sub; };

__device__ __forceinline__ void mkoff(const Unit& u, int tid, unsigned (&vA)[2], unsigned (&vB)[2]) {
#pragma unroll
    for (int i = 0; i < 2; ++i) { int R, C; stage_rc(tid * 16 + i * 8192, R, C); const int Rb = (R & ~31) + perm32(R & 31);
        vA[i] = (unsigned)(R * u.lda + C) * 2u; vB[i] = (unsigned)(Rb * u.ldb + C) * 2u; }
}

template <class Epi, class Sched>
__device__ __forceinline__ void gemm_phase(LAS unsigned char* lds, const Sched& S, const Epi& E) {
    int tid_ = threadIdx.x; asm volatile("" : "+v"(tid_));
    const int tid = tid_, wid = __builtin_amdgcn_readfirstlane(tid >> 6), lane = tid & 63, wr = wid >> 2, wc = wid & 3, fr = lane & 15, fq = lane >> 4;
    const size_t kstep = (size_t)(BK * 2);
    const unsigned ldsw = (unsigned)wid * 1024u;
    const int aoff = lds_byte(wr * 64 + fr, fq * 8), boff = lds_byte(wc * 32 + fr, fq * 8);
#define PG8_SA(b, h) (((b) * 2 + (h)) * HTB)
#define PG8_SB(b, h) ((4 + (b) * 2 + (h)) * HTB)
#define PG8_STAGE(bufoff, gbase, voff) do { _Pragma("unroll") for (int _i = 0; _i < 2; ++_i) \
        __builtin_amdgcn_global_load_lds((const unsigned*)((const char*)(gbase) + (voff)[_i]), (LAS unsigned*)(lds + (bufoff) + ldsw + _i * 8192), 16, 0, 0); } while (0)
#define PG8_LDA(dst, b, h) do { _Pragma("unroll") for (int m = 0; m < 4; ++m) _Pragma("unroll") for (int k = 0; k < 2; ++k) dst[m][k] = *(const LAS bf16x8*)(lds + PG8_SA(b, h) + aoff + m * 2048 + k * 1024); } while (0)
#define PG8_LDB(dst, b, h) do { _Pragma("unroll") for (int n = 0; n < 2; ++n) _Pragma("unroll") for (int k = 0; k < 2; ++k) dst[n][k] = *(const LAS bf16x8*)(lds + PG8_SB(b, h) + boff + n * 2048 + k * 1024); } while (0)
#define PG8_MMA(ai, bj, At, Bt) do { __builtin_amdgcn_s_setprio(1); _Pragma("unroll") for (int m = 0; m < 4; ++m) _Pragma("unroll") for (int n = 0; n < 2; ++n) _Pragma("unroll") for (int k = 0; k < 2; ++k) \
        acc[ai][bj][m][n] = __builtin_amdgcn_mfma_f32_16x16x32_bf16(Bt[n][k], At[m][k], acc[ai][bj][m][n], 0, 0, 0); __builtin_amdgcn_s_setprio(0); } while (0)
#define PG8_WAIT_V(n) asm volatile("s_waitcnt vmcnt(" #n ")" ::: "memory")
#define PG8_WAIT_L(n) asm volatile("s_waitcnt lgkmcnt(" #n ")" ::: "memory")
#define PG8_BAR __builtin_amdgcn_s_barrier()
#define PG8_SCHED __builtin_amdgcn_sched_barrier(0)
    Unit cur, nxt; int ui = 0;
    if (!S.next(0, cur)) return;
    f32x4 acc[2][2][4][2];
#pragma unroll
    for (int a = 0; a < 2; ++a)
#pragma unroll
        for (int b = 0; b < 2; ++b)
#pragma unroll
            for (int m = 0; m < 4; ++m)
#pragma unroll
                for (int n = 0; n < 2; ++n) acc[a][b][m][n] = (f32x4){0.f, 0.f, 0.f, 0.f};
    bf16x8 At[4][2], B0[2][2], B1[2][2];
    unsigned vAc[2], vBc[2], vAn[2], vBn[2];
    mkoff(cur, tid, vAc, vBc);
    const char* cA = cur.a; const char* cB = cur.b;
    size_t hAc = (size_t)HALF * cur.lda * 2, hBc = (size_t)HALF * cur.ldb * 2;
    PG8_STAGE(PG8_SB(0, 0), cB, vBc); PG8_STAGE(PG8_SB(0, 1), cB + hBc, vBc); PG8_STAGE(PG8_SA(0, 0), cA, vAc); PG8_STAGE(PG8_SA(0, 1), cA + hAc, vAc);
    if (wr == 1) PG8_BAR;
    PG8_WAIT_V(2); PG8_BAR;
    PG8_STAGE(PG8_SB(1, 0), cB + kstep, vBc); PG8_STAGE(PG8_SA(1, 0), cA + kstep, vAc); PG8_STAGE(PG8_SB(1, 1), cB + hBc + kstep, vBc);
    PG8_WAIT_V(6); PG8_BAR;
    for (;;) {
        const bool has_next = S.next(ui + 1, nxt);
        const char* nA = cA; const char* nB = cB; size_t hAn = hAc, hBn = hBc;
        vAn[0] = vAc[0]; vAn[1] = vAc[1]; vBn[0] = vBc[0]; vBn[1] = vBc[1];
        if (has_next) { nA = nxt.a; nB = nxt.b; mkoff(nxt, tid, vAn, vBn); hAn = (size_t)HALF * nxt.lda * 2; hBn = (size_t)HALF * nxt.ldb * 2; }
        const int nt = cur.nt;
        for (int t = 0; t < nt; t += 2) {
            const bool last = (t == nt - 2);
            const char* a1 = cA + (size_t)(t + 1) * kstep;
            const char* a2 = last ? nA : cA + (size_t)(t + 2) * kstep; const char* b2 = last ? nB : cB + (size_t)(t + 2) * kstep;
            const char* a3 = a2 + kstep; const char* b3 = b2 + kstep;
            unsigned vA2[2], vB2[2];
            vA2[0] = last ? vAn[0] : vAc[0]; vA2[1] = last ? vAn[1] : vAc[1]; vB2[0] = last ? vBn[0] : vBc[0]; vB2[1] = last ? vBn[1] : vBc[1];
            const size_t hA2 = last ? hAn : hAc, hB2 = last ? hBn : hBc;
            PG8_LDB(B0, 0, 0); PG8_LDB(B1, 0, 1); PG8_SCHED; PG8_LDA(At, 0, 0); PG8_STAGE(PG8_SA(1, 1), a1 + hAc, vAc);
            PG8_WAIT_V(8); PG8_WAIT_L(0); PG8_BAR; PG8_MMA(0, 0, At, B0); PG8_MMA(0, 1, At, B1); PG8_BAR; PG8_SCHED;
            PG8_LDA(At, 0, 1); PG8_STAGE(PG8_SB(0, 0), b2, vB2); PG8_STAGE(PG8_SB(0, 1), b2 + hB2, vB2); PG8_STAGE(PG8_SA(0, 0), a2, vA2);
            PG8_WAIT_V(8); PG8_WAIT_L(0); PG8_BAR; PG8_MMA(1, 0, At, B0); PG8_MMA(1, 1, At, B1); PG8_BAR; PG8_SCHED;
            PG8_LDB(B0, 1, 0); PG8_LDB(B1, 1, 1); PG8_SCHED; PG8_LDA(At, 1, 0); PG8_STAGE(PG8_SA(0, 1), a2 + hA2, vA2);
            PG8_WAIT_V(8); PG8_WAIT_L(0); PG8_BAR; PG8_MMA(0, 0, At, B0); PG8_MMA(0, 1, At, B1); PG8_BAR; PG8_SCHED;
            PG8_LDA(At, 1, 1); PG8_STAGE(PG8_SB(1, 0), b3, vB2); PG8_STAGE(PG8_SB(1, 1), b3 + hB2, vB2); PG8_STAGE(PG8_SA(1, 0), a3, vA2);
            PG8_WAIT_V(8); PG8_WAIT_L(0); PG8_BAR; PG8_MMA(1, 0, At, B0); PG8_MMA(1, 1, At, B1); PG8_BAR; PG8_SCHED;
        }
        if (wr == 0) PG8_BAR;
        E(acc, cur, wr, wc, fr, fq, tid);
        if (!has_next) break;
#pragma unroll
        for (int a = 0; a < 2; ++a)
#pragma unroll
            for (int b = 0; b < 2; ++b)
#pragma unroll
                for (int m = 0; m < 4; ++m)
#pragma unroll
                    for (int n = 0; n < 2; ++n) acc[a][b][m][n] = (f32x4){0.f, 0.f, 0.f, 0.f};
        cur = nxt; cA = nA; cB = nB; hAc = hAn; hBc = hBn; vAc[0] = vAn[0]; vAc[1] = vAn[1]; vBc[0] = vBn[0]; vBc[1] = vBn[1]; ++ui;
        if (wr == 1) PG8_BAR;
    }
    PG8_WAIT_V(0);
    PG8_BAR;
#undef PG8_SA
#undef PG8_SB
#undef PG8_STAGE
#undef PG8_LDA
#undef PG8_LDB
#undef PG8_MMA
#undef PG8_WAIT_V
#undef PG8_WAIT_L
#undef PG8_BAR
#undef PG8_SCHED
}
}
using pg8::Unit;

struct Epi {
    unsigned char* ws;
    __device__ __forceinline__ void operator()(const f32x4 (&acc)[2][2][4][2], const Unit& u, int wr, int wc, int fr, int fq, int tid) const {
        asm volatile("" : "+v"(tid), "+v"(fr), "+v"(fq));
        const int row0 = u.pm * 256 + wr * 64 + fr, col0 = u.pn * 256 + wc * 32 + 8 * fq;
        if (u.kind == 0) {
            bf16_t* cols = (bf16_t*)(ws + WS_COLS); bf16_t* halo = (bf16_t*)(ws + WS_HALO);
            const int pn = u.pn;
            const int act = (pn == 6 || pn == 7 || pn == 12 || pn == 13 || pn == 17 || pn == 18 || pn >= 21) ? 1 : ((pn >= 8 && pn <= 11) ? 2 : 0);
#pragma unroll
            for (int ai = 0; ai < 2; ++ai)
#pragma unroll
                for (int m = 0; m < 4; ++m) {
                    const int r = row0 + ai * 128 + m * 16;
                    bf16_t* rowp = cols + (size_t)r * NC + col0;
#pragma unroll
                    for (int bj = 0; bj < 2; ++bj) {
                        f32x4 v0 = acc[ai][bj][m][0], v1 = acc[ai][bj][m][1];
                        if (act == 1) {
#pragma unroll
                            for (int e = 0; e < 4; ++e) { v0[e] = silu_fast(v0[e]); v1[e] = silu_fast(v1[e]); }
                        } else if (act == 2) {
#pragma unroll
                            for (int e = 0; e < 4; ++e) { v0[e] = gelu_fast(v0[e]); v1[e] = gelu_fast(v1[e]); }
                        }
                        u32x4 w; w.x = cvt_pk_bf16(v0[0], v0[1]); w.y = cvt_pk_bf16(v0[2], v0[3]); w.z = cvt_pk_bf16(v1[0], v1[1]); w.w = cvt_pk_bf16(v1[2], v1[3]);
                        *(u32x4*)(rowp + bj * 128) = w;
                        if (pn < 6 && (r & 63) >= 61) *(u32x4*)(halo + ((size_t)(r >> 6) * 3 + ((r & 63) - 61)) * 1536 + col0 + bj * 128) = w;
                    }
                }
        } else if (u.kind == 1) {
            bf16_t* o = (bf16_t*)(ws + WS_MEMKV);
#pragma unroll
            for (int ai = 0; ai < 2; ++ai)
#pragma unroll
                for (int m = 0; m < 4; ++m) {
                    bf16_t* rowp = o + (size_t)(row0 + ai * 128 + m * 16) * 1024 + col0;
#pragma unroll
                    for (int bj = 0; bj < 2; ++bj) {
                        const f32x4 v0 = acc[ai][bj][m][0], v1 = acc[ai][bj][m][1];
                        u32x4 w; w.x = cvt_pk_bf16(v0[0], v0[1]); w.y = cvt_pk_bf16(v0[2], v0[3]); w.z = cvt_pk_bf16(v1[0], v1[1]); w.w = cvt_pk_bf16(v1[2], v1[3]);
                        *(u32x4*)(rowp + bj * 128) = w;
                    }
                }
        } else if (u.kind == 2) {
            u32x4* g = (u32x4*)(ws + WS_GSCR) + (size_t)(u.pm * 4 + u.pn) * 16 * 512 + tid;
#pragma unroll
            for (int ai = 0; ai < 2; ++ai)
#pragma unroll
                for (int m = 0; m < 4; ++m)
#pragma unroll
                    for (int bj = 0; bj < 2; ++bj) {
                        const f32x4 v0 = acc[ai][bj][m][0], v1 = acc[ai][bj][m][1];
                        u32x4 w; w.x = cvt_pk_bf16(v0[0], v0[1]); w.y = cvt_pk_bf16(v0[2], v0[3]);
                        w.z = cvt_pk_bf16(v1[0], v1[1]); w.w = cvt_pk_bf16(v1[2], v1[3]);
                        g[(size_t)((ai * 4 + m) * 2 + bj) * 512] = w;
                    }
        } else if (u.kind == 3) {
            const unsigned char* gb = ws + WS_GSCR + (size_t)(u.pm * 4 + u.pn) * 16 * 512 * 16;
            unsigned char* mb = ws + WS_MERGED + (size_t)u.pm * 256 * 2048 + (size_t)u.pn * 512;
            const unsigned gvo = (unsigned)tid * 16u, mvo = (unsigned)((wr * 64 + fr) * 2048 + (wc * 32 + 8 * fq) * 2);
            u32x4 gwn[2];
            gwn[0] = *(const u32x4*)(gb + gvo); gwn[1] = *(const u32x4*)(gb + 8192 + gvo);
#pragma unroll
            for (int sp = 0; sp < 8; ++sp) {
                const int ai = sp >> 2, m = sp & 3;
                u32x4 gw[2], pw[2];
                gw[0] = gwn[0]; gw[1] = gwn[1];
#pragma unroll
                for (int k = 0; k < 2; ++k) { pw[k] = (u32x4){0u, 0u, 0u, 0u};
                    if (u.sub > 0) pw[k] = *(const u32x4*)(mb + (size_t)(ai * 128 + m * 16) * 2048 + k * 256 + mvo); }
                if (sp + 1 < 8) { gwn[0] = *(const u32x4*)(gb + (size_t)(2 * (sp + 1)) * 8192 + gvo); gwn[1] = *(const u32x4*)(gb + (size_t)(2 * (sp + 1) + 1) * 8192 + gvo); }
#pragma unroll
                for (int k = 0; k < 2; ++k) { const int bj = k;
                    const f32x4 v0 = acc[ai][bj][m][0], v1 = acc[ai][bj][m][1];
                    const float r0 = sigmoid_fast(lo_bf(gw[k].x)) * v0[0] + lo_bf(pw[k].x), r1 = sigmoid_fast(hi_bf(gw[k].x)) * v0[1] + hi_bf(pw[k].x), r2 = sigmoid_fast(lo_bf(gw[k].y)) * v0[2] + lo_bf(pw[k].y), r3 = sigmoid_fast(hi_bf(gw[k].y)) * v0[3] + hi_bf(pw[k].y);
                    const float r4 = sigmoid_fast(lo_bf(gw[k].z)) * v1[0] + lo_bf(pw[k].z), r5 = sigmoid_fast(hi_bf(gw[k].z)) * v1[1] + hi_bf(pw[k].z), r6 = sigmoid_fast(lo_bf(gw[k].w)) * v1[2] + lo_bf(pw[k].w), r7 = sigmoid_fast(hi_bf(gw[k].w)) * v1[3] + hi_bf(pw[k].w);
                    u32x4 w; w.x = cvt_pk_bf16(r0, r1); w.y = cvt_pk_bf16(r2, r3); w.z = cvt_pk_bf16(r4, r5); w.w = cvt_pk_bf16(r6, r7);
                    *(u32x4*)(mb + (size_t)(ai * 128 + m * 16) * 2048 + bj * 256 + mvo) = w; }
                asm volatile("" ::: "memory");
            }
        } else {
            bf16_t* o = (bf16_t*)(ws + WS_OUT);
#pragma unroll
            for (int ai = 0; ai < 2; ++ai)
#pragma unroll
                for (int m = 0; m < 4; ++m) {
                    bf16_t* rowp = o + (size_t)(row0 + ai * 128 + m * 16) * 1024 + col0;
#pragma unroll
                    for (int bj = 0; bj < 2; ++bj) { const f32x4 v0 = acc[ai][bj][m][0], v1 = acc[ai][bj][m][1];
                        u32x4 w; w.x = cvt_pk_bf16(v0[0], v0[1]); w.y = cvt_pk_bf16(v0[2], v0[3]); w.z = cvt_pk_bf16(v1[0], v1[1]); w.w = cvt_pk_bf16(v1[2], v1[3]);
                        *(u32x4*)(rowp + bj * 128) = w; }
                }
        }
    }
};

struct SchedA {
    const unsigned char* ws; int G, c;
    __device__ __forceinline__ bool next(int i, Unit& u) const {
        const int L = i * G + c;
        constexpr int nN = 23, nwg = 64 * nN;
        if (L < nwg) {
            int wgid = L; { const int q = nwg / 8, xcd = wgid % 8, off = wgid / 8; wgid = xcd * q + off; }
            const int nig = 8 * nN, gid = wgid / nig, fm = gid * 8;
            u.pm = fm + ((wgid % nig) % 8); u.pn = (wgid % nig) / 8; u.kind = 0; u.sub = 0; u.lda = 1024; u.ldb = 1024; u.nt = 16;
            u.a = (const char*)(ws + WS_H) + (size_t)u.pm * 256 * 1024 * 2; u.b = (const char*)(ws + WS_WINT) + (size_t)u.pn * 256 * 1024 * 2;
            return true;
        }
        const int r = L - nwg; if (r >= 32) return false;
        u.pm = r >> 2; u.pn = r & 3; u.kind = 1; u.sub = 0; u.lda = 1024; u.ldb = 1024; u.nt = 16;
        u.a = (const char*)(ws + WS_MEMN) + (size_t)u.pm * 256 * 1024 * 2; u.b = (const char*)(ws + WS_WMKVT) + (size_t)u.pn * 256 * 1024 * 2;
        return true;
    }
};
struct SchedD {
    const unsigned char* ws; int G, vcu;
    __device__ __forceinline__ bool next(int i, Unit& u) const {
        const int tile = vcu + (i >> 3) * G; if (tile >= 256) return false;
        const int sub = i & 7, n = sub >> 1;
        u.pm = tile >> 2; u.pn = tile & 3; u.sub = n;
        if ((sub & 1) == 0) { u.kind = 2; u.lda = 1024; u.ldb = 1024; u.nt = 16;
            u.a = (const char*)(ws + WS_H) + (size_t)u.pm * 256 * 1024 * 2; u.b = (const char*)(ws + WS_WGT) + (size_t)(n * 1024 + u.pn * 256) * 1024 * 2;
        } else { u.kind = 3; u.lda = NC; u.ldb = 512; u.nt = 8;
            const int yoff = n == 0 ? C_DNZ : (n == 1 ? C_GMU : (n == 2 ? C_SWQ : C_XMQ));
            u.a = (const char*)(ws + WS_COLS) + ((size_t)u.pm * 256 * NC + yoff) * 2; u.b = (const char*)(ws + WS_WUPT) + (size_t)(n * 1024 + u.pn * 256) * 512 * 2; }
        return true;
    }
};
struct SchedE {
    const unsigned char* ws; int G, vcu;
    __device__ __forceinline__ bool next(int i, Unit& u) const {
        const int tile = vcu + i * G; if (tile >= 256) return false;
        u.pm = tile >> 2; u.pn = tile & 3; u.kind = 4; u.sub = 0; u.lda = 1024; u.ldb = 1024; u.nt = 16;
        u.a = (const char*)(ws + WS_MERGED) + (size_t)u.pm * 256 * 1024 * 2; u.b = (const char*)(ws + WS_WOUTT) + (size_t)u.pn * 256 * 1024 * 2;
        return true;
    }
};

__device__ __forceinline__ void tr_item(const float* W, int ldw, int k0, bf16_t* WT, int Kdst, LAS float* scr, int lane) {
    float tv[32];
#pragma unroll
    for (int i = 0; i < 32; ++i) tv[i] = __builtin_nontemporal_load(&W[(size_t)(k0 + 2 * i + (lane >> 5)) * ldw + (lane & 31)]);
#pragma unroll
    for (int i = 0; i < 32; ++i) scr[(2 * i + (lane >> 5)) * 33 + (lane & 31)] = tv[i];
    asm volatile("s_waitcnt lgkmcnt(0)" ::: "memory");
    const int c = lane & 7;
#pragma unroll
    for (int j = 0; j < 4; ++j) { const int n = (lane >> 3) + 8 * j; const LAS float* s = scr + (8 * c) * 33 + n;
        u32x4 o; o.x = cvt_pk_bf16(s[0 * 33], s[1 * 33]); o.y = cvt_pk_bf16(s[2 * 33], s[3 * 33]); o.z = cvt_pk_bf16(s[4 * 33], s[5 * 33]); o.w = cvt_pk_bf16(s[6 * 33], s[7 * 33]);
        *(u32x4*)(WT + (size_t)n * Kdst + k0 + 8 * c) = o; }
    asm volatile("s_waitcnt lgkmcnt(0)" ::: "memory");
}

__device__ __forceinline__ void p0_stage(const Params& p, int rk, LAS unsigned char* lds) {
    int tid_ = threadIdx.x; asm volatile("" : "+v"(tid_));
    const int tid = tid_, lane = tid & 63, wave = tid >> 6;
    const int gw = blockIdx.x * 8 + wave, NGW = gridDim.x * 8;
    unsigned char* ws = p.ws;
    LAS float* W8T = (LAS float*)(lds + 8 * 8448);
    if (rk <= 1) {
        const int l = rk;
        const float* win = p.w_in + (size_t)l * 1024 * DIN;
        {   f32x4 wv[4];
#pragma unroll
            for (int t2 = 0; t2 < 2; ++t2) { const float* wp = win + (size_t)(tid + 512 * t2) * DIN + 2048; wv[2 * t2] = *(const f32x4*)wp; wv[2 * t2 + 1] = *(const f32x4*)(wp + 4); }
#pragma unroll
            for (int t2 = 0; t2 < 2; ++t2)
#pragma unroll
                for (int j = 0; j < 8; ++j) W8T[j * 1024 + tid + 512 * t2] = wv[2 * t2 + (j >> 2)][j & 3]; }
        LAS float* scr = (LAS float*)(lds + wave * 8448);
        for (int it = gw; it < 7040; it += NGW) {
            if (it < 2944) { const int kb = it / 184, nb = it % 184, n0 = 32 * nb, sc = n0 < 2048 ? n0 : n0 + 8;
                tr_item(win + sc, DIN, 64 * kb, (bf16_t*)(ws + WS_WINT) + (size_t)n0 * 1024, 1024, scr, lane);
            } else if (it < 4992) { const int r = it - 2944, kb = r / 128, nb = r % 128;
                tr_item(win + 5896 + 32 * nb, DIN, 64 * kb, (bf16_t*)(ws + WS_WGT) + (size_t)(32 * nb) * 1024, 1024, scr, lane);
            } else if (it < 6016) { const int r = it - 4992, n = r / 256, r2 = r % 256, kb = r2 / 32, nb = r2 % 32;
                tr_item(p.w_up + (size_t)(l * 4 + n) * 512 * 1024 + 32 * nb, 1024, 64 * kb, (bf16_t*)(ws + WS_WUPT) + (size_t)(n * 1024 + 32 * nb) * 512, 512, scr, lane);
            } else if (it < 6528) { const int r = it - 6016, kb = r / 32, nb = r % 32;
                tr_item(p.w_out + (size_t)l * 1024 * 1024 + 32 * nb, 1024, 64 * kb, (bf16_t*)(ws + WS_WOUTT) + (size_t)(32 * nb) * 1024, 1024, scr, lane);
            } else { const int r = it - 6528, kb = r / 32, nb = r % 32;
                tr_item(p.w_mem_kv + (size_t)l * 1024 * 1024 + 32 * nb, 1024, 64 * kb, (bf16_t*)(ws + WS_WMKVT) + (size_t)(32 * nb) * 1024, 1024, scr, lane);
            }
        }
        for (int e = blockIdx.x * 512 + tid; e < 65536; e += gridDim.x * 512) { const int pp = (e >> 7) & 127, qq = e & 127;
            ((bf16_t*)(ws + WS_SPW))[e] = (bf16_t)(qq <= pp ? f2bf(p.spatial_w[(size_t)l * 65536 + e]) : 0u); }
        for (int r = gw; r < 2048; r += NGW) {
            const f32x4* xr = (const f32x4*)(p.mem + (size_t)r * D) + lane; const f32x4* gr = (const f32x4*)(p.norm_mem + l * D) + lane;
            f32x4 v[4]; float ss = 0.f;
#pragma unroll
            for (int j = 0; j < 4; ++j) { v[j] = xr[64 * j]; ss += v[j][0] * v[j][0] + v[j][1] * v[j][1] + v[j][2] * v[j][2] + v[j][3] * v[j][3]; }
            const float rstd = rsqrtf(wave_sum(ss) * (1.f / D) + EPS);
            u32x2* o = (u32x2*)((bf16_t*)(ws + WS_MEMN) + (size_t)r * D) + lane;
#pragma unroll
            for (int j = 0; j < 4; ++j) { const f32x4 g = gr[64 * j]; u32x2 w; w.x = cvt_pk_bf16(v[j][0] * rstd * g[0], v[j][1] * rstd * g[1]); w.y = cvt_pk_bf16(v[j][2] * rstd * g[2], v[j][3] * rstd * g[3]); o[64 * j] = w; }
        }
    }
    __syncthreads();
    const float* xin = rk == 2 ? p.out : p.x;
    for (int row0 = gw; row0 < M; row0 += 2 * NGW) {
        f32x4 v[2][4], o[2][4];
#pragma unroll
        for (int rr = 0; rr < 2; ++rr) { const int row = row0 + rr * NGW;
            const f32x4* xr = (const f32x4*)(xin + (size_t)row * D) + lane;
#pragma unroll
            for (int j = 0; j < 4; ++j) v[rr][j] = __builtin_nontemporal_load(&xr[64 * j]);
            if (rk >= 1) { const u32x2* orow = (const u32x2*)((const bf16_t*)(ws + WS_OUT) + (size_t)row * D) + lane;
#pragma unroll
                for (int j = 0; j < 4; ++j) { const u32x2 ow = orow[64 * j]; o[rr][j] = (f32x4){lo_bf(ow.x), hi_bf(ow.x), lo_bf(ow.y), hi_bf(ow.y)}; } } }
        if (rk >= 1) {
            const f32x4* gr = (const f32x4*)(p.norm_post + (rk - 1) * D) + lane;
            float ss[2] = {0.f, 0.f};
#pragma unroll
            for (int rr = 0; rr < 2; ++rr)
#pragma unroll
                for (int j = 0; j < 4; ++j) ss[rr] += o[rr][j][0] * o[rr][j][0] + o[rr][j][1] * o[rr][j][1] + o[rr][j][2] * o[rr][j][2] + o[rr][j][3] * o[rr][j][3];
#pragma unroll
            for (int of = 1; of < 64; of <<= 1) { ss[0] += __shfl_xor(ss[0], of); ss[1] += __shfl_xor(ss[1], of); }
#pragma unroll
            for (int rr = 0; rr < 2; ++rr) { const float rstd = rsqrtf(ss[rr] * (1.f / D) + EPS);
                f32x4* dst = (f32x4*)(p.out + (size_t)(row0 + rr * NGW) * D) + lane;
#pragma unroll
                for (int j = 0; j < 4; ++j) { const f32x4 g = gr[64 * j]; v[rr][j] = v[rr][j] + o[rr][j] * rstd * g; dst[64 * j] = v[rr][j]; } }
        }
        if (rk <= 1) {
            const f32x4* gr = (const f32x4*)(p.norm_pre + rk * D) + lane;
            float ss[2] = {0.f, 0.f};
#pragma unroll
            for (int rr = 0; rr < 2; ++rr)
#pragma unroll
                for (int j = 0; j < 4; ++j) ss[rr] += v[rr][j][0] * v[rr][j][0] + v[rr][j][1] * v[rr][j][1] + v[rr][j][2] * v[rr][j][2] + v[rr][j][3] * v[rr][j][3];
#pragma unroll
            for (int of = 1; of < 64; of <<= 1) { ss[0] += __shfl_xor(ss[0], of); ss[1] += __shfl_xor(ss[1], of); }
            LAS float* red = (LAS float*)(lds + 8 * 8448 + 32768) + wave * 1024;
#pragma unroll
            for (int rr = 0; rr < 2; ++rr) { const float rstd = rsqrtf(ss[rr] * (1.f / D) + EPS);
                u32x2* oh = (u32x2*)((bf16_t*)(ws + WS_H) + (size_t)(row0 + rr * NGW) * D) + lane;
#pragma unroll
                for (int j = 0; j < 4; ++j) { const f32x4 g = gr[64 * j]; v[rr][j] = v[rr][j] * rstd * g; u32x2 w; w.x = cvt_pk_bf16(v[rr][j][0], v[rr][j][1]); w.y = cvt_pk_bf16(v[rr][j][2], v[rr][j][3]); oh[64 * j] = w; }
#pragma unroll
                for (int jj = 0; jj < 8; ++jj) { float a = 0.f;
#pragma unroll
                    for (int j = 0; j < 4; ++j) { const f32x4 w = *(const LAS f32x4*)(W8T + jj * 1024 + 256 * j + 4 * lane); a += v[rr][j][0] * w[0] + v[rr][j][1] * w[1] + v[rr][j][2] * w[2] + v[rr][j][3] * w[3]; }
                    red[rr * 512 + jj * 64 + lane] = a; } }
            asm volatile("s_waitcnt lgkmcnt(0)" ::: "memory");
#pragma unroll
            for (int rr = 0; rr < 2; ++rr) { const f32x4 r0 = *(const LAS f32x4*)(red + rr * 512 + lane * 8), r1 = *(const LAS f32x4*)(red + rr * 512 + lane * 8 + 4);
                float a = (r0[0] + r0[1]) + (r0[2] + r0[3]) + (r1[0] + r1[1]) + (r1[2] + r1[3]);
                a += __shfl_xor(a, 1); a += __shfl_xor(a, 2); a += __shfl_xor(a, 4);
                if ((lane & 7) == 0) ((float*)(ws + WS_SM) + (size_t)(row0 + rr * NGW) * 8)[lane >> 3] = a; }
            asm volatile("s_waitcnt lgkmcnt(0)" ::: "memory");
        }
    }
    __syncthreads();
}

__device__ __forceinline__ void delta_pre_unit(const Params& p, int l, int unit, LAS unsigned char* lds) {
    int tid_ = threadIdx.x; asm volatile("" : "+v"(tid_));
    const int tid = tid_, lane = tid & 63, wave = tid >> 6;
    const int h = unit & 3, gch = unit >> 2, c = gch & 31;
    const size_t row0 = (size_t)gch * 64;
    unsigned char* ws = p.ws;
    bf16_t* cols = (bf16_t*)(ws + WS_COLS);
    LAS float* Qf = (LAS float*)lds; LAS float* Kf = Qf + 64 * 129; LAS float* Vf = Kf + 64 * 129; LAS float* Lf = Vf + 64 * 129;
    LAS bf16_t* Qb = (LAS bf16_t*)(Lf + 64 * 68); LAS bf16_t* Kb = Qb + 64 * 136;
    LAS float* gcs = (LAS float*)(lds + 154112); LAS float* betas = gcs + 64; LAS float* facs = betas + 64;
    LAS bf16_t* Rw = (LAS bf16_t*)Lf;
    {
#pragma unroll
        for (int it = 0; it < 6; ++it) { const int pc = tid + 512 * it, r = pc / 48, rem = pc % 48, part = rem >> 4, cp = rem & 15;
            const u32x4 v = *(const u32x4*)(cols + (row0 + r) * NC + part * 512 + h * 128 + cp * 8);
            *(LAS u32x4*)(Rw + (r + 3) * 384 + part * 128 + cp * 8) = v; }
        if (tid < 144) { const int r = tid / 48, rem = tid % 48, part = rem >> 4, cp = rem & 15;
            u32x4 v = {0u, 0u, 0u, 0u};
            if (c > 0) v = *(const u32x4*)((const bf16_t*)(ws + WS_HALO) + ((size_t)(gch - 1) * 3 + r) * 1536 + part * 512 + h * 128 + cp * 8);
            *(LAS u32x4*)(Rw + r * 384 + part * 128 + cp * 8) = v; }
        if (wave == 6) {
            const float* sm = (const float*)(ws + WS_SM) + (row0 + lane) * 8;
            const float a = sm[4 + h] + p.dt_bias[l * 4 + h];
            const float sp = a > 20.f ? a : __logf(1.f + __expf(a));
            float g = -__expf(p.a_log[l * 4 + h]) * sp;
#pragma unroll
            for (int o = 1; o < 64; o <<= 1) { const float t = __shfl_up(g, o); if (lane >= o) g += t; }
            gcs[lane] = g;
        } else if (wave == 7) {
            const float* sm = (const float*)(ws + WS_SM) + (row0 + lane) * 8;
            betas[lane] = sigmoid_f(sm[h]);
        }
    }
    LDS_BAR();
    if (tid < 384) {
        const int quad = tid % 96, seg = tid / 96, c4 = 4 * quad, part = c4 >> 7, cc = c4 & 127;
        const float* cw = p.conv_w + (size_t)l * 4 * 1536 + part * 512 + h * 128 + cc;
        const f32x4 w0 = *(const f32x4*)cw, w1 = *(const f32x4*)(cw + 1536), w2 = *(const f32x4*)(cw + 2 * 1536), w3 = *(const f32x4*)(cw + 3 * 1536);
        const LAS bf16_t* src = Rw + (16 * seg) * 384 + c4;
        u32x2 rv[19];
#pragma unroll
        for (int r = 0; r < 19; ++r) rv[r] = *(const LAS u32x2*)(src + r * 384);
        LAS float* dst = (part == 0 ? Qf : (part == 1 ? Kf : Vf)) + (16 * seg) * 129 + cc;
#pragma unroll
        for (int r = 0; r < 16; ++r) {
            const u32x2 a3 = rv[r], a2 = rv[r + 1], a1 = rv[r + 2], a0 = rv[r + 3];
            const float y0 = w0[0] * lo_bf(a3.x) + w1[0] * lo_bf(a2.x) + w2[0] * lo_bf(a1.x) + w3[0] * lo_bf(a0.x);
            const float y1 = w0[1] * hi_bf(a3.x) + w1[1] * hi_bf(a2.x) + w2[1] * hi_bf(a1.x) + w3[1] * hi_bf(a0.x);
            const float y2 = w0[2] * lo_bf(a3.y) + w1[2] * lo_bf(a2.y) + w2[2] * lo_bf(a1.y) + w3[2] * lo_bf(a0.y);
            const float y3 = w0[3] * hi_bf(a3.y) + w1[3] * hi_bf(a2.y) + w2[3] * hi_bf(a1.y) + w3[3] * hi_bf(a0.y);
            dst[r * 129 + 0] = silu_f(y0); dst[r * 129 + 1] = silu_f(y1); dst[r * 129 + 2] = silu_f(y2); dst[r * 129 + 3] = silu_f(y3);
        }
    }
    LDS_BAR();
    if (tid < 64) { facs[tid] = betas[tid]; facs[64 + tid] = betas[tid] * __expf(gcs[tid]); }
    {
        const int r = tid >> 3, sub = tid & 7; float sq = 0.f, sk = 0.f;
#pragma unroll
        for (int e = 0; e < 16; ++e) { const float a = Qf[r * 129 + sub * 16 + e]; sq += a * a; const float b = Kf[r * 129 + sub * 16 + e]; sk += b * b; }
        sq += __shfl_xor(sq, 1); sq += __shfl_xor(sq, 2); sq += __shfl_xor(sq, 4);
        sk += __shfl_xor(sk, 1); sk += __shfl_xor(sk, 2); sk += __shfl_xor(sk, 4);
        const float rq = rsqrtf(sq + EPS) * 0.08838834764831845f, rkk = rsqrtf(sk + EPS);
#pragma unroll
        for (int e = 0; e < 16; ++e) { const int o = sub * 16 + e; const float a = Qf[r * 129 + o] * rq; Qb[r * 136 + o] = (bf16_t)f2bf(a);
            const float b = Kf[r * 129 + o] * rkk; Kf[r * 129 + o] = b; Kb[r * 136 + o] = (bf16_t)f2bf(b); }
    }
    LDS_BAR();
    LAS bf16_t* Al = (LAS bf16_t*)Qf;
    LAS float* Db = Qf;
    LAS bf16_t* Lb = (LAS bf16_t*)(lds + 16640);
    LAS bf16_t* XT = Qb;
    LAS bf16_t* Wl = (LAS bf16_t*)Vf;
    {
        const int i = lane & 15, q = lane >> 4;
#pragma unroll
        for (int jb = 0; jb < 4; ++jb) { const int job = wave + 8 * jb;
            const int kind = job >> 4, ct = (job >> 2) & 3, st = job & 3;
            f32x4 acc = {0.f, 0.f, 0.f, 0.f};
            if (st <= ct) {
                const LAS bf16_t* Ab = kind == 0 ? Kb : Qb;
#pragma unroll
                for (int ks = 0; ks < 4; ++ks) { const bf16x8 a = *(const LAS bf16x8*)(Ab + (16 * ct + i) * 136 + 32 * ks + 8 * q); const bf16x8 b = *(const LAS bf16x8*)(Kb + (16 * st + i) * 136 + 32 * ks + 8 * q);
                    acc = MFMA16(a, b, acc); }
            }
            const int s = 16 * st + i; const float gs = gcs[s];
#pragma unroll
            for (int r = 0; r < 4; ++r) { const int cr = 16 * ct + 4 * q + r; const float e = __expf(fminf(gcs[cr] - gs, 0.f));
                if (kind == 0) { const float v = (cr > s) ? acc[r] * betas[cr] * e : 0.f; Lf[cr * 68 + s] = v; Lb[cr * 72 + s] = (bf16_t)f2bf(v); }
                else Al[cr * 72 + (s & ~31) + kperm32(s & 31)] = (bf16_t)f2bf(cr >= s ? acc[r] * e : 0.f); }
        }
    }
    LDS_BAR();
    {
        *(u32x4*)(ws + WS_WA_A + (size_t)unit * 8192 + tid * 16) = *(const LAS u32x4*)(Al + (tid >> 3) * 72 + (tid & 7) * 8);
        { const int cr = tid >> 3, d0 = (tid & 7) * 16; const float e = __expf(gcs[cr]);
            bf16_t* dst = cols + (row0 + cr) * NC + C_DNQ + h * 128 + d0;
#pragma unroll
            for (int g4 = 0; g4 < 2; ++g4) { const u32x4 v = *(const LAS u32x4*)(Qb + cr * 136 + d0 + 8 * g4); u32x4 w;
                w.x = cvt_pk_bf16(lo_bf(v.x) * e, hi_bf(v.x) * e); w.y = cvt_pk_bf16(lo_bf(v.y) * e, hi_bf(v.y) * e); w.z = cvt_pk_bf16(lo_bf(v.z) * e, hi_bf(v.z) * e); w.w = cvt_pk_bf16(lo_bf(v.w) * e, hi_bf(v.w) * e);
                const int o0 = (d0 + 8 * g4) & 31, gb = (d0 + 8 * g4) & ~31;
                *(u32x2*)(dst - d0 + gb + kperm32(o0)) = (u32x2){w.x, w.y}; *(u32x2*)(dst - d0 + gb + kperm32(o0 + 4)) = (u32x2){w.z, w.w}; } }
        { const int dk = tid & 127, c0 = (tid >> 7) * 16; const float gl = gcs[63];
            bf16_t* dst = cols + (row0 + (dk >> 1)) * NC + C_DNK + h * 128 + (dk & 1) * 64 + c0;
#pragma unroll
            for (int g4 = 0; g4 < 2; ++g4) { float v[8];
#pragma unroll
                for (int e = 0; e < 8; ++e) { const int cr = c0 + 8 * g4 + e; v[e] = Kf[cr * 129 + dk] * __expf(gl - gcs[cr]); }
                u32x4 w; w.x = cvt_pk_bf16(v[0], v[1]); w.y = cvt_pk_bf16(v[2], v[3]); w.z = cvt_pk_bf16(v[4], v[5]); w.w = cvt_pk_bf16(v[6], v[7]);
                const int cc0 = c0 + 8 * g4, gb = cc0 & ~31, o0 = cc0 & 31;
                *(u32x2*)(dst - c0 + gb + kperm32(o0)) = (u32x2){w.x, w.y}; *(u32x2*)(dst - c0 + gb + kperm32(o0 + 4)) = (u32x2){w.z, w.w}; } }
        if (tid == 0) ((float*)(ws + WS_DL))[unit] = __expf(gcs[63]);
    }
    LDS_BAR();
    for (int e = tid; e < 2304; e += 512) ((LAS u32x4*)XT)[e] = (u32x4){0u, 0u, 0u, 0u};
    LDS_BAR();
    {
        const int j = tid & 255; const bool isv = j < 128; const int jj = j & 127;
        const LAS float* src = (isv ? Vf : Kf) + jj;
        const LAS float* fac = facs + (isv ? 0 : 64);
        const int i16 = lane & 15, q = lane >> 4;
        float x[64];
#pragma unroll
        for (int bb = 0; bb < 4; ++bb) {
            if (bb > 0) {
#pragma unroll
                for (int tt = 0; tt < 2; ++tt) { const int ct = 2 * wave + tt; f32x4 acc = {0.f, 0.f, 0.f, 0.f};
#pragma unroll
                    for (int ks = 0; ks < 2; ++ks) if (32 * ks < 16 * bb) acc = MFMA16(*(const LAS bf16x8*)(Lb + (16 * bb + i16) * 72 + 32 * ks + 8 * q), *(const LAS bf16x8*)(XT + (16 * ct + i16) * 72 + 32 * ks + 8 * q), acc);
#pragma unroll
                    for (int r = 0; r < 4; ++r) Db[(4 * q + r) * 260 + 16 * ct + i16] = acc[r]; }
                LDS_BAR();
            }
            if (tid < 256) {
                int Lr[16]; float rh[16];
#pragma unroll
                for (int i = 0; i < 16; ++i) { const int row = 16 * bb + i;
                    Lr[i] = __float_as_int(Lf[row * 68 + 16 * bb + i16]);
                    rh[i] = src[row * 129] * fac[row] - (bb > 0 ? Db[i * 260 + j] : 0.f); }
#pragma unroll
                for (int i = 0; i < 16; ++i) { const int row = 16 * bb + i;
                    float sa[4] = {rh[i], 0.f, 0.f, 0.f};
#pragma unroll
                    for (int jx = 0; jx < i; ++jx) sa[jx & 3] -= __int_as_float(__builtin_amdgcn_readlane(Lr[i], jx)) * x[16 * bb + jx];
                    x[row] = (sa[0] + sa[1]) + (sa[2] + sa[3]); }
                u32x4 w0, w1;
                w0.x = cvt_pk_bf16(x[16 * bb + 0], x[16 * bb + 1]); w0.y = cvt_pk_bf16(x[16 * bb + 2], x[16 * bb + 3]); w0.z = cvt_pk_bf16(x[16 * bb + 4], x[16 * bb + 5]); w0.w = cvt_pk_bf16(x[16 * bb + 6], x[16 * bb + 7]);
                w1.x = cvt_pk_bf16(x[16 * bb + 8], x[16 * bb + 9]); w1.y = cvt_pk_bf16(x[16 * bb + 10], x[16 * bb + 11]); w1.z = cvt_pk_bf16(x[16 * bb + 12], x[16 * bb + 13]); w1.w = cvt_pk_bf16(x[16 * bb + 14], x[16 * bb + 15]);
                *(LAS u32x4*)(XT + j * 72 + 16 * bb) = w0; *(LAS u32x4*)(XT + j * 72 + 16 * bb + 8) = w1;
            }
            LDS_BAR();
        }
#pragma unroll
        for (int it = 0; it < 2; ++it) { const int pc = tid + 512 * it, dv = pc >> 3, cp = pc & 7;
            *(u32x4*)(cols + (row0 + (dv >> 1)) * NC + C_DNV + h * 128 + (dv & 1) * 64 + cp * 8) = *(const LAS u32x4*)(XT + dv * 72 + cp * 8); }
        if (tid >= 128 && tid < 256) {
#pragma unroll
            for (int i = 0; i < 64; ++i) Wl[i * 136 + (jj & ~31) + kperm32(jj & 31)] = (bf16_t)f2bf(x[i]); }
    }
    LDS_BAR();
    {   unsigned char* wo = ws + WS_WA_W + (size_t)unit * 16384;
#pragma unroll
        for (int it = 0; it < 2; ++it) { const int pc = tid + 512 * it; *(u32x4*)(wo + pc * 16) = *(const LAS u32x4*)(Wl + (pc >> 4) * 136 + (pc & 15) * 8); }
    }
    LDS_BAR();
}

__device__ __forceinline__ void delta_scan_unit(const Params& p, int l, int bh, LAS unsigned char* lds) {
    int tid_ = threadIdx.x; asm volatile("" : "+v"(tid_));
    const int tid = tid_, lane = tid & 63, wave = tid >> 6, i = lane & 15, q = lane >> 4;
    const int b = bh >> 2, h = bh & 3;
    unsigned char* ws = p.ws;
    unsigned char* colsb = ws + WS_COLS;
    constexpr int BUFB = 62464, O_W = 0, O_QG = 17408, O_KD = 34816, O_A = 53248;
    LAS bf16_t* Ot = (LAS bf16_t*)(lds + 2 * BUFB);
    if (wave < 4) {
        __builtin_amdgcn_s_setprio(3);
        f32x4 S[2][8];
#pragma unroll
        for (int s2 = 0; s2 < 2; ++s2)
#pragma unroll
            for (int t = 0; t < 8; ++t) S[s2][t] = (f32x4){0.f, 0.f, 0.f, 0.f};
        u32x2 uraw[2][4]; float dl;
        const float dlv = ((const float*)(ws + WS_DL))[(b * 32 + (lane & 31)) * 4 + h];
#define SCAN_ULOAD(cidx, dstu, dstd) do { const int gch_ = b * 32 + (cidx); const size_t r0_ = (size_t)gch_ * 64; \
            _Pragma("unroll") for (int s2 = 0; s2 < 2; ++s2) { const int dv_ = 32 * wave + 16 * s2 + i; \
                const unsigned char* ub_ = colsb + ((r0_ + (dv_ >> 1)) * NC + C_DNV + h * 128 + (dv_ & 1) * 64 + 4 * q) * 2; \
                _Pragma("unroll") for (int mt = 0; mt < 4; ++mt) dstu[s2][mt] = *(const u32x2*)(ub_ + mt * 32); } } while (0)
#define SCAN_LD16(pp) (*(const LAS bf16x8*)(pp))
#define SCAN_FRAG(f) ( (f) < 16 ? SCAN_LD16(buf + O_W + (16 * ((f) >> 2) + i) * 272 + (32 * ((f) & 3) + 8 * q) * 2) \
                     : (f) < 32 ? SCAN_LD16(buf + O_QG + (16 * (((f) - 16) >> 2) + i) * 272 + (32 * (((f) - 16) & 3) + 8 * q) * 2) \
                     : (f) < 38 ? SCAN_LD16(buf + O_A + (16 * ((f) == 32 ? 0 : (f) == 33 ? 1 : (f) <= 35 ? 2 : 3) + i) * 144 + (32 * (((f) == 35 || (f) == 37) ? 1 : 0) + 8 * q) * 2) \
                     : SCAN_LD16(buf + O_KD + (16 * (((f) - 38) >> 1) + i) * 144 + (32 * (((f) - 38) & 1) + 8 * q) * 2) )
        SCAN_ULOAD(0, uraw, dl);
        __syncthreads();
#pragma unroll 1
        for (int c = 0; c < 32; ++c) {
            const LAS unsigned char* buf = lds + (c & 1) * BUFB;
            dl = __int_as_float(__builtin_amdgcn_readlane(__float_as_int(dlv), c));
            bf16x8 Sb[2][4];
#pragma unroll
            for (int s2 = 0; s2 < 2; ++s2)
#pragma unroll
                for (int ks = 0; ks < 4; ++ks) Sb[s2][ks] = pack8(S[s2][2 * ks], S[s2][2 * ks + 1]);
            f32x4 aw[2][4], o[2][4];
            bf16x8 Vb[2][2];
            bf16x8 Fq[8];
            constexpr int DEPTH = 6;
            Fq[0] = SCAN_FRAG(0); Fq[1] = SCAN_FRAG(1); Fq[2] = SCAN_FRAG(2); Fq[3] = SCAN_FRAG(3); Fq[4] = SCAN_FRAG(4); Fq[5] = SCAN_FRAG(5);
#define SCAN_STEP(f) { \
                if ((f) + DEPTH < 54) Fq[((f) + DEPTH) & 7] = SCAN_FRAG(((f) + DEPTH < 54 ? (f) + DEPTH : 53)); \
                const bf16x8 A = Fq[(f) & 7]; \
                if ((f) < 16) { constexpr int mt = ((f) >> 2) & 3, ks = (f) & 3; \
                    if (ks == 0) { aw[0][mt] = (f32x4){0.f, 0.f, 0.f, 0.f}; aw[1][mt] = (f32x4){0.f, 0.f, 0.f, 0.f}; } \
                    aw[0][mt] = MFMA16(A, Sb[0][ks], aw[0][mt]); aw[1][mt] = MFMA16(A, Sb[1][ks], aw[1][mt]); \
                } else if ((f) < 32) { constexpr int mt = (((f) - 16) >> 2) & 3, ks = (f) & 3; \
                    if (ks == 0) { o[0][mt] = (f32x4){0.f, 0.f, 0.f, 0.f}; o[1][mt] = (f32x4){0.f, 0.f, 0.f, 0.f}; } \
                    o[0][mt] = MFMA16(A, Sb[0][ks], o[0][mt]); o[1][mt] = MFMA16(A, Sb[1][ks], o[1][mt]); \
                } else if ((f) < 38) { constexpr int mt = (f) == 32 ? 0 : ((f) == 33 ? 1 : ((f) <= 35 ? 2 : 3)), k2 = ((f) == 35 || (f) == 37) ? 1 : 0; \
                    o[0][mt] = MFMA16(A, Vb[0][k2], o[0][mt]); o[1][mt] = MFMA16(A, Vb[1][k2], o[1][mt]); \
                } else { constexpr int t = (((f) - 38) >> 1) & 7, k2 = (f) & 1; \
                    if (k2 == 0) { S[0][t] = S[0][t] * dl; S[1][t] = S[1][t] * dl; } \
                    S[0][t] = MFMA16(A, Vb[0][k2], S[0][t]); S[1][t] = MFMA16(A, Vb[1][k2], S[1][t]); } \
                if ((f) == 19) { \
                    f32x4 vn[2][4]; \
                    _Pragma("unroll") for (int s2 = 0; s2 < 2; ++s2) \
                    _Pragma("unroll") for (int mt = 0; mt < 4; ++mt) vn[s2][mt] = (f32x4){lo_bf(uraw[s2][mt].x) - aw[s2][mt][0], hi_bf(uraw[s2][mt].x) - aw[s2][mt][1], lo_bf(uraw[s2][mt].y) - aw[s2][mt][2], hi_bf(uraw[s2][mt].y) - aw[s2][mt][3]}; \
                    _Pragma("unroll") for (int s2 = 0; s2 < 2; ++s2) { Vb[s2][0] = pack8(vn[s2][0], vn[s2][1]); Vb[s2][1] = pack8(vn[s2][2], vn[s2][3]); } \
                    if (c + 1 < 32) SCAN_ULOAD(c + 1, uraw, dl); \
                } \
                __builtin_amdgcn_sched_barrier(0); }
#define SCAN_STEP6(f) SCAN_STEP(f) SCAN_STEP((f) + 1) SCAN_STEP((f) + 2) SCAN_STEP((f) + 3) SCAN_STEP((f) + 4) SCAN_STEP((f) + 5)
            SCAN_STEP6(0) SCAN_STEP6(6) SCAN_STEP6(12) SCAN_STEP6(18) SCAN_STEP6(24) SCAN_STEP6(30) SCAN_STEP6(36) SCAN_STEP6(42) SCAN_STEP6(48)
#undef SCAN_STEP6
#undef SCAN_STEP
            __syncthreads();
#pragma unroll
            for (int s2 = 0; s2 < 2; ++s2)
#pragma unroll
                for (int mt = 0; mt < 4; ++mt)
#pragma unroll
                    for (int r = 0; r < 4; ++r) Ot[(16 * mt + 4 * q + r) * 136 + 32 * wave + 16 * s2 + i] = (bf16_t)f2bf(o[s2][mt][r]);
            __syncthreads();
        }
#undef SCAN_FRAG
#undef SCAN_LD16
#undef SCAN_ULOAD
        __builtin_amdgcn_s_setprio(0);
        __syncthreads();
    } else {
        const int t2 = tid - 256, fr_ = t2 >> 2, fs_ = t2 & 3;
        float gn[32];
#pragma unroll
        for (int e = 0; e < 32; ++e) gn[e] = p.dn_norm[l * 128 + fs_ * 32 + e];
        u32x4 pre[14], zc[4], zn[4];
#define SCAN_LOAD(cidx) do { const int gch_ = b * 32 + (cidx); const size_t r0_ = (size_t)gch_ * 64; const int un2_ = gch_ * 4 + h; \
            const unsigned char* wsrc_ = ws + WS_WA_W + (size_t)un2_ * 16384; const unsigned char* asrc_ = ws + WS_WA_A + (size_t)un2_ * 8192; \
            _Pragma("unroll") for (int k = 0; k < 4; ++k) { const int pc_ = t2 + 256 * k; \
                pre[k] = *(const u32x4*)(wsrc_ + pc_ * 16); \
                pre[4 + k] = *(const u32x4*)(colsb + ((r0_ + (pc_ >> 4)) * NC + C_DNQ + h * 128) * 2 + (pc_ & 15) * 16); \
                pre[8 + k] = *(const u32x4*)(colsb + ((r0_ + (pc_ >> 4)) * NC + C_DNK + h * 128) * 2 + (pc_ & 15) * 16); } \
            pre[12] = *(const u32x4*)(asrc_ + t2 * 16); pre[13] = *(const u32x4*)(asrc_ + (t2 + 256) * 16); } while (0)
#define SCAN_ZLOAD(cidx, dst) do { const unsigned char* zb_ = colsb + (((size_t)(b * 32 + (cidx)) * 64 + fr_) * NC + C_DNZ + h * 128 + fs_ * 32) * 2; \
            _Pragma("unroll") for (int k = 0; k < 4; ++k) dst[k] = *(const u32x4*)(zb_ + 16 * k); } while (0)
#define SCAN_STORE(bufp) do { LAS unsigned char* b_ = (bufp); \
            _Pragma("unroll") for (int k = 0; k < 4; ++k) { const int pc_ = t2 + 256 * k; \
                *(LAS u32x4*)(b_ + O_W + (pc_ >> 4) * 272 + (pc_ & 15) * 16) = pre[k]; \
                *(LAS u32x4*)(b_ + O_QG + (pc_ >> 4) * 272 + (pc_ & 15) * 16) = pre[4 + k]; \
                *(LAS u32x4*)(b_ + O_KD + (pc_ >> 3) * 144 + (pc_ & 7) * 16) = pre[8 + k]; } \
            *(LAS u32x4*)(b_ + O_A + (t2 >> 3) * 144 + (t2 & 7) * 16) = pre[12]; *(LAS u32x4*)(b_ + O_A + ((t2 + 256) >> 3) * 144 + (t2 & 7) * 16) = pre[13]; } while (0)
#define SCAN_FINAL(cidx) do { \
            float ss_ = 0.f; u32x4 ov_[4]; \
            _Pragma("unroll") for (int k = 0; k < 4; ++k) { ov_[k] = *(const LAS u32x4*)(Ot + fr_ * 136 + fs_ * 32 + 8 * k); \
                ss_ += lo_bf(ov_[k].x) * lo_bf(ov_[k].x) + hi_bf(ov_[k].x) * hi_bf(ov_[k].x) + lo_bf(ov_[k].y) * lo_bf(ov_[k].y) + hi_bf(ov_[k].y) * hi_bf(ov_[k].y) \
                     + lo_bf(ov_[k].z) * lo_bf(ov_[k].z) + hi_bf(ov_[k].z) * hi_bf(ov_[k].z) + lo_bf(ov_[k].w) * lo_bf(ov_[k].w) + hi_bf(ov_[k].w) * hi_bf(ov_[k].w); } \
            ss_ += __shfl_xor(ss_, 1); ss_ += __shfl_xor(ss_, 2); \
            const float rstd_ = rsqrtf(ss_ * (1.f / 128.f) + EPS); \
            unsigned char* yb_ = colsb + (((size_t)(b * 32 + (cidx)) * 64 + fr_) * NC + C_DNZ + h * 128 + fs_ * 32) * 2; \
            _Pragma("unroll") for (int k = 0; k < 4; ++k) { u32x4 w_; \
                w_.x = cvt_pk_bf16(lo_bf(ov_[k].x) * rstd_ * gn[8 * k + 0] * lo_bf(zc[k].x), hi_bf(ov_[k].x) * rstd_ * gn[8 * k + 1] * hi_bf(zc[k].x)); \
                w_.y = cvt_pk_bf16(lo_bf(ov_[k].y) * rstd_ * gn[8 * k + 2] * lo_bf(zc[k].y), hi_bf(ov_[k].y) * rstd_ * gn[8 * k + 3] * hi_bf(zc[k].y)); \
                w_.z = cvt_pk_bf16(lo_bf(ov_[k].z) * rstd_ * gn[8 * k + 4] * lo_bf(zc[k].z), hi_bf(ov_[k].z) * rstd_ * gn[8 * k + 5] * hi_bf(zc[k].z)); \
                w_.w = cvt_pk_bf16(lo_bf(ov_[k].w) * rstd_ * gn[8 * k + 6] * lo_bf(zc[k].w), hi_bf(ov_[k].w) * rstd_ * gn[8 * k + 7] * hi_bf(zc[k].w)); \
                *(u32x4*)(yb_ + 16 * k) = w_; } } while (0)
        SCAN_LOAD(0); SCAN_STORE(lds);
        __syncthreads();
#pragma unroll 1
        for (int c = 0; c < 32; ++c) {
            if (c + 1 < 32) SCAN_LOAD(c + 1);
            SCAN_ZLOAD(c, zn);
            if (c > 0) SCAN_FINAL(c - 1);
            __syncthreads();
            if (c + 1 < 32) SCAN_STORE(lds + ((c + 1) & 1) * BUFB);
            __syncthreads();
#pragma unroll
            for (int k = 0; k < 4; ++k) zc[k] = zn[k];
        }
        SCAN_FINAL(31);
#undef SCAN_LOAD
#undef SCAN_ZLOAD
#undef SCAN_STORE
#undef SCAN_FINAL
        __syncthreads();
    }
}

__device__ __forceinline__ void gmlp_unit(const Params& p, int l, int unit, LAS unsigned char* lds) {
    int tid_ = threadIdx.x; asm volatile("" : "+v"(tid_));
    const int tid = tid_, lane = tid & 63, wave = tid >> 6, i = lane & 15, q = lane >> 4;
    const int g = unit & 3, bn = unit >> 2;
    const size_t row0 = (size_t)bn * 128;
    unsigned char* ws = p.ws;
    bf16_t* cols = (bf16_t*)(ws + WS_COLS);
    LAS float* rstd = (LAS float*)lds;
    LAS bf16_t* vT = (LAS bf16_t*)(lds + 512);
    {   u32x4 rv[16];
#pragma unroll
        for (int tt = 0; tt < 16; ++tt) rv[tt] = *(const u32x4*)(cols + (row0 + 16 * wave + tt) * NC + C_GMV + lane * 8);
#pragma unroll
        for (int tt = 0; tt < 16; ++tt) { const u32x4 v = rv[tt];
            float ss = lo_bf(v.x) * lo_bf(v.x) + hi_bf(v.x) * hi_bf(v.x) + lo_bf(v.y) * lo_bf(v.y) + hi_bf(v.y) * hi_bf(v.y) + lo_bf(v.z) * lo_bf(v.z) + hi_bf(v.z) * hi_bf(v.z) + lo_bf(v.w) * lo_bf(v.w) + hi_bf(v.w) * hi_bf(v.w);
            ss = wave_sum(ss); if (lane == 0) rstd[16 * wave + tt] = rsqrtf(ss * (1.f / 512.f) + EPS); } }
    LDS_BAR();
#pragma unroll
    for (int it = 0; it < 4; ++it) { const int pc = tid + 512 * it, qrow = pc >> 4, cp = pc & 15;
        const u32x4 v = *(const u32x4*)(cols + (row0 + qrow) * NC + C_GMV + g * 128 + cp * 8);
        const float* gp = p.gm_norm + l * 512 + g * 128 + cp * 8; const float rs = rstd[qrow];
        const float f[8] = {lo_bf(v.x), hi_bf(v.x), lo_bf(v.y), hi_bf(v.y), lo_bf(v.z), hi_bf(v.z), lo_bf(v.w), hi_bf(v.w)};
#pragma unroll
        for (int e = 0; e < 8; ++e) vT[(cp * 8 + e) * 136 + qrow] = (bf16_t)f2bf(f[e] * rs * gp[e]); }
    LDS_BAR();
    {
        const int pt = wave; const int nks = (pt >> 1) + 1;
        const bf16_t* spw = (const bf16_t*)(ws + WS_SPW) + (size_t)g * 16384 + (16 * pt + i) * 128 + 8 * q;
        bf16x8 Bf[4];
#pragma unroll
        for (int ks = 0; ks < 4; ++ks) Bf[ks] = *(const bf16x8*)(spw + 32 * ks);
        const float bias = p.spatial_b[l * 512 + g * 128 + 16 * pt + i];
        const size_t prow = row0 + 16 * pt + i;
        u32x2 uu8[8], zz8[8];
#pragma unroll
        for (int ct = 0; ct < 8; ++ct) { const int ch = g * 128 + 16 * ct + 4 * q; uu8[ct] = *(const u32x2*)(cols + prow * NC + C_GMU + ch); zz8[ct] = *(const u32x2*)(cols + prow * NC + C_GMZ + ch); }
#pragma unroll
        for (int ct = 0; ct < 8; ++ct) { f32x4 acc = {0.f, 0.f, 0.f, 0.f};
#pragma unroll
            for (int ks = 0; ks < 4; ++ks) if (ks < nks) acc = MFMA16(*(const LAS bf16x8*)(vT + (16 * ct + i) * 136 + 32 * ks + 8 * q), Bf[ks], acc);
            const int ch = g * 128 + 16 * ct + 4 * q;
            u32x2* up = (u32x2*)(cols + prow * NC + C_GMU + ch); const u32x2 uu = uu8[ct]; const u32x2 zz = zz8[ct];
            u32x2 w; w.x = cvt_pk_bf16(lo_bf(uu.x) * (acc[0] + bias) * lo_bf(zz.x), hi_bf(uu.x) * (acc[1] + bias) * hi_bf(zz.x));
            w.y = cvt_pk_bf16(lo_bf(uu.y) * (acc[2] + bias) * lo_bf(zz.y), hi_bf(uu.y) * (acc[3] + bias) * hi_bf(zz.y));
            *up = w; }
    }
    LDS_BAR();
}

template <int HD, int NK, bool SWA>
__device__ __forceinline__ void attn_pair16(bf16_t* qpA, bf16_t* qpB, const bf16x8 (&QfA)[HD / 32], const bf16x8 (&QfB)[HD / 32], const u32x2 (&ZfA)[HD / 16], const u32x2 (&ZfB)[HD / 16],
                                            const LAS bf16_t* Kl, const LAS bf16_t* VTl, int kp_lo, int kp_hi, float scale, float m0, float l0, int qi0A, int qi0B, bool blk0, int lane) {
    const int i = lane & 15, q = lane >> 4;
    float m[2] = {m0, m0}, lsum[2] = {l0, l0};
    f32x4 O[2][HD / 16];
#pragma unroll
    for (int t = 0; t < 2; ++t)
#pragma unroll
        for (int dt = 0; dt < HD / 16; ++dt) O[t][dt] = (f32x4){0.f, 0.f, 0.f, 0.f};
    const int qi[2] = {qi0A + i, qi0B + i};
    for (int kp = kp_lo; kp <= kp_hi; ++kp) {
        f32x4 s0[2], s1[2];
#pragma unroll
        for (int t = 0; t < 2; ++t) { s0[t] = (f32x4){0.f, 0.f, 0.f, 0.f}; s1[t] = (f32x4){0.f, 0.f, 0.f, 0.f}; }
#pragma unroll
        for (int kd = 0; kd < HD / 32; ++kd) {
            const bf16x8 k0f = *(const LAS bf16x8*)(Kl + (32 * kp + i) * (HD + 8) + 32 * kd + 8 * q), k1f = *(const LAS bf16x8*)(Kl + (32 * kp + 16 + i) * (HD + 8) + 32 * kd + 8 * q);
            s0[0] = MFMA16(k0f, QfA[kd], s0[0]); s1[0] = MFMA16(k1f, QfA[kd], s1[0]);
            s0[1] = MFMA16(k0f, QfB[kd], s0[1]); s1[1] = MFMA16(k1f, QfB[kd], s1[1]);
        }
        bf16x8 Pb[2]; float alpha[2];
#pragma unroll
        for (int t = 0; t < 2; ++t) {
            float mx = -1e30f;
#pragma unroll
            for (int r = 0; r < 4; ++r) {
                float a = s0[t][r] * scale, b = s1[t][r] * scale;
                if (SWA) { const int k0 = 32 * kp + 4 * q + r, k1 = k0 + 16;
                    if (!(k0 >= qi[t] + 1 && k0 <= qi[t] + 128 && (!blk0 || k0 >= 128))) a = -1e30f;
                    if (!(k1 >= qi[t] + 1 && k1 <= qi[t] + 128 && (!blk0 || k1 >= 128))) b = -1e30f; }
                s0[t][r] = a; s1[t][r] = b; mx = fmaxf(mx, fmaxf(a, b));
            }
            mx = fmaxf(mx, __shfl_xor(mx, 16)); mx = fmaxf(mx, __shfl_xor(mx, 32));
            const float mn = fmaxf(m[t], mx); alpha[t] = __expf(m[t] - mn);
            float ps = 0.f;
#pragma unroll
            for (int r = 0; r < 4; ++r) { s0[t][r] = __expf(s0[t][r] - mn); s1[t][r] = __expf(s1[t][r] - mn); ps += s0[t][r] + s1[t][r]; }
            ps += __shfl_xor(ps, 16); ps += __shfl_xor(ps, 32);
            lsum[t] = lsum[t] * alpha[t] + ps; m[t] = mn;
            Pb[t] = pack8(s0[t], s1[t]);
        }
#pragma unroll
        for (int dt = 0; dt < HD / 16; ++dt) {
            const bf16x8 vf = lds_ld2x8((const LAS unsigned char*)(VTl + (16 * dt + i) * (NK + 8) + 32 * kp + 4 * q));
            O[0][dt] = MFMA16(vf, Pb[0], O[0][dt] * alpha[0]); O[1][dt] = MFMA16(vf, Pb[1], O[1][dt] * alpha[1]); }
    }
#pragma unroll
    for (int t = 0; t < 2; ++t) { const float inv = 1.f / lsum[t]; bf16_t* qp = t == 0 ? qpA : qpB;
#pragma unroll
        for (int dt = 0; dt < HD / 16; ++dt) { const int d = 16 * dt + 4 * q;
            const u32x2 zz = t == 0 ? ZfA[dt] : ZfB[dt];
            u32x2 w; w.x = cvt_pk_bf16(O[t][dt][0] * inv * lo_bf(zz.x), O[t][dt][1] * inv * hi_bf(zz.x)); w.y = cvt_pk_bf16(O[t][dt][2] * inv * lo_bf(zz.y), O[t][dt][3] * inv * hi_bf(zz.y));
            *(u32x2*)(qp + (size_t)i * NC + d) = w; } }
}

__device__ __forceinline__ void swa_unit(const Params& p, int l, int unit, LAS unsigned char* lds) {
    int tid_ = threadIdx.x; asm volatile("" : "+v"(tid_));
    const int tid = tid_, lane = tid & 63, wave = tid >> 6;
    const int kvh = unit & 1, bn = unit >> 1, n = bn & 15, b = bn >> 4;
    unsigned char* ws = p.ws; bf16_t* cols = (bf16_t*)(ws + WS_COLS);
    LAS bf16_t* Kl = (LAS bf16_t*)lds;
    LAS bf16_t* VTl = Kl + 256 * 72;
    const long krow0 = (long)b * T + (long)(n - 1) * 128;
    const int g = wave >> 1, hq = kvh * 4 + g;
    bf16x8 Qf[4][2]; u32x2 Zf[4][4];
#pragma unroll
    for (int qt = 0; qt < 4; ++qt) { const size_t qrow = (size_t)b * T + n * 128 + (wave & 1) * 64 + 16 * qt + (lane & 15);
#pragma unroll
        for (int kd = 0; kd < 2; ++kd) Qf[qt][kd] = *(const bf16x8*)(cols + qrow * NC + C_SWQ + hq * 64 + 32 * kd + 8 * (lane >> 4));
#pragma unroll
        for (int dt = 0; dt < 4; ++dt) Zf[qt][dt] = *(const u32x2*)(cols + qrow * NC + C_SWZ + hq * 64 + 16 * dt + 4 * (lane >> 4)); }
#pragma unroll
    for (int it = 0; it < 4; ++it) { const int pc = tid + 512 * it, kj = pc >> 3, cp = pc & 7;
        u32x4 kv = {0u, 0u, 0u, 0u}, vv = {0u, 0u, 0u, 0u};
        if (n > 0 || kj >= 128) { const bf16_t* rp = cols + (size_t)(krow0 + kj) * NC; kv = *(const u32x4*)(rp + C_SWK + kvh * 64 + cp * 8); vv = *(const u32x4*)(rp + C_SWV + kvh * 64 + cp * 8); }
        *(LAS u32x4*)(Kl + kj * 72 + cp * 8) = kv;
        const unsigned vw[4] = {vv.x, vv.y, vv.z, vv.w};
#pragma unroll
        for (int e = 0; e < 4; ++e) { VTl[(cp * 8 + 2 * e) * 264 + kj] = (bf16_t)(vw[e] & 0xffffu); VTl[(cp * 8 + 2 * e + 1) * 264 + kj] = (bf16_t)(vw[e] >> 16); } }
    LDS_BAR();
    {
        const float sink = p.sinks[l * 8 + hq];
#pragma unroll
        for (int qp2 = 0; qp2 < 2; ++qp2) {
            const int qi0 = (wave & 1) * 64 + 32 * qp2;
            const size_t qrow = (size_t)b * T + n * 128 + qi0;
            int kp_lo = (qi0 + 1) >> 5, kp_hi = (qi0 + 16 + 143) >> 5; if (kp_hi > 7) kp_hi = 7; if (n == 0 && kp_lo < 4) kp_lo = 4;
            attn_pair16<64, 256, true>(cols + qrow * NC + C_SWQ + hq * 64, cols + (qrow + 16) * NC + C_SWQ + hq * 64, Qf[2 * qp2], Qf[2 * qp2 + 1], Zf[2 * qp2], Zf[2 * qp2 + 1], Kl, VTl, kp_lo, kp_hi, 0.125f, sink, 1.f, qi0, qi0 + 16, n == 0, lane);
        }
    }
    LDS_BAR();
}

__device__ __forceinline__ void xmem_unit(const Params& p, int l, int unit, LAS unsigned char* lds) {
    int tid_ = threadIdx.x; asm volatile("" : "+v"(tid_));
    const int tid = tid_, lane = tid & 63, wave = tid >> 6;
    const int qb = unit & 7, hm = (unit >> 3) & 3, b = unit >> 5;
    unsigned char* ws = p.ws; bf16_t* cols = (bf16_t*)(ws + WS_COLS);
    const bf16_t* mkv = (const bf16_t*)(ws + WS_MEMKV) + (size_t)b * 256 * 1024;
    LAS bf16_t* Kl = (LAS bf16_t*)lds;
    LAS bf16_t* VTl = Kl + 256 * 136;
    bf16x8 Qf[2][4]; u32x2 Zf[2][8];
#pragma unroll
    for (int qt = 0; qt < 2; ++qt) { const size_t qrow = (size_t)b * T + qb * 256 + 32 * wave + 16 * qt + (lane & 15);
#pragma unroll
        for (int kd = 0; kd < 4; ++kd) Qf[qt][kd] = *(const bf16x8*)(cols + qrow * NC + C_XMQ + hm * 128 + 32 * kd + 8 * (lane >> 4));
#pragma unroll
        for (int dt = 0; dt < 8; ++dt) Zf[qt][dt] = *(const u32x2*)(cols + qrow * NC + C_XMZ + hm * 128 + 16 * dt + 4 * (lane >> 4)); }
#pragma unroll
    for (int it = 0; it < 8; ++it) { const int pc = tid + 512 * it, kj = pc >> 4, cp = pc & 15;
        const bf16_t* rp = mkv + (size_t)kj * 1024 + hm * 128 + cp * 8;
        const u32x4 kv = *(const u32x4*)rp, vv = *(const u32x4*)(rp + 512);
        *(LAS u32x4*)(Kl + kj * 136 + cp * 8) = kv;
        const unsigned vw[4] = {vv.x, vv.y, vv.z, vv.w};
#pragma unroll
        for (int e = 0; e < 4; ++e) { VTl[(cp * 8 + 2 * e) * 264 + kj] = (bf16_t)(vw[e] & 0xffffu); VTl[(cp * 8 + 2 * e + 1) * 264 + kj] = (bf16_t)(vw[e] >> 16); } }
    LDS_BAR();
    { const size_t qrow = (size_t)b * T + qb * 256 + 32 * wave;
      attn_pair16<128, 256, false>(cols + qrow * NC + C_XMQ + hm * 128, cols + (qrow + 16) * NC + C_XMQ + hm * 128, Qf[0], Qf[1], Zf[0], Zf[1], Kl, VTl, 0, 7, 0.08838834764831845f, -1e30f, 0.f, 0, 0, false, lane); }
    LDS_BAR();
}

#define XB_TMO      128
#define XB_XCNT(j)  (256  + 64 * (j))
#define XB_XSUB(j)  (1280 + 64 * (j))
#define XB_XGEN(j)  (2304 + 64 * (j))
#define XB_TOP      3328
#define XB_TOPGEN   3392
#define XCD_BAR_WORDS 3456
#define XB_SPIN_CAP (1u << 18)

__device__ __forceinline__ unsigned xb_ld(unsigned* p)              { return __hip_atomic_load(p, __ATOMIC_RELAXED, __HIP_MEMORY_SCOPE_AGENT); }
__device__ __forceinline__ unsigned xb_add(unsigned* p, unsigned v) { return __hip_atomic_fetch_add(p, v, __ATOMIC_RELAXED, __HIP_MEMORY_SCOPE_AGENT); }
__device__ __forceinline__ unsigned xb_xcc_id() { return (unsigned)__builtin_amdgcn_s_getreg((3 << 11) | 20) & 0xFu; }
#define XB_SPIN(cond, bar) do { unsigned _sp = 0; while (cond) { __builtin_amdgcn_s_sleep(1); \
    if ((++_sp & 255u) == 0u) { if (xb_ld(&(bar)[XB_TMO])) break; if (_sp > XB_SPIN_CAP) { atomicAdd(&(bar)[XB_TMO], 1u); break; } } } } while (0)

struct XcdBarrier {
    unsigned* bar; unsigned x;
    volatile LAS unsigned* st;
};

__device__ __forceinline__ XcdBarrier xcd_barrier_post(unsigned* bar, volatile LAS unsigned* st) {
    XcdBarrier b; b.bar = bar; b.x = xb_xcc_id(); b.st = st;
    if (threadIdx.x == 0) (void)xb_add(&bar[XB_XCNT(b.x)], 1u);
    return b;
}
__device__ __forceinline__ void xcd_barrier_complete(unsigned* bar, unsigned x, unsigned& nloc, unsigned& nx) {
    const unsigned G = gridDim.x * gridDim.y * gridDim.z;
    unsigned sum, cnt, mine, sp = 0u;
    for (;;) {
        sum = 0u; cnt = 0u; mine = 0u;
#pragma unroll
        for (unsigned j = 0; j < 16; ++j) { const unsigned c = xb_ld(&bar[XB_XCNT(j)]); sum += c; cnt += (c > 0u) ? 1u : 0u; mine = (j == x) ? c : mine; }
        if (sum == G) break;
        __builtin_amdgcn_s_sleep(1);
        if ((++sp & 255u) == 0u) { if (xb_ld(&bar[XB_TMO])) break; if (sp > XB_SPIN_CAP) { atomicAdd(&bar[XB_TMO], 1u); break; } }
    }
    nloc = mine > 0u ? mine : 1u; nx = cnt > 0u ? cnt : 1u;
}

__device__ __forceinline__ void xcd_barrier(const XcdBarrier& b) {
    asm volatile("s_waitcnt vmcnt(0)" ::: "memory");
    __syncthreads();
    if (threadIdx.x == 0) {
        unsigned* bar = b.bar;
        __builtin_amdgcn_s_waitcnt(0);
        unsigned nloc = b.st[0], nx = b.st[1];
        if (nloc == 0u) { xcd_barrier_complete(bar, b.x, nloc, nx); b.st[0] = nloc; b.st[1] = nx; }
        const unsigned old = xb_add(&bar[XB_XSUB(b.x)], 1u);
        const unsigned gen = old / nloc;
        if (old + 1u == (gen + 1u) * nloc) {
            __builtin_amdgcn_fence(__ATOMIC_RELEASE, "agent");
            asm volatile("s_waitcnt vmcnt(0)" ::: "memory");
            const unsigned og = xb_add(&bar[XB_TOP], 1u);
            const unsigned tg = og / nx;
            if (og + 1u == (tg + 1u) * nx) xb_add(&bar[XB_TOPGEN], 1u);
            else XB_SPIN(xb_ld(&bar[XB_TOPGEN]) == tg, bar);
            __builtin_amdgcn_fence(__ATOMIC_ACQUIRE, "agent");
            xb_add(&bar[XB_XGEN(b.x)], 1u);
            asm volatile("s_waitcnt vmcnt(0)" ::: "memory");
        } else {
            XB_SPIN(xb_ld(&bar[XB_XGEN(b.x)]) == gen, bar);
            __builtin_amdgcn_fence(__ATOMIC_ACQUIRE, "agent");
            asm volatile("s_waitcnt vmcnt(0)" ::: "memory");
        }
    }
    __syncthreads();
}


__global__ void __launch_bounds__(512) mega_fwd(Params p) {
    extern __shared__ __attribute__((aligned(16))) unsigned char lds_raw[];
    LAS unsigned char* lds = (LAS unsigned char*)lds_raw;
    const int G = gridDim.x, bx = blockIdx.x;
    const int vcu = (G % 8 == 0) ? (bx % 8) * (G / 8) + bx / 8 : bx;
    const Epi E{p.ws};
    unsigned* barw = (unsigned*)p.ws + 4096;
    volatile LAS unsigned* bst = (volatile LAS unsigned*)(lds + LDS_BYTES - 16);
    if (threadIdx.x == 0) { bst[0] = 0u; bst[1] = 0u; }
    __syncthreads();
    XcdBarrier bar = xcd_barrier_post(barw, bst);
#ifdef TSTAMP
    int nst = 0;
#define STAMP() do { if (bx == 0 && threadIdx.x == 0) ((unsigned long long*)p.ws)[nst] = __builtin_amdgcn_s_memrealtime(); ++nst; } while (0)
#else
#define STAMP() do {} while (0)
#endif
#define GRID_BAR() do { xcd_barrier(bar); STAMP(); } while (0)
    STAMP();
#pragma unroll 1
    for (int l = 0; l < 2; ++l) {
        p0_stage(p, l, lds);
        GRID_BAR();
#ifndef PROBE_REP
#define PROBE_REP 0
#endif
        for (int rep = 0; rep < ((PROBE_REP == 1 || PROBE_REP == 2) ? 2 : 1); ++rep) {
        { SchedA S{p.ws, G, bx}; pg8::gemm_phase<Epi, SchedA>(lds, S, E); }
        GRID_BAR();
        if (PROBE_REP == 1 && rep == 0) continue;
        for (int u = bx; u < 1024; u += G) delta_pre_unit(p, l, u, lds);
        GRID_BAR();
        if (G >= 64) {
            if (bx < 32) delta_scan_unit(p, l, bx, lds);
            else for (int u = bx - 32; u < 1024; u += G - 32) { if (u < 256) swa_unit(p, l, u, lds); else if (u < 512) xmem_unit(p, l, u - 256, lds); else gmlp_unit(p, l, u - 512, lds); }
        } else {
            for (int u = bx; u < 32 + 1024; u += G) { if (u < 32) delta_scan_unit(p, l, u, lds); else if (u < 288) swa_unit(p, l, u - 32, lds); else if (u < 544) xmem_unit(p, l, u - 288, lds); else gmlp_unit(p, l, u - 544, lds); }
        }
        GRID_BAR();
        }
        for (int rep = 0; rep < ((PROBE_REP == 3 || PROBE_REP == 4) ? 2 : 1); ++rep) {
        { SchedD S{p.ws, G, vcu}; pg8::gemm_phase<Epi, SchedD>(lds, S, E); }
        GRID_BAR();
        if (PROBE_REP == 3 && rep == 0) continue;
        { SchedE S{p.ws, G, vcu}; pg8::gemm_phase<Epi, SchedE>(lds, S, E); }
        GRID_BAR();
        }
    }
    p0_stage(p, 2, lds);
#ifdef TSTAMP
    __syncthreads();
    if (bx == 0 && threadIdx.x == 0) { const unsigned long long* st = (const unsigned long long*)p.ws; const float us = (float)(st[TS_B] - st[TS_A]) * 0.01f; p.out[0] += us * TS_SCALE; }
#endif
}

extern "C" void kernel_launch(void* const* d_in, const int* in_sizes, int n_in, void* d_out, int out_size, void* d_ws, size_t ws_size, hipStream_t stream) {
    static int grid = 0;
    if (grid == 0) {
        if (n_in != 17 || out_size != M * D || ws_size < WS_END) { fprintf(stderr, "kernel_launch: unexpected shapes / workspace (%d inputs, out %d, ws %zu)\n", n_in, out_size, ws_size); grid = -1; return; }
        int dev = 0, cus = 0, per_cu = 0;
        hipGetDevice(&dev);
        hipDeviceGetAttribute(&cus, hipDeviceAttributeMultiprocessorCount, dev);
        hipFuncSetAttribute((const void*)mega_fwd, hipFuncAttributeMaxDynamicSharedMemorySize, LDS_BYTES);
        hipOccupancyMaxActiveBlocksPerMultiprocessor(&per_cu, (const void*)mega_fwd, 512, LDS_BYTES);
        if (per_cu < 1) { fprintf(stderr, "kernel_launch: occupancy query reports %d blocks per CU\n", per_cu); (void)hipGetLastError(); per_cu = 1; }
        grid = cus * 1;
    }
    if (grid < 0) return;
    Params p{};
    p.x = (const float*)d_in[0]; p.mem = (const float*)d_in[1]; p.norm_pre = (const float*)d_in[2]; p.norm_post = (const float*)d_in[3]; p.norm_mem = (const float*)d_in[4];
    p.w_in = (const float*)d_in[5]; p.conv_w = (const float*)d_in[6]; p.a_log = (const float*)d_in[7]; p.dt_bias = (const float*)d_in[8]; p.dn_norm = (const float*)d_in[9];
    p.gm_norm = (const float*)d_in[10]; p.spatial_w = (const float*)d_in[11]; p.spatial_b = (const float*)d_in[12]; p.sinks = (const float*)d_in[13];
    p.w_mem_kv = (const float*)d_in[14]; p.w_up = (const float*)d_in[15]; p.w_out = (const float*)d_in[16];
    p.out = (float*)d_out; p.ws = (unsigned char*)d_ws;
    if (hipMemsetAsync((char*)d_ws + 16384, 0, XCD_BAR_WORDS * 4, stream) != hipSuccess) { fprintf(stderr, "kernel_launch: memset of the barrier words failed\n"); return; }
    void* args[] = {&p};
    hipError_t e = hipLaunchCooperativeKernel((const void*)mega_fwd, dim3(grid), dim3(512), args, LDS_BYTES, stream);
    if (e != hipSuccess) fprintf(stderr, "cooperative launch failed: %s (grid %d)\n", hipGetErrorString(e), grid);
}
```

```cpp
#include <hip/hip_runtime.h>
#include <hip/hip_cooperative_groups.h>
#include <cstdio>
#include <cstdint>
namespace cg = cooperative_groups;

#define LAS __attribute__((address_space(3)))
typedef unsigned short bf16_t;
typedef short bf16x8 __attribute__((ext_vector_type(8)));
typedef float f32x4 __attribute__((ext_vector_type(4)));
typedef unsigned u32x4 __attribute__((ext_vector_type(4)));
typedef unsigned u32x2 __attribute__((ext_vector_type(2)));

constexpr int NB = 8, T = 2048, M = NB * T, D = 1024, NC = 5888, DIN = 9992;
constexpr int C_DNQ = 0, C_DNK = 512, C_DNV = 1024, C_DNZ = 1536, C_GMU = 2048, C_GMV = 2560, C_GMZ = 3072, C_SWQ = 3584, C_SWK = 4096, C_SWV = 4224,
              C_SWZ = 4352, C_XMQ = 4864, C_XMZ = 5376;
constexpr float EPS = 1e-6f;
constexpr size_t MiB = 1u << 20;
constexpr size_t WS_WINT = 1 * MiB, WS_WGT = WS_WINT + 12058624, WS_WUPT = WS_WGT + 8 * MiB, WS_WOUTT = WS_WUPT + 4 * MiB, WS_WMKVT = WS_WOUTT + 2 * MiB,
                 WS_SPW = WS_WMKVT + 2 * MiB;
constexpr size_t WS_H = 29 * MiB, WS_COLS = 61 * MiB, WS_OUT = WS_COLS, WS_X = 245 * MiB;
constexpr size_t WS_WA_W = WS_X, WS_WA_A = WS_X + 16 * MiB, WS_HALO = WS_X + 24 * MiB, WS_SM = WS_X + 27 * MiB, WS_DL = WS_SM + 512 * 1024,
                 WS_MEMN = WS_X + 28 * MiB, WS_MEMKV = WS_X + 32 * MiB, WS_GSCR = WS_X, WS_MERGED = WS_X + 32 * MiB, WS_END = 309 * MiB;
constexpr int LDS_BYTES = 155648;

struct Params {
    const float *x, *mem, *norm_pre, *norm_post, *norm_mem, *w_in, *conv_w, *a_log, *dt_bias, *dn_norm, *gm_norm, *spatial_w, *spatial_b, *sinks, *w_mem_kv,
        *w_up, *w_out;
    float* out;
    unsigned char* ws;
};

__device__ __forceinline__ unsigned f2bf(float f) { unsigned u = __float_as_uint(f); return (u + 0x7fffu + ((u >> 16) & 1u)) >> 16; }
__device__ __forceinline__ float bf2f(unsigned b) { return __uint_as_float(b << 16); }
typedef float f32x2_t __attribute__((ext_vector_type(2)));
typedef __bf16 bf16x2_t __attribute__((ext_vector_type(2)));
__device__ __forceinline__ unsigned cvt_pk_bf16(float lo, float hi) { const f32x2_t v = {lo, hi}; return __builtin_bit_cast(unsigned, __builtin_convertvector(v, bf16x2_t)); }
__device__ __forceinline__ float lo_bf(unsigned w) { return __uint_as_float(w << 16); }
__device__ __forceinline__ float hi_bf(unsigned w) { return __uint_as_float(w & 0xffff0000u); }
__device__ __forceinline__ float wave_sum(float v) {
#pragma unroll
    for (int o = 1; o < 64; o <<= 1) v += __shfl_xor(v, o);
    return v;
}
__device__ __forceinline__ float silu_f(float y) { return y * __builtin_amdgcn_rcpf(1.f + __expf(-y)); }
__device__ __forceinline__ float sigmoid_f(float y) { return __builtin_amdgcn_rcpf(1.f + __expf(-y)); }
__device__ __forceinline__ float gelu_tanh_f(float x) {
    const float u = 0.7978845608f * (x + 0.044715f * x * x * x);
    return x * __builtin_amdgcn_rcpf(1.f + __expf(-2.f * u));
}
__device__ __forceinline__ float silu_fast(float y) { return y * __builtin_amdgcn_rcpf(1.f + __expf(-y)); }
__device__ __forceinline__ float sigmoid_fast(float y) { return __builtin_amdgcn_rcpf(1.f + __expf(-y)); }
__device__ __forceinline__ float gelu_fast(float x) { const float u = 0.7978845608f * (x + 0.044715f * x * x * x); return x * __builtin_amdgcn_rcpf(1.f + __expf(-2.f * u)); }
__device__ __forceinline__ bf16x8 pack8(const f32x4 a, const f32x4 b) {
    u32x4 w; w.x = cvt_pk_bf16(a[0], a[1]); w.y = cvt_pk_bf16(a[2], a[3]); w.z = cvt_pk_bf16(b[0], b[1]); w.w = cvt_pk_bf16(b[2], b[3]);
    return __builtin_bit_cast(bf16x8, w);
}
__device__ __forceinline__ bf16x8 lds_ld2x8(const LAS unsigned char* pl) {
    const u32x2 lo = *(const LAS u32x2*)pl, hi = *(const LAS u32x2*)(pl + 32);
    u32x4 w; w.x = lo.x; w.y = lo.y; w.z = hi.x; w.w = hi.y; return __builtin_bit_cast(bf16x8, w);
}
#define LDS_BAR() asm volatile("s_waitcnt lgkmcnt(0)\n\ts_barrier" ::: "memory")
__device__ __forceinline__ int kperm32(int o) { return (o < 16) ? (8 * (o >> 2) + (o & 3)) : (8 * ((o - 16) >> 2) + 4 + (o & 3)); }
#define MFMA16(a, b, c) __builtin_amdgcn_mfma_f32_16x16x32_bf16((a), (b), (c), 0, 0, 0)

namespace pg8 {
constexpr int BM = 256, BK = 64, HALF = 128, HTB = HALF * BK * 2, STAGE_BYTES = 8 * HTB;
__device__ __forceinline__ int lds_byte(int r, int c) { const int st = (r >> 4) * 2 + (c >> 5), rr = r & 15, cc = c & 31, ob = rr * 64 + cc * 2; return st * 1024 + (ob ^ (((ob >> 9) & 1) << 5)); }
__device__ __forceinline__ void stage_rc(int b, int& R, int& C) { const int st = b / 1024, sb = b % 1024, swz = sb ^ (((sb >> 9) & 1) << 5); R = (st >> 1) * 16 + swz / 64; C = (st & 1) * 32 + (swz % 64) / 2; }
__device__ __forceinline__ int perm32(int rho) { const int n = rho >> 4, i = rho & 15; return 8 * (i >> 2) + 4 * n + (i & 3); }

struct Unit { const char* a; const char* b; unsigned lda, ldb; int nt; int pm, pn, kind, sub; };

__device__ __forceinline__ void mkoff(const Unit& u, int tid, unsigned (&vA)[2], unsigned (&vB)[2]) {
#pragma unroll
    for (int i = 0; i < 2; ++i) { int R, C; stage_rc(tid * 16 + i * 8192, R, C); const int Rb = (R & ~31) + perm32(R & 31);
        vA[i] = (unsigned)(R * u.lda + C) * 2u; vB[i] = (unsigned)(Rb * u.ldb + C) * 2u; }
}

template <class Epi, class Sched>
__device__ __forceinline__ void gemm_phase(LAS unsigned char* lds, const Sched& S, const Epi& E) {
    int tid_ = threadIdx.x; asm volatile("" : "+v"(tid_));
    const int tid = tid_, wid = __builtin_amdgcn_readfirstlane(tid >> 6), lane = tid & 63, wr = wid >> 2, wc = wid & 3, fr = lane & 15, fq = lane >> 4;
    const size_t kstep = (size_t)(BK * 2);
    const unsigned ldsw = (unsigned)wid * 1024u;
    const int aoff = lds_byte(wr * 64 + fr, fq * 8), boff = lds_byte(wc * 32 + fr, fq * 8);
#define PG8_SA(b, h) (((b) * 2 + (h)) * HTB)
#define PG8_SB(b, h) ((4 + (b) * 2 + (h)) * HTB)
#define PG8_STAGE(bufoff, gbase, voff) do { _Pragma("unroll") for (int _i = 0; _i < 2; ++_i) \
        __builtin_amdgcn_global_load_lds((const unsigned*)((const char*)(gbase) + (voff)[_i]), (LAS unsigned*)(lds + (bufoff) + ldsw + _i * 8192), 16, 0, 0); } while (0)
#define PG8_LDA(dst, b, h) do { _Pragma("unroll") for (int m = 0; m < 4; ++m) _Pragma("unroll") for (int k = 0; k < 2; ++k) dst[m][k] = *(const LAS bf16x8*)(lds + PG8_SA(b, h) + aoff + m * 2048 + k * 1024); } while (0)
#define PG8_LDB(dst, b, h) do { _Pragma("unroll") for (int n = 0; n < 2; ++n) _Pragma("unroll") for (int k = 0; k < 2; ++k) dst[n][k] = *(const LAS bf16x8*)(lds + PG8_SB(b, h) + boff + n * 2048 + k * 1024); } while (0)
#define PG8_MMA(ai, bj, At, Bt) do { __builtin_amdgcn_s_setprio(1); _Pragma("unroll") for (int m = 0; m < 4; ++m) _Pragma("unroll") for (int n = 0; n < 2; ++n) _Pragma("unroll") for (int k = 0; k < 2; ++k) \
        acc[ai][bj][m][n] = __builtin_amdgcn_mfma_f32_16x16x32_bf16(Bt[n][k], At[m][k], acc[ai][bj][m][n], 0, 0, 0); __builtin_amdgcn_s_setprio(0); } while (0)
#define PG8_WAIT_V(n) asm volatile("s_waitcnt vmcnt(" #n ")" ::: "memory")
#define PG8_WAIT_L(n) asm volatile("s_waitcnt lgkmcnt(" #n ")" ::: "memory")
#define PG8_BAR __builtin_amdgcn_s_barrier()
#define PG8_SCHED __builtin_amdgcn_sched_barrier(0)
    Unit cur, nxt; int ui = 0;
    if (!S.next(0, cur)) return;
    f32x4 acc[2][2][4][2];
#pragma unroll
    for (int a = 0; a < 2; ++a)
#pragma unroll
        for (int b = 0; b < 2; ++b)
#pragma unroll
            for (int m = 0; m < 4; ++m)
#pragma unroll
                for (int n = 0; n < 2; ++n) acc[a][b][m][n] = (f32x4){0.f, 0.f, 0.f, 0.f};
    bf16x8 At[4][2], B0[2][2], B1[2][2];
    unsigned vAc[2], vBc[2], vAn[2], vBn[2];
    mkoff(cur, tid, vAc, vBc);
    const char* cA = cur.a; const char* cB = cur.b;
    size_t hAc = (size_t)HALF * cur.lda * 2, hBc = (size_t)HALF * cur.ldb * 2;
    PG8_STAGE(PG8_SB(0, 0), cB, vBc); PG8_STAGE(PG8_SB(0, 1), cB + hBc, vBc); PG8_STAGE(PG8_SA(0, 0), cA, vAc); PG8_STAGE(PG8_SA(0, 1), cA + hAc, vAc);
    if (wr == 1) PG8_BAR;
    PG8_WAIT_V(2); PG8_BAR;
    PG8_STAGE(PG8_SB(1, 0), cB + kstep, vBc); PG8_STAGE(PG8_SA(1, 0), cA + kstep, vAc); PG8_STAGE(PG8_SB(1, 1), cB + hBc + kstep, vBc);
    PG8_WAIT_V(6); PG8_BAR;
    for (;;) {
        const bool has_next = S.next(ui + 1, nxt);
        const char* nA = cA; const char* nB = cB; size_t hAn = hAc, hBn = hBc;
        vAn[0] = vAc[0]; vAn[1] = vAc[1]; vBn[0] = vBc[0]; vBn[1] = vBc[1];
        if (has_next) { nA = nxt.a; nB = nxt.b; mkoff(nxt, tid, vAn, vBn); hAn = (size_t)HALF * nxt.lda * 2; hBn = (size_t)HALF * nxt.ldb * 2; }
        const int nt = cur.nt;
        for (int t = 0; t < nt; t += 2) {
            const bool last = (t == nt - 2);
            const char* a1 = cA + (size_t)(t + 1) * kstep;
            const char* a2 = last ? nA : cA + (size_t)(t + 2) * kstep; const char* b2 = last ? nB : cB + (size_t)(t + 2) * kstep;
            const char* a3 = a2 + kstep; const char* b3 = b2 + kstep;
            unsigned vA2[2], vB2[2];
            vA2[0] = last ? vAn[0] : vAc[0]; vA2[1] = last ? vAn[1] : vAc[1]; vB2[0] = last ? vBn[0] : vBc[0]; vB2[1] = last ? vBn[1] : vBc[1];
            const size_t hA2 = last ? hAn : hAc, hB2 = last ? hBn : hBc;
            PG8_LDB(B0, 0, 0); PG8_LDB(B1, 0, 1); PG8_SCHED; PG8_LDA(At, 0, 0); PG8_STAGE(PG8_SA(1, 1), a1 + hAc, vAc);
            PG8_WAIT_V(8); PG8_WAIT_L(0); PG8_BAR; PG8_MMA(0, 0, At, B0); PG8_MMA(0, 1, At, B1); PG8_BAR; PG8_SCHED;
            PG8_LDA(At, 0, 1); PG8_STAGE(PG8_SB(0, 0), b2, vB2); PG8_STAGE(PG8_SB(0, 1), b2 + hB2, vB2); PG8_STAGE(PG8_SA(0, 0), a2, vA2);
            PG8_WAIT_V(8); PG8_WAIT_L(0); PG8_BAR; PG8_MMA(1, 0, At, B0); PG8_MMA(1, 1, At, B1); PG8_BAR; PG8_SCHED;
            PG8_LDB(B0, 1, 0); PG8_LDB(B1, 1, 1); PG8_SCHED; PG8_LDA(At, 1, 0); PG8_STAGE(PG8_SA(0, 1), a2 + hA2, vA2);
            PG8_WAIT_V(8); PG8_WAIT_L(0); PG8_BAR; PG8_MMA(0, 0, At, B0); PG8_MMA(0, 1, At, B1); PG8_BAR; PG8_SCHED;
            PG8_LDA(At, 1, 1); PG8_STAGE(PG8_SB(1, 0), b3, vB2); PG8_STAGE(PG8_SB(1, 1), b3 + hB2, vB2); PG8_STAGE(PG8_SA(1, 0), a3, vA2);
            PG8_WAIT_V(8); PG8_WAIT_L(0); PG8_BAR; PG8_MMA(1, 0, At, B0); PG8_MMA(1, 1, At, B1); PG8_BAR; PG8_SCHED;
        }
        if (wr == 0) PG8_BAR;
        E(acc, cur, wr, wc, fr, fq, tid);
        if (!has_next) break;
#pragma unroll
        for (int a = 0; a < 2; ++a)
#pragma unroll
            for (int b = 0; b < 2; ++b)
#pragma unroll
                for (int m = 0; m < 4; ++m)
#pragma unroll
                    for (int n = 0; n < 2; ++n) acc[a][b][m][n] = (f32x4){0.f, 0.f, 0.f, 0.f};
        cur = nxt; cA = nA; cB = nB; hAc = hAn; hBc = hBn; vAc[0] = vAn[0]; vAc[1] = vAn[1]; vBc[0] = vBn[0]; vBc[1] = vBn[1]; ++ui;
        if (wr == 1) PG8_BAR;
    }
    PG8_WAIT_V(0);
    PG8_BAR;
#undef PG8_SA
#undef PG8_SB
#undef PG8_STAGE
#undef PG8_LDA
#undef PG8_LDB
#undef PG8_MMA
#undef PG8_WAIT_V
#undef PG8_WAIT_L
#undef PG8_BAR
#undef PG8_SCHED
}
}
using pg8::Unit;

struct Epi {
    unsigned char* ws;
    __device__ __forceinline__ void operator()(const f32x4 (&acc)[2][2][4][2], const Unit& u, int wr, int wc, int fr, int fq, int tid) const {
        asm volatile("" : "+v"(tid), "+v"(fr), "+v"(fq));
        const int row0 = u.pm * 256 + wr * 64 + fr, col0 = u.pn * 256 + wc * 32 + 8 * fq;
        if (u.kind == 0) {
            bf16_t* cols = (bf16_t*)(ws + WS_COLS); bf16_t* halo = (bf16_t*)(ws + WS_HALO);
            const int pn = u.pn;
            const int act = (pn == 6 || pn == 7 || pn == 12 || pn == 13 || pn == 17 || pn == 18 || pn >= 21) ? 1 : ((pn >= 8 && pn <= 11) ? 2 : 0);
#pragma unroll
            for (int ai = 0; ai < 2; ++ai)
#pragma unroll
                for (int m = 0; m < 4; ++m) {
                    const int r = row0 + ai * 128 + m * 16;
                    bf16_t* rowp = cols + (size_t)r * NC + col0;
#pragma unroll
                    for (int bj = 0; bj < 2; ++bj) {
                        f32x4 v0 = acc[ai][bj][m][0], v1 = acc[ai][bj][m][1];
                        if (act == 1) {
#pragma unroll
                            for (int e = 0; e < 4; ++e) { v0[e] = silu_fast(v0[e]); v1[e] = silu_fast(v1[e]); }
                        } else if (act == 2) {
#pragma unroll
                            for (int e = 0; e < 4; ++e) { v0[e] = gelu_fast(v0[e]); v1[e] = gelu_fast(v1[e]); }
                        }
                        u32x4 w; w.x = cvt_pk_bf16(v0[0], v0[1]); w.y = cvt_pk_bf16(v0[2], v0[3]); w.z = cvt_pk_bf16(v1[0], v1[1]); w.w = cvt_pk_bf16(v1[2], v1[3]);
                        *(u32x4*)(rowp + bj * 128) = w;
                        if (pn < 6 && (r & 63) >= 61) *(u32x4*)(halo + ((size_t)(r >> 6) * 3 + ((r & 63) - 61)) * 1536 + col0 + bj * 128) = w;
                    }
                }
        } else if (u.kind == 1) {
            bf16_t* o = (bf16_t*)(ws + WS_MEMKV);
#pragma unroll
            for (int ai = 0; ai < 2; ++ai)
#pragma unroll
                for (int m = 0; m < 4; ++m) {
                    bf16_t* rowp = o + (size_t)(row0 + ai * 128 + m * 16) * 1024 + col0;
#pragma unroll
                    for (int bj = 0; bj < 2; ++bj) {
                        const f32x4 v0 = acc[ai][bj][m][0], v1 = acc[ai][bj][m][1];
                        u32x4 w; w.x = cvt_pk_bf16(v0[0], v0[1]); w.y = cvt_pk_bf16(v0[2], v0[3]); w.z = cvt_pk_bf16(v1[0], v1[1]); w.w = cvt_pk_bf16(v1[2], v1[3]);
                        *(u32x4*)(rowp + bj * 128) = w;
                    }
                }
        } else if (u.kind == 2) {
            u32x4* g = (u32x4*)(ws + WS_GSCR) + (size_t)(u.pm * 4 + u.pn) * 16 * 512 + tid;
#pragma unroll
            for (int ai = 0; ai < 2; ++ai)
#pragma unroll
                for (int m = 0; m < 4; ++m)
#pragma unroll
                    for (int bj = 0; bj < 2; ++bj) {
                        const f32x4 v0 = acc[ai][bj][m][0], v1 = acc[ai][bj][m][1];
                        u32x4 w; w.x = cvt_pk_bf16(v0[0], v0[1]); w.y = cvt_pk_bf16(v0[2], v0[3]);
                        w.z = cvt_pk_bf16(v1[0], v1[1]); w.w = cvt_pk_bf16(v1[2], v1[3]);
                        g[(size_t)((ai * 4 + m) * 2 + bj) * 512] = w;
                    }
        } else if (u.kind == 3) {
            const unsigned char* gb = ws + WS_GSCR + (size_t)(u.pm * 4 + u.pn) * 16 * 512 * 16;
            unsigned char* mb = ws + WS_MERGED + (size_t)u.pm * 256 * 2048 + (size_t)u.pn * 512;
            const unsigned gvo = (unsigned)tid * 16u, mvo = (unsigned)((wr * 64 + fr) * 2048 + (wc * 32 + 8 * fq) * 2);
            u32x4 gwn[2];
            gwn[0] = *(const u32x4*)(gb + gvo); gwn[1] = *(const u32x4*)(gb + 8192 + gvo);
#pragma unroll
            for (int sp = 0; sp < 8; ++sp) {
                const int ai = sp >> 2, m = sp & 3;
                u32x4 gw[2], pw[2];
                gw[0] = gwn[0]; gw[1] = gwn[1];
#pragma unroll
                for (int k = 0; k < 2; ++k) { pw[k] = (u32x4){0u, 0u, 0u, 0u};
                    if (u.sub > 0) pw[k] = *(const u32x4*)(mb + (size_t)(ai * 128 + m * 16) * 2048 + k * 256 + mvo); }
                if (sp + 1 < 8) { gwn[0] = *(const u32x4*)(gb + (size_t)(2 * (sp + 1)) * 8192 + gvo); gwn[1] = *(const u32x4*)(gb + (size_t)(2 * (sp + 1) + 1) * 8192 + gvo); }
#pragma unroll
                for (int k = 0; k < 2; ++k) { const int bj = k;
                    const f32x4 v0 = acc[ai][bj][m][0], v1 = acc[ai][bj][m][1];
                    const float r0 = sigmoid_fast(lo_bf(gw[k].x)) * v0[0] + lo_bf(pw[k].x), r1 = sigmoid_fast(hi_bf(gw[k].x)) * v0[1] + hi_bf(pw[k].x), r2 = sigmoid_fast(lo_bf(gw[k].y)) * v0[2] + lo_bf(pw[k].y), r3 = sigmoid_fast(hi_bf(gw[k].y)) * v0[3] + hi_bf(pw[k].y);
                    const float r4 = sigmoid_fast(lo_bf(gw[k].z)) * v1[0] + lo_bf(pw[k].z), r5 = sigmoid_fast(hi_bf(gw[k].z)) * v1[1] + hi_bf(pw[k].z), r6 = sigmoid_fast(lo_bf(gw[k].w)) * v1[2] + lo_bf(pw[k].w), r7 = sigmoid_fast(hi_bf(gw[k].w)) * v1[3] + hi_bf(pw[k].w);
                    u32x4 w; w.x = cvt_pk_bf16(r0, r1); w.y = cvt_pk_bf16(r2, r3); w.z = cvt_pk_bf16(r4, r5); w.w = cvt_pk_bf16(r6, r7);
                    *(u32x4*)(mb + (size_t)(ai * 128 + m * 16) * 2048 + bj * 256 + mvo) = w; }
                asm volatile("" ::: "memory");
            }
        } else {
            bf16_t* o = (bf16_t*)(ws + WS_OUT);
#pragma unroll
            for (int ai = 0; ai < 2; ++ai)
#pragma unroll
                for (int m = 0; m < 4; ++m) {
                    bf16_t* rowp = o + (size_t)(row0 + ai * 128 + m * 16) * 1024 + col0;
#pragma unroll
                    for (int bj = 0; bj < 2; ++bj) { const f32x4 v0 = acc[ai][bj][m][0], v1 = acc[ai][bj][m][1];
                        u32x4 w; w.x = cvt_pk_bf16(v0[0], v0[1]); w.y = cvt_pk_bf16(v0[2], v0[3]); w.z = cvt_pk_bf16(v1[0], v1[1]); w.w = cvt_pk_bf16(v1[2], v1[3]);
                        *(u32x4*)(rowp + bj * 128) = w; }
                }
        }
    }
};

struct SchedA {
    const unsigned char* ws; int G, c;
    __device__ __forceinline__ bool next(int i, Unit& u) const {
        const int L = i * G + c;
        constexpr int nN = 23, nwg = 64 * nN;
        if (L < nwg) {
            int wgid = L; { const int q = nwg / 8, xcd = wgid % 8, off = wgid / 8; wgid = xcd * q + off; }
            const int nig = 8 * nN, gid = wgid / nig, fm = gid * 8;
            u.pm = fm + ((wgid % nig) % 8); u.pn = (wgid % nig) / 8; u.kind = 0; u.sub = 0; u.lda = 1024; u.ldb = 1024; u.nt = 16;
            u.a = (const char*)(ws + WS_H) + (size_t)u.pm * 256 * 1024 * 2; u.b = (const char*)(ws + WS_WINT) + (size_t)u.pn * 256 * 1024 * 2;
            return true;
        }
        const int r = L - nwg; if (r >= 32) return false;
        u.pm = r >> 2; u.pn = r & 3; u.kind = 1; u.sub = 0; u.lda = 1024; u.ldb = 1024; u.nt = 16;
        u.a = (const char*)(ws + WS_MEMN) + (size_t)u.pm * 256 * 1024 * 2; u.b = (const char*)(ws + WS_WMKVT) + (size_t)u.pn * 256 * 1024 * 2;
        return true;
    }
};
struct SchedD {
    const unsigned char* ws; int G, vcu;
    __device__ __forceinline__ bool next(int i, Unit& u) const {
        const int tile = vcu + (i >> 3) * G; if (tile >= 256) return false;
        const int sub = i & 7, n = sub >> 1;
        u.pm = tile >> 2; u.pn = tile & 3; u.sub = n;
        if ((sub & 1) == 0) { u.kind = 2; u.lda = 1024; u.ldb = 1024; u.nt = 16;
            u.a = (const char*)(ws + WS_H) + (size_t)u.pm * 256 * 1024 * 2; u.b = (const char*)(ws + WS_WGT) + (size_t)(n * 1024 + u.pn * 256) * 1024 * 2;
        } else { u.kind = 3; u.lda = NC; u.ldb = 512; u.nt = 8;
            const int yoff = n == 0 ? C_DNZ : (n == 1 ? C_GMU : (n == 2 ? C_SWQ : C_XMQ));
            u.a = (const char*)(ws + WS_COLS) + ((size_t)u.pm * 256 * NC + yoff) * 2; u.b = (const char*)(ws + WS_WUPT) + (size_t)(n * 1024 + u.pn * 256) * 512 * 2; }
        return true;
    }
};
struct SchedE {
    const unsigned char* ws; int G, vcu;
    __device__ __forceinline__ bool next(int i, Unit& u) const {
        const int tile = vcu + i * G; if (tile >= 256) return false;
        u.pm = tile >> 2; u.pn = tile & 3; u.kind = 4; u.sub = 0; u.lda = 1024; u.ldb = 1024; u.nt = 16;
        u.a = (const char*)(ws + WS_MERGED) + (size_t)u.pm * 256 * 1024 * 2; u.b = (const char*)(ws + WS_WOUTT) + (size_t)u.pn * 256 * 1024 * 2;
        return true;
    }
};

__device__ __forceinline__ void tr_item(const float* W, int ldw, int k0, bf16_t* WT, int Kdst, LAS float* scr, int lane) {
    float tv[32];
#pragma unroll
    for (int i = 0; i < 32; ++i) tv[i] = __builtin_nontemporal_load(&W[(size_t)(k0 + 2 * i + (lane >> 5)) * ldw + (lane & 31)]);
#pragma unroll
    for (int i = 0; i < 32; ++i) scr[(2 * i + (lane >> 5)) * 33 + (lane & 31)] = tv[i];
    asm volatile("s_waitcnt lgkmcnt(0)" ::: "memory");
    const int c = lane & 7;
#pragma unroll
    for (int j = 0; j < 4; ++j) { const int n = (lane >> 3) + 8 * j; const LAS float* s = scr + (8 * c) * 33 + n;
        u32x4 o; o.x = cvt_pk_bf16(s[0 * 33], s[1 * 33]); o.y = cvt_pk_bf16(s[2 * 33], s[3 * 33]); o.z = cvt_pk_bf16(s[4 * 33], s[5 * 33]); o.w = cvt_pk_bf16(s[6 * 33], s[7 * 33]);
        *(u32x4*)(WT + (size_t)n * Kdst + k0 + 8 * c) = o; }
    asm volatile("s_waitcnt lgkmcnt(0)" ::: "memory");
}

__device__ __forceinline__ void p0_stage(const Params& p, int rk, LAS unsigned char* lds) {
    int tid_ = threadIdx.x; asm volatile("" : "+v"(tid_));
    const int tid = tid_, lane = tid & 63, wave = tid >> 6;
    const int gw = blockIdx.x * 8 + wave, NGW = gridDim.x * 8;
    unsigned char* ws = p.ws;
    LAS float* W8T = (LAS float*)(lds + 8 * 8448);
    if (rk <= 1) {
        const int l = rk;
        const float* win = p.w_in + (size_t)l * 1024 * DIN;
        {   f32x4 wv[4];
#pragma unroll
            for (int t2 = 0; t2 < 2; ++t2) { const float* wp = win + (size_t)(tid + 512 * t2) * DIN + 2048; wv[2 * t2] = *(const f32x4*)wp; wv[2 * t2 + 1] = *(const f32x4*)(wp + 4); }
#pragma unroll
            for (int t2 = 0; t2 < 2; ++t2)
#pragma unroll
                for (int j = 0; j < 8; ++j) W8T[j * 1024 + tid + 512 * t2] = wv[2 * t2 + (j >> 2)][j & 3]; }
        LAS float* scr = (LAS float*)(lds + wave * 8448);
        for (int it = gw; it < 7040; it += NGW) {
            if (it < 2944) { const int kb = it / 184, nb = it % 184, n0 = 32 * nb, sc = n0 < 2048 ? n0 : n0 + 8;
                tr_item(win + sc, DIN, 64 * kb, (bf16_t*)(ws + WS_WINT) + (size_t)n0 * 1024, 1024, scr, lane);
            } else if (it < 4992) { const int r = it - 2944, kb = r / 128, nb = r % 128;
                tr_item(win + 5896 + 32 * nb, DIN, 64 * kb, (bf16_t*)(ws + WS_WGT) + (size_t)(32 * nb) * 1024, 1024, scr, lane);
            } else if (it < 6016) { const int r = it - 4992, n = r / 256, r2 = r % 256, kb = r2 / 32, nb = r2 % 32;
                tr_item(p.w_up + (size_t)(l * 4 + n) * 512 * 1024 + 32 * nb, 1024, 64 * kb, (bf16_t*)(ws + WS_WUPT) + (size_t)(n * 1024 + 32 * nb) * 512, 512, scr, lane);
            } else if (it < 6528) { const int r = it - 6016, kb = r / 32, nb = r % 32;
                tr_item(p.w_out + (size_t)l * 1024 * 1024 + 32 * nb, 1024, 64 * kb, (bf16_t*)(ws + WS_WOUTT) + (size_t)(32 * nb) * 1024, 1024, scr, lane);
            } else { const int r = it - 6528, kb = r / 32, nb = r % 32;
                tr_item(p.w_mem_kv + (size_t)l * 1024 * 1024 + 32 * nb, 1024, 64 * kb, (bf16_t*)(ws + WS_WMKVT) + (size_t)(32 * nb) * 1024, 1024, scr, lane);
            }
        }
        for (int e = blockIdx.x * 512 + tid; e < 65536; e += gridDim.x * 512) { const int pp = (e >> 7) & 127, qq = e & 127;
            ((bf16_t*)(ws + WS_SPW))[e] = (bf16_t)(qq <= pp ? f2bf(p.spatial_w[(size_t)l * 65536 + e]) : 0u); }
        for (int r = gw; r < 2048; r += NGW) {
            const f32x4* xr = (const f32x4*)(p.mem + (size_t)r * D) + lane; const f32x4* gr = (const f32x4*)(p.norm_mem + l * D) + lane;
            f32x4 v[4]; float ss = 0.f;
#pragma unroll
            for (int j = 0; j < 4; ++j) { v[j] = __builtin_nontemporal_load(&xr[64 * j]); ss += v[j][0] * v[j][0] + v[j][1] * v[j][1] + v[j][2] * v[j][2] + v[j][3] * v[j][3]; }
            const float rstd = rsqrtf(wave_sum(ss) * (1.f / D) + EPS);
            u32x2* o = (u32x2*)((bf16_t*)(ws + WS_MEMN) + (size_t)r * D) + lane;
#pragma unroll
            for (int j = 0; j < 4; ++j) { const f32x4 g = gr[64 * j]; u32x2 w; w.x = cvt_pk_bf16(v[j][0] * rstd * g[0], v[j][1] * rstd * g[1]); w.y = cvt_pk_bf16(v[j][2] * rstd * g[2], v[j][3] * rstd * g[3]); o[64 * j] = w; }
        }
    }
    __syncthreads();
    const float* xin = rk == 2 ? p.out : p.x;
    for (int row0 = gw; row0 < M; row0 += 2 * NGW) {
        f32x4 v[2][4], o[2][4];
#pragma unroll
        for (int rr = 0; rr < 2; ++rr) { const int row = row0 + rr * NGW;
            const f32x4* xr = (const f32x4*)(xin + (size_t)row * D) + lane;
#pragma unroll
            for (int j = 0; j < 4; ++j) v[rr][j] = __builtin_nontemporal_load(&xr[64 * j]);
            if (rk >= 1) { const u32x2* orow = (const u32x2*)((const bf16_t*)(ws + WS_OUT) + (size_t)row * D) + lane;
#pragma unroll
                for (int j = 0; j < 4; ++j) { const u32x2 ow = __builtin_nontemporal_load(&orow[64 * j]); o[rr][j] = (f32x4){lo_bf(ow.x), hi_bf(ow.x), lo_bf(ow.y), hi_bf(ow.y)}; } } }
        if (rk >= 1) {
            const f32x4* gr = (const f32x4*)(p.norm_post + (rk - 1) * D) + lane;
            float ss[2] = {0.f, 0.f};
#pragma unroll
            for (int rr = 0; rr < 2; ++rr)
#pragma unroll
                for (int j = 0; j < 4; ++j) ss[rr] += o[rr][j][0] * o[rr][j][0] + o[rr][j][1] * o[rr][j][1] + o[rr][j][2] * o[rr][j][2] + o[rr][j][3] * o[rr][j][3];
#pragma unroll
            for (int of = 1; of < 64; of <<= 1) { ss[0] += __shfl_xor(ss[0], of); ss[1] += __shfl_xor(ss[1], of); }
#pragma unroll
            for (int rr = 0; rr < 2; ++rr) { const float rstd = rsqrtf(ss[rr] * (1.f / D) + EPS);
                f32x4* dst = (f32x4*)(p.out + (size_t)(row0 + rr * NGW) * D) + lane;
#pragma unroll
                for (int j = 0; j < 4; ++j) { const f32x4 g = gr[64 * j]; v[rr][j] = v[rr][j] + o[rr][j] * rstd * g; dst[64 * j] = v[rr][j]; } }
        }
        if (rk <= 1) {
            const f32x4* gr = (const f32x4*)(p.norm_pre + rk * D) + lane;
            float ss[2] = {0.f, 0.f};
#pragma unroll
            for (int rr = 0; rr < 2; ++rr)
#pragma unroll
                for (int j = 0; j < 4; ++j) ss[rr] += v[rr][j][0] * v[rr][j][0] + v[rr][j][1] * v[rr][j][1] + v[rr][j][2] * v[rr][j][2] + v[rr][j][3] * v[rr][j][3];
#pragma unroll
            for (int of = 1; of < 64; of <<= 1) { ss[0] += __shfl_xor(ss[0], of); ss[1] += __shfl_xor(ss[1], of); }
            LAS float* red = (LAS float*)(lds + 8 * 8448 + 32768) + wave * 1024;
#pragma unroll
            for (int rr = 0; rr < 2; ++rr) { const float rstd = rsqrtf(ss[rr] * (1.f / D) + EPS);
                u32x2* oh = (u32x2*)((bf16_t*)(ws + WS_H) + (size_t)(row0 + rr * NGW) * D) + lane;
#pragma unroll
                for (int j = 0; j < 4; ++j) { const f32x4 g = gr[64 * j]; v[rr][j] = v[rr][j] * rstd * g; u32x2 w; w.x = cvt_pk_bf16(v[rr][j][0], v[rr][j][1]); w.y = cvt_pk_bf16(v[rr][j][2], v[rr][j][3]); oh[64 * j] = w; }
#pragma unroll
                for (int jj = 0; jj < 8; ++jj) { float a = 0.f;
#pragma unroll
                    for (int j = 0; j < 4; ++j) { const f32x4 w = *(const LAS f32x4*)(W8T + jj * 1024 + 256 * j + 4 * lane); a += v[rr][j][0] * w[0] + v[rr][j][1] * w[1] + v[rr][j][2] * w[2] + v[rr][j][3] * w[3]; }
                    red[rr * 512 + jj * 64 + lane] = a; } }
            asm volatile("s_waitcnt lgkmcnt(0)" ::: "memory");
#pragma unroll
            for (int rr = 0; rr < 2; ++rr) { const f32x4 r0 = *(const LAS f32x4*)(red + rr * 512 + lane * 8), r1 = *(const LAS f32x4*)(red + rr * 512 + lane * 8 + 4);
                float a = (r0[0] + r0[1]) + (r0[2] + r0[3]) + (r1[0] + r1[1]) + (r1[2] + r1[3]);
                a += __shfl_xor(a, 1); a += __shfl_xor(a, 2); a += __shfl_xor(a, 4);
                if ((lane & 7) == 0) ((float*)(ws + WS_SM) + (size_t)(row0 + rr * NGW) * 8)[lane >> 3] = a; }
            asm volatile("s_waitcnt lgkmcnt(0)" ::: "memory");
        }
    }
    __syncthreads();
}

__device__ __forceinline__ void delta_pre_unit(const Params& p, int l, int unit, LAS unsigned char* lds) {
    int tid_ = threadIdx.x; asm volatile("" : "+v"(tid_));
    const int tid = tid_, lane = tid & 63, wave = tid >> 6;
    const int h = unit & 3, gch = unit >> 2, c = gch & 31;
    const size_t row0 = (size_t)gch * 64;
    unsigned char* ws = p.ws;
    bf16_t* cols = (bf16_t*)(ws + WS_COLS);
    LAS float* Qf = (LAS float*)lds; LAS float* Kf = Qf + 64 * 129; LAS float* Vf = Kf + 64 * 129; LAS float* Lf = Vf + 64 * 129;
    LAS bf16_t* Qb = (LAS bf16_t*)(Lf + 64 * 68); LAS bf16_t* Kb = Qb + 64 * 136;
    LAS float* gcs = (LAS float*)(lds + 154112); LAS float* betas = gcs + 64; LAS float* facs = betas + 64;
    LAS bf16_t* Rw = (LAS bf16_t*)Lf;
    {
#pragma unroll
        for (int it = 0; it < 6; ++it) { const int pc = tid + 512 * it, r = pc / 48, rem = pc % 48, part = rem >> 4, cp = rem & 15;
            const u32x4 v = *(const u32x4*)(cols + (row0 + r) * NC + part * 512 + h * 128 + cp * 8);
            *(LAS u32x4*)(Rw + (r + 3) * 384 + part * 128 + cp * 8) = v; }
        if (tid < 144) { const int r = tid / 48, rem = tid % 48, part = rem >> 4, cp = rem & 15;
            u32x4 v = {0u, 0u, 0u, 0u};
            if (c > 0) v = *(const u32x4*)((const bf16_t*)(ws + WS_HALO) + ((size_t)(gch - 1) * 3 + r) * 1536 + part * 512 + h * 128 + cp * 8);
            *(LAS u32x4*)(Rw + r * 384 + part * 128 + cp * 8) = v; }
        if (wave == 6) {
            const float* sm = (const float*)(ws + WS_SM) + (row0 + lane) * 8;
            const float a = sm[4 + h] + p.dt_bias[l * 4 + h];
            const float sp = a > 20.f ? a : __logf(1.f + __expf(a));
            float g = -__expf(p.a_log[l * 4 + h]) * sp;
#pragma unroll
            for (int o = 1; o < 64; o <<= 1) { const float t = __shfl_up(g, o); if (lane >= o) g += t; }
            gcs[lane] = g;
        } else if (wave == 7) {
            const float* sm = (const float*)(ws + WS_SM) + (row0 + lane) * 8;
            betas[lane] = sigmoid_f(sm[h]);
        }
    }
    LDS_BAR();
    if (tid < 384) {
        const int quad = tid % 96, seg = tid / 96, c4 = 4 * quad, part = c4 >> 7, cc = c4 & 127;
        const float* cw = p.conv_w + (size_t)l * 4 * 1536 + part * 512 + h * 128 + cc;
        const f32x4 w0 = *(const f32x4*)cw, w1 = *(const f32x4*)(cw + 1536), w2 = *(const f32x4*)(cw + 2 * 1536), w3 = *(const f32x4*)(cw + 3 * 1536);
        const LAS bf16_t* src = Rw + (16 * seg) * 384 + c4;
        u32x2 rv[19];
#pragma unroll
        for (int r = 0; r < 19; ++r) rv[r] = *(const LAS u32x2*)(src + r * 384);
        LAS float* dst = (part == 0 ? Qf : (part == 1 ? Kf : Vf)) + (16 * seg) * 129 + cc;
#pragma unroll
        for (int r = 0; r < 16; ++r) {
            const u32x2 a3 = rv[r], a2 = rv[r + 1], a1 = rv[r + 2], a0 = rv[r + 3];
            const float y0 = w0[0] * lo_bf(a3.x) + w1[0] * lo_bf(a2.x) + w2[0] * lo_bf(a1.x) + w3[0] * lo_bf(a0.x);
            const float y1 = w0[1] * hi_bf(a3.x) + w1[1] * hi_bf(a2.x) + w2[1] * hi_bf(a1.x) + w3[1] * hi_bf(a0.x);
            const float y2 = w0[2] * lo_bf(a3.y) + w1[2] * lo_bf(a2.y) + w2[2] * lo_bf(a1.y) + w3[2] * lo_bf(a0.y);
            const float y3 = w0[3] * hi_bf(a3.y) + w1[3] * hi_bf(a2.y) + w2[3] * hi_bf(a1.y) + w3[3] * hi_bf(a0.y);
            dst[r * 129 + 0] = silu_f(y0); dst[r * 129 + 1] = silu_f(y1); dst[r * 129 + 2] = silu_f(y2); dst[r * 129 + 3] = silu_f(y3);
        }
    }
    LDS_BAR();
    if (tid < 64) { facs[tid] = betas[tid]; facs[64 + tid] = betas[tid] * __expf(gcs[tid]); }
    {
        const int r = tid >> 3, sub = tid & 7; float sq = 0.f, sk = 0.f;
#pragma unroll
        for (int e = 0; e < 16; ++e) { const float a = Qf[r * 129 + sub * 16 + e]; sq += a * a; const float b = Kf[r * 129 + sub * 16 + e]; sk += b * b; }
        sq += __shfl_xor(sq, 1); sq += __shfl_xor(sq, 2); sq += __shfl_xor(sq, 4);
        sk += __shfl_xor(sk, 1); sk += __shfl_xor(sk, 2); sk += __shfl_xor(sk, 4);
        const float rq = rsqrtf(sq + EPS) * 0.08838834764831845f, rkk = rsqrtf(sk + EPS);
#pragma unroll
        for (int e = 0; e < 16; ++e) { const int o = sub * 16 + e; const float a = Qf[r * 129 + o] * rq; Qb[r * 136 + o] = (bf16_t)f2bf(a);
            const float b = Kf[r * 129 + o] * rkk; Kf[r * 129 + o] = b; Kb[r * 136 + o] = (bf16_t)f2bf(b); }
    }
    LDS_BAR();
    LAS bf16_t* Al = (LAS bf16_t*)Qf;
    LAS float* Db = Qf;
    LAS bf16_t* Lb = (LAS bf16_t*)(lds + 16640);
    LAS bf16_t* XT = Qb;
    LAS bf16_t* Wl = (LAS bf16_t*)Vf;
    {
        const int i = lane & 15, q = lane >> 4;
#pragma unroll
        for (int jb = 0; jb < 4; ++jb) { const int job = wave + 8 * jb;
            const int kind = job >> 4, ct = (job >> 2) & 3, st = job & 3;
            f32x4 acc = {0.f, 0.f, 0.f, 0.f};
            if (st <= ct) {
                const LAS bf16_t* Ab = kind == 0 ? Kb : Qb;
#pragma unroll
                for (int ks = 0; ks < 4; ++ks) { const bf16x8 a = *(const LAS bf16x8*)(Ab + (16 * ct + i) * 136 + 32 * ks + 8 * q); const bf16x8 b = *(const LAS bf16x8*)(Kb + (16 * st + i) * 136 + 32 * ks + 8 * q);
                    acc = MFMA16(a, b, acc); }
            }
            const int s = 16 * st + i; const float gs = gcs[s];
#pragma unroll
            for (int r = 0; r < 4; ++r) { const int cr = 16 * ct + 4 * q + r; const float e = __expf(fminf(gcs[cr] - gs, 0.f));
                if (kind == 0) { const float v = (cr > s) ? acc[r] * betas[cr] * e : 0.f; Lf[cr * 68 + s] = v; Lb[cr * 72 + s] = (bf16_t)f2bf(v); }
                else Al[cr * 72 + (s & ~31) + kperm32(s & 31)] = (bf16_t)f2bf(cr >= s ? acc[r] * e : 0.f); }
        }
    }
    LDS_BAR();
    {
        *(u32x4*)(ws + WS_WA_A + (size_t)unit * 8192 + tid * 16) = *(const LAS u32x4*)(Al + (tid >> 3) * 72 + (tid & 7) * 8);
        { const int cr = tid >> 3, d0 = (tid & 7) * 16; const float e = __expf(gcs[cr]);
            bf16_t* dst = cols + (row0 + cr) * NC + C_DNQ + h * 128 + d0;
#pragma unroll
            for (int g4 = 0; g4 < 2; ++g4) { const u32x4 v = *(const LAS u32x4*)(Qb + cr * 136 + d0 + 8 * g4); u32x4 w;
                w.x = cvt_pk_bf16(lo_bf(v.x) * e, hi_bf(v.x) * e); w.y = cvt_pk_bf16(lo_bf(v.y) * e, hi_bf(v.y) * e); w.z = cvt_pk_bf16(lo_bf(v.z) * e, hi_bf(v.z) * e); w.w = cvt_pk_bf16(lo_bf(v.w) * e, hi_bf(v.w) * e);
                const int o0 = (d0 + 8 * g4) & 31, gb = (d0 + 8 * g4) & ~31;
                *(u32x2*)(dst - d0 + gb + kperm32(o0)) = (u32x2){w.x, w.y}; *(u32x2*)(dst - d0 + gb + kperm32(o0 + 4)) = (u32x2){w.z, w.w}; } }
        { const int dk = tid & 127, c0 = (tid >> 7) * 16; const float gl = gcs[63];
            bf16_t* dst = cols + (row0 + (dk >> 1)) * NC + C_DNK + h * 128 + (dk & 1) * 64 + c0;
#pragma unroll
            for (int g4 = 0; g4 < 2; ++g4) { float v[8];
#pragma unroll
                for (int e = 0; e < 8; ++e) { const int cr = c0 + 8 * g4 + e; v[e] = Kf[cr * 129 + dk] * __expf(gl - gcs[cr]); }
                u32x4 w; w.x = cvt_pk_bf16(v[0], v[1]); w.y = cvt_pk_bf16(v[2], v[3]); w.z = cvt_pk_bf16(v[4], v[5]); w.w = cvt_pk_bf16(v[6], v[7]);
                const int cc0 = c0 + 8 * g4, gb = cc0 & ~31, o0 = cc0 & 31;
                *(u32x2*)(dst - c0 + gb + kperm32(o0)) = (u32x2){w.x, w.y}; *(u32x2*)(dst - c0 + gb + kperm32(o0 + 4)) = (u32x2){w.z, w.w}; } }
        if (tid == 0) ((float*)(ws + WS_DL))[unit] = __expf(gcs[63]);
    }
    LDS_BAR();
    for (int e = tid; e < 2304; e += 512) ((LAS u32x4*)XT)[e] = (u32x4){0u, 0u, 0u, 0u};
    LDS_BAR();
    {
        const int j = tid & 255; const bool isv = j < 128; const int jj = j & 127;
        const LAS float* src = (isv ? Vf : Kf) + jj;
        const LAS float* fac = facs + (isv ? 0 : 64);
        const int i16 = lane & 15, q = lane >> 4;
        float x[64];
#pragma unroll
        for (int bb = 0; bb < 4; ++bb) {
            if (bb > 0) {
#pragma unroll
                for (int tt = 0; tt < 2; ++tt) { const int ct = 2 * wave + tt; f32x4 acc = {0.f, 0.f, 0.f, 0.f};
#pragma unroll
                    for (int ks = 0; ks < 2; ++ks) if (32 * ks < 16 * bb) acc = MFMA16(*(const LAS bf16x8*)(Lb + (16 * bb + i16) * 72 + 32 * ks + 8 * q), *(const LAS bf16x8*)(XT + (16 * ct + i16) * 72 + 32 * ks + 8 * q), acc);
#pragma unroll
                    for (int r = 0; r < 4; ++r) Db[(4 * q + r) * 260 + 16 * ct + i16] = acc[r]; }
                LDS_BAR();
            }
            if (tid < 256) {
                int Lr[16]; float rh[16];
#pragma unroll
                for (int i = 0; i < 16; ++i) { const int row = 16 * bb + i;
                    Lr[i] = __float_as_int(Lf[row * 68 + 16 * bb + i16]);
                    rh[i] = src[row * 129] * fac[row] - (bb > 0 ? Db[i * 260 + j] : 0.f); }
#pragma unroll
                for (int i = 0; i < 16; ++i) { const int row = 16 * bb + i;
                    float sa[4] = {rh[i], 0.f, 0.f, 0.f};
#pragma unroll
                    for (int jx = 0; jx < i; ++jx) sa[jx & 3] -= __int_as_float(__builtin_amdgcn_readlane(Lr[i], jx)) * x[16 * bb + jx];
                    x[row] = (sa[0] + sa[1]) + (sa[2] + sa[3]); }
                u32x4 w0, w1;
                w0.x = cvt_pk_bf16(x[16 * bb + 0], x[16 * bb + 1]); w0.y = cvt_pk_bf16(x[16 * bb + 2], x[16 * bb + 3]); w0.z = cvt_pk_bf16(x[16 * bb + 4], x[16 * bb + 5]); w0.w = cvt_pk_bf16(x[16 * bb + 6], x[16 * bb + 7]);
                w1.x = cvt_pk_bf16(x[16 * bb + 8], x[16 * bb + 9]); w1.y = cvt_pk_bf16(x[16 * bb + 10], x[16 * bb + 11]); w1.z = cvt_pk_bf16(x[16 * bb + 12], x[16 * bb + 13]); w1.w = cvt_pk_bf16(x[16 * bb + 14], x[16 * bb + 15]);
                *(LAS u32x4*)(XT + j * 72 + 16 * bb) = w0; *(LAS u32x4*)(XT + j * 72 + 16 * bb + 8) = w1;
            }
            LDS_BAR();
        }
#pragma unroll
        for (int it = 0; it < 2; ++it) { const int pc = tid + 512 * it, dv = pc >> 3, cp = pc & 7;
            *(u32x4*)(cols + (row0 + (dv >> 1)) * NC + C_DNV + h * 128 + (dv & 1) * 64 + cp * 8) = *(const LAS u32x4*)(XT + dv * 72 + cp * 8); }
        if (tid >= 128 && tid < 256) {
#pragma unroll
            for (int i = 0; i < 64; ++i) Wl[i * 136 + (jj & ~31) + kperm32(jj & 31)] = (bf16_t)f2bf(x[i]); }
    }
    LDS_BAR();
    {   unsigned char* wo = ws + WS_WA_W + (size_t)unit * 16384;
#pragma unroll
        for (int it = 0; it < 2; ++it) { const int pc = tid + 512 * it; *(u32x4*)(wo + pc * 16) = *(const LAS u32x4*)(Wl + (pc >> 4) * 136 + (pc & 15) * 8); }
    }
    LDS_BAR();
}

__device__ __forceinline__ void delta_scan_unit(const Params& p, int l, int bh, LAS unsigned char* lds) {
    int tid_ = threadIdx.x; asm volatile("" : "+v"(tid_));
    const int tid = tid_, lane = tid & 63, wave = tid >> 6, i = lane & 15, q = lane >> 4;
    const int b = bh >> 2, h = bh & 3;
    unsigned char* ws = p.ws;
    unsigned char* colsb = ws + WS_COLS;
    constexpr int BUFB = 62464, O_W = 0, O_QG = 17408, O_KD = 34816, O_A = 53248;
    LAS bf16_t* Ot = (LAS bf16_t*)(lds + 2 * BUFB);
    if (wave < 4) {
        __builtin_amdgcn_s_setprio(3);
        f32x4 S[2][8];
#pragma unroll
        for (int s2 = 0; s2 < 2; ++s2)
#pragma unroll
            for (int t = 0; t < 8; ++t) S[s2][t] = (f32x4){0.f, 0.f, 0.f, 0.f};
        u32x2 uraw[2][4]; float dl;
        const float dlv = ((const float*)(ws + WS_DL))[(b * 32 + (lane & 31)) * 4 + h];
#define SCAN_ULOAD(cidx, dstu, dstd) do { const int gch_ = b * 32 + (cidx); const size_t r0_ = (size_t)gch_ * 64; \
            _Pragma("unroll") for (int s2 = 0; s2 < 2; ++s2) { const int dv_ = 32 * wave + 16 * s2 + i; \
                const unsigned char* ub_ = colsb + ((r0_ + (dv_ >> 1)) * NC + C_DNV + h * 128 + (dv_ & 1) * 64 + 4 * q) * 2; \
                _Pragma("unroll") for (int mt = 0; mt < 4; ++mt) dstu[s2][mt] = *(const u32x2*)(ub_ + mt * 32); } } while (0)
#define SCAN_LD16(pp) (*(const LAS bf16x8*)(pp))
#define SCAN_FRAG(f) ( (f) < 16 ? SCAN_LD16(buf + O_W + (16 * ((f) >> 2) + i) * 272 + (32 * ((f) & 3) + 8 * q) * 2) \
                     : (f) < 32 ? SCAN_LD16(buf + O_QG + (16 * (((f) - 16) >> 2) + i) * 272 + (32 * (((f) - 16) & 3) + 8 * q) * 2) \
                     : (f) < 38 ? SCAN_LD16(buf + O_A + (16 * ((f) == 32 ? 0 : (f) == 33 ? 1 : (f) <= 35 ? 2 : 3) + i) * 144 + (32 * (((f) == 35 || (f) == 37) ? 1 : 0) + 8 * q) * 2) \
                     : SCAN_LD16(buf + O_KD + (16 * (((f) - 38) >> 1) + i) * 144 + (32 * (((f) - 38) & 1) + 8 * q) * 2) )
        SCAN_ULOAD(0, uraw, dl);
        __syncthreads();
#pragma unroll 1
        for (int c = 0; c < 32; ++c) {
            const LAS unsigned char* buf = lds + (c & 1) * BUFB;
            dl = __int_as_float(__builtin_amdgcn_readlane(__float_as_int(dlv), c));
            bf16x8 Sb[2][4];
#pragma unroll
            for (int s2 = 0; s2 < 2; ++s2)
#pragma unroll
                for (int ks = 0; ks < 4; ++ks) Sb[s2][ks] = pack8(S[s2][2 * ks], S[s2][2 * ks + 1]);
            f32x4 aw[2][4], o[2][4];
            bf16x8 Vb[2][2];
            bf16x8 Fq[8];
            constexpr int DEPTH = 6;
            Fq[0] = SCAN_FRAG(0); Fq[1] = SCAN_FRAG(1); Fq[2] = SCAN_FRAG(2); Fq[3] = SCAN_FRAG(3); Fq[4] = SCAN_FRAG(4); Fq[5] = SCAN_FRAG(5);
#define SCAN_STEP(f) { \
                if ((f) + DEPTH < 54) Fq[((f) + DEPTH) & 7] = SCAN_FRAG(((f) + DEPTH < 54 ? (f) + DEPTH : 53)); \
                const bf16x8 A = Fq[(f) & 7]; \
                if ((f) < 16) { constexpr int mt = ((f) >> 2) & 3, ks = (f) & 3; \
                    if (ks == 0) { aw[0][mt] = (f32x4){0.f, 0.f, 0.f, 0.f}; aw[1][mt] = (f32x4){0.f, 0.f, 0.f, 0.f}; } \
                    aw[0][mt] = MFMA16(A, Sb[0][ks], aw[0][mt]); aw[1][mt] = MFMA16(A, Sb[1][ks], aw[1][mt]); \
                } else if ((f) < 32) { constexpr int mt = (((f) - 16) >> 2) & 3, ks = (f) & 3; \
                    if (ks == 0) { o[0][mt] = (f32x4){0.f, 0.f, 0.f, 0.f}; o[1][mt] = (f32x4){0.f, 0.f, 0.f, 0.f}; } \
                    o[0][mt] = MFMA16(A, Sb[0][ks], o[0][mt]); o[1][mt] = MFMA16(A, Sb[1][ks], o[1][mt]); \
                } else if ((f) < 38) { constexpr int mt = (f) == 32 ? 0 : ((f) == 33 ? 1 : ((f) <= 35 ? 2 : 3)), k2 = ((f) == 35 || (f) == 37) ? 1 : 0; \
                    o[0][mt] = MFMA16(A, Vb[0][k2], o[0][mt]); o[1][mt] = MFMA16(A, Vb[1][k2], o[1][mt]); \
                } else { constexpr int t = (((f) - 38) >> 1) & 7, k2 = (f) & 1; \
                    if (k2 == 0) { S[0][t] = S[0][t] * dl; S[1][t] = S[1][t] * dl; } \
                    S[0][t] = MFMA16(A, Vb[0][k2], S[0][t]); S[1][t] = MFMA16(A, Vb[1][k2], S[1][t]); } \
                if ((f) == 19) { \
                    f32x4 vn[2][4]; \
                    _Pragma("unroll") for (int s2 = 0; s2 < 2; ++s2) \
                    _Pragma("unroll") for (int mt = 0; mt < 4; ++mt) vn[s2][mt] = (f32x4){lo_bf(uraw[s2][mt].x) - aw[s2][mt][0], hi_bf(uraw[s2][mt].x) - aw[s2][mt][1], lo_bf(uraw[s2][mt].y) - aw[s2][mt][2], hi_bf(uraw[s2][mt].y) - aw[s2][mt][3]}; \
                    _Pragma("unroll") for (int s2 = 0; s2 < 2; ++s2) { Vb[s2][0] = pack8(vn[s2][0], vn[s2][1]); Vb[s2][1] = pack8(vn[s2][2], vn[s2][3]); } \
                    if (c + 1 < 32) SCAN_ULOAD(c + 1, uraw, dl); \
                } \
                __builtin_amdgcn_sched_barrier(0); }
#define SCAN_STEP6(f) SCAN_STEP(f) SCAN_STEP((f) + 1) SCAN_STEP((f) + 2) SCAN_STEP((f) + 3) SCAN_STEP((f) + 4) SCAN_STEP((f) + 5)
            SCAN_STEP6(0) SCAN_STEP6(6) SCAN_STEP6(12) SCAN_STEP6(18) SCAN_STEP6(24) SCAN_STEP6(30) SCAN_STEP6(36) SCAN_STEP6(42) SCAN_STEP6(48)
#undef SCAN_STEP6
#undef SCAN_STEP
            __syncthreads();
#pragma unroll
            for (int s2 = 0; s2 < 2; ++s2)
#pragma unroll
                for (int mt = 0; mt < 4; ++mt)
#pragma unroll
                    for (int r = 0; r < 4; ++r) Ot[(16 * mt + 4 * q + r) * 136 + 32 * wave + 16 * s2 + i] = (bf16_t)f2bf(o[s2][mt][r]);
            __syncthreads();
        }
#undef SCAN_FRAG
#undef SCAN_LD16
#undef SCAN_ULOAD
        __builtin_amdgcn_s_setprio(0);
        __syncthreads();
    } else {
        const int t2 = tid - 256, fr_ = t2 >> 2, fs_ = t2 & 3;
        float gn[32];
#pragma unroll
        for (int e = 0; e < 32; ++e) gn[e] = p.dn_norm[l * 128 + fs_ * 32 + e];
        u32x4 pre[14], zc[4], zn[4];
#define SCAN_LOAD(cidx) do { const int gch_ = b * 32 + (cidx); const size_t r0_ = (size_t)gch_ * 64; const int un2_ = gch_ * 4 + h; \
            const unsigned char* wsrc_ = ws + WS_WA_W + (size_t)un2_ * 16384; const unsigned char* asrc_ = ws + WS_WA_A + (size_t)un2_ * 8192; \
            _Pragma("unroll") for (int k = 0; k < 4; ++k) { const int pc_ = t2 + 256 * k; \
                pre[k] = *(const u32x4*)(wsrc_ + pc_ * 16); \
                pre[4 + k] = *(const u32x4*)(colsb + ((r0_ + (pc_ >> 4)) * NC + C_DNQ + h * 128) * 2 + (pc_ & 15) * 16); \
                pre[8 + k] = *(const u32x4*)(colsb + ((r0_ + (pc_ >> 4)) * NC + C_DNK + h * 128) * 2 + (pc_ & 15) * 16); } \
            pre[12] = *(const u32x4*)(asrc_ + t2 * 16); pre[13] = *(const u32x4*)(asrc_ + (t2 + 256) * 16); } while (0)
#define SCAN_ZLOAD(cidx, dst) do { const unsigned char* zb_ = colsb + (((size_t)(b * 32 + (cidx)) * 64 + fr_) * NC + C_DNZ + h * 128 + fs_ * 32) * 2; \
            _Pragma("unroll") for (int k = 0; k < 4; ++k) dst[k] = *(const u32x4*)(zb_ + 16 * k); } while (0)
#define SCAN_STORE(bufp) do { LAS unsigned char* b_ = (bufp); \
            _Pragma("unroll") for (int k = 0; k < 4; ++k) { const int pc_ = t2 + 256 * k; \
                *(LAS u32x4*)(b_ + O_W + (pc_ >> 4) * 272 + (pc_ & 15) * 16) = pre[k]; \
                *(LAS u32x4*)(b_ + O_QG + (pc_ >> 4) * 272 + (pc_ & 15) * 16) = pre[4 + k]; \
                *(LAS u32x4*)(b_ + O_KD + (pc_ >> 3) * 144 + (pc_ & 7) * 16) = pre[8 + k]; } \
            *(LAS u32x4*)(b_ + O_A + (t2 >> 3) * 144 + (t2 & 7) * 16) = pre[12]; *(LAS u32x4*)(b_ + O_A + ((t2 + 256) >> 3) * 144 + (t2 & 7) * 16) = pre[13]; } while (0)
#define SCAN_FINAL(cidx) do { \
            float ss_ = 0.f; u32x4 ov_[4]; \
            _Pragma("unroll") for (int k = 0; k < 4; ++k) { ov_[k] = *(const LAS u32x4*)(Ot + fr_ * 136 + fs_ * 32 + 8 * k); \
                ss_ += lo_bf(ov_[k].x) * lo_bf(ov_[k].x) + hi_bf(ov_[k].x) * hi_bf(ov_[k].x) + lo_bf(ov_[k].y) * lo_bf(ov_[k].y) + hi_bf(ov_[k].y) * hi_bf(ov_[k].y) \
                     + lo_bf(ov_[k].z) * lo_bf(ov_[k].z) + hi_bf(ov_[k].z) * hi_bf(ov_[k].z) + lo_bf(ov_[k].w) * lo_bf(ov_[k].w) + hi_bf(ov_[k].w) * hi_bf(ov_[k].w); } \
            ss_ += __shfl_xor(ss_, 1); ss_ += __shfl_xor(ss_, 2); \
            const float rstd_ = rsqrtf(ss_ * (1.f / 128.f) + EPS); \
            unsigned char* yb_ = colsb + (((size_t)(b * 32 + (cidx)) * 64 + fr_) * NC + C_DNZ + h * 128 + fs_ * 32) * 2; \
            _Pragma("unroll") for (int k = 0; k < 4; ++k) { u32x4 w_; \
                w_.x = cvt_pk_bf16(lo_bf(ov_[k].x) * rstd_ * gn[8 * k + 0] * lo_bf(zc[k].x), hi_bf(ov_[k].x) * rstd_ * gn[8 * k + 1] * hi_bf(zc[k].x)); \
                w_.y = cvt_pk_bf16(lo_bf(ov_[k].y) * rstd_ * gn[8 * k + 2] * lo_bf(zc[k].y), hi_bf(ov_[k].y) * rstd_ * gn[8 * k + 3] * hi_bf(zc[k].y)); \
                w_.z = cvt_pk_bf16(lo_bf(ov_[k].z) * rstd_ * gn[8 * k + 4] * lo_bf(zc[k].z), hi_bf(ov_[k].z) * rstd_ * gn[8 * k + 5] * hi_bf(zc[k].z)); \
                w_.w = cvt_pk_bf16(lo_bf(ov_[k].w) * rstd_ * gn[8 * k + 6] * lo_bf(zc[k].w), hi_bf(ov_[k].w) * rstd_ * gn[8 * k + 7] * hi_bf(zc[k].w)); \
                *(u32x4*)(yb_ + 16 * k) = w_; } } while (0)
        SCAN_LOAD(0); SCAN_STORE(lds);
        __syncthreads();
#pragma unroll 1
        for (int c = 0; c < 32; ++c) {
            if (c + 1 < 32) SCAN_LOAD(c + 1);
            SCAN_ZLOAD(c, zn);
            if (c > 0) SCAN_FINAL(c - 1);
            __syncthreads();
            if (c + 1 < 32) SCAN_STORE(lds + ((c + 1) & 1) * BUFB);
            __syncthreads();
#pragma unroll
            for (int k = 0; k < 4; ++k) zc[k] = zn[k];
        }
        SCAN_FINAL(31);
#undef SCAN_LOAD
#undef SCAN_ZLOAD
#undef SCAN_STORE
#undef SCAN_FINAL
        __syncthreads();
    }
}

__device__ __forceinline__ void gmlp_unit(const Params& p, int l, int unit, LAS unsigned char* lds) {
    int tid_ = threadIdx.x; asm volatile("" : "+v"(tid_));
    const int tid = tid_, lane = tid & 63, wave = tid >> 6, i = lane & 15, q = lane >> 4;
    const int g = unit & 3, bn = unit >> 2;
    const size_t row0 = (size_t)bn * 128;
    unsigned char* ws = p.ws;
    bf16_t* cols = (bf16_t*)(ws + WS_COLS);
    LAS float* rstd = (LAS float*)lds;
    LAS bf16_t* vT = (LAS bf16_t*)(lds + 512);
    {   u32x4 rv[16];
#pragma unroll
        for (int tt = 0; tt < 16; ++tt) rv[tt] = *(const u32x4*)(cols + (row0 + 16 * wave + tt) * NC + C_GMV + lane * 8);
#pragma unroll
        for (int tt = 0; tt < 16; ++tt) { const u32x4 v = rv[tt];
            float ss = lo_bf(v.x) * lo_bf(v.x) + hi_bf(v.x) * hi_bf(v.x) + lo_bf(v.y) * lo_bf(v.y) + hi_bf(v.y) * hi_bf(v.y) + lo_bf(v.z) * lo_bf(v.z) + hi_bf(v.z) * hi_bf(v.z) + lo_bf(v.w) * lo_bf(v.w) + hi_bf(v.w) * hi_bf(v.w);
            ss = wave_sum(ss); if (lane == 0) rstd[16 * wave + tt] = rsqrtf(ss * (1.f / 512.f) + EPS); } }
    LDS_BAR();
#pragma unroll
    for (int it = 0; it < 4; ++it) { const int pc = tid + 512 * it, qrow = pc >> 4, cp = pc & 15;
        const u32x4 v = *(const u32x4*)(cols + (row0 + qrow) * NC + C_GMV + g * 128 + cp * 8);
        const float* gp = p.gm_norm + l * 512 + g * 128 + cp * 8; const float rs = rstd[qrow];
        const float f[8] = {lo_bf(v.x), hi_bf(v.x), lo_bf(v.y), hi_bf(v.y), lo_bf(v.z), hi_bf(v.z), lo_bf(v.w), hi_bf(v.w)};
#pragma unroll
        for (int e = 0; e < 8; ++e) vT[(cp * 8 + e) * 136 + qrow] = (bf16_t)f2bf(f[e] * rs * gp[e]); }
    LDS_BAR();
    {
        const int pt = wave; const int nks = (pt >> 1) + 1;
        const bf16_t* spw = (const bf16_t*)(ws + WS_SPW) + (size_t)g * 16384 + (16 * pt + i) * 128 + 8 * q;
        bf16x8 Bf[4];
#pragma unroll
        for (int ks = 0; ks < 4; ++ks) Bf[ks] = *(const bf16x8*)(spw + 32 * ks);
        const float bias = p.spatial_b[l * 512 + g * 128 + 16 * pt + i];
        const size_t prow = row0 + 16 * pt + i;
        u32x2 uu8[8], zz8[8];
#pragma unroll
        for (int ct = 0; ct < 8; ++ct) { const int ch = g * 128 + 16 * ct + 4 * q; uu8[ct] = *(const u32x2*)(cols + prow * NC + C_GMU + ch); zz8[ct] = *(const u32x2*)(cols + prow * NC + C_GMZ + ch); }
#pragma unroll
        for (int ct = 0; ct < 8; ++ct) { f32x4 acc = {0.f, 0.f, 0.f, 0.f};
#pragma unroll
            for (int ks = 0; ks < 4; ++ks) if (ks < nks) acc = MFMA16(*(const LAS bf16x8*)(vT + (16 * ct + i) * 136 + 32 * ks + 8 * q), Bf[ks], acc);
            const int ch = g * 128 + 16 * ct + 4 * q;
            u32x2* up = (u32x2*)(cols + prow * NC + C_GMU + ch); const u32x2 uu = uu8[ct]; const u32x2 zz = zz8[ct];
            u32x2 w; w.x = cvt_pk_bf16(lo_bf(uu.x) * (acc[0] + bias) * lo_bf(zz.x), hi_bf(uu.x) * (acc[1] + bias) * hi_bf(zz.x));
            w.y = cvt_pk_bf16(lo_bf(uu.y) * (acc[2] + bias) * lo_bf(zz.y), hi_bf(uu.y) * (acc[3] + bias) * hi_bf(zz.y));
            *up = w; }
    }
    LDS_BAR();
}

template <int HD, int NK, bool SWA>
__device__ __forceinline__ void attn_pair16(bf16_t* qpA, bf16_t* qpB, const bf16x8 (&QfA)[HD / 32], const bf16x8 (&QfB)[HD / 32], const u32x2 (&ZfA)[HD / 16], const u32x2 (&ZfB)[HD / 16],
                                            const LAS bf16_t* Kl, const LAS bf16_t* VTl, int kp_lo, int kp_hi, float scale, float m0, float l0, int qi0A, int qi0B, bool blk0, int lane) {
    const int i = lane & 15, q = lane >> 4;
    float m[2] = {m0, m0}, lsum[2] = {l0, l0};
    f32x4 O[2][HD / 16];
#pragma unroll
    for (int t = 0; t < 2; ++t)
#pragma unroll
        for (int dt = 0; dt < HD / 16; ++dt) O[t][dt] = (f32x4){0.f, 0.f, 0.f, 0.f};
    const int qi[2] = {qi0A + i, qi0B + i};
    for (int kp = kp_lo; kp <= kp_hi; ++kp) {
        f32x4 s0[2], s1[2];
#pragma unroll
        for (int t = 0; t < 2; ++t) { s0[t] = (f32x4){0.f, 0.f, 0.f, 0.f}; s1[t] = (f32x4){0.f, 0.f, 0.f, 0.f}; }
#pragma unroll
        for (int kd = 0; kd < HD / 32; ++kd) {
            const bf16x8 k0f = *(const LAS bf16x8*)(Kl + (32 * kp + i) * (HD + 8) + 32 * kd + 8 * q), k1f = *(const LAS bf16x8*)(Kl + (32 * kp + 16 + i) * (HD + 8) + 32 * kd + 8 * q);
            s0[0] = MFMA16(k0f, QfA[kd], s0[0]); s1[0] = MFMA16(k1f, QfA[kd], s1[0]);
            s0[1] = MFMA16(k0f, QfB[kd], s0[1]); s1[1] = MFMA16(k1f, QfB[kd], s1[1]);
        }
        bf16x8 Pb[2]; float alpha[2];
#pragma unroll
        for (int t = 0; t < 2; ++t) {
            float mx = -1e30f;
#pragma unroll
            for (int r = 0; r < 4; ++r) {
                float a = s0[t][r] * scale, b = s1[t][r] * scale;
                if (SWA) { const int k0 = 32 * kp + 4 * q + r, k1 = k0 + 16;
                    if (!(k0 >= qi[t] + 1 && k0 <= qi[t] + 128 && (!blk0 || k0 >= 128))) a = -1e30f;
                    if (!(k1 >= qi[t] + 1 && k1 <= qi[t] + 128 && (!blk0 || k1 >= 128))) b = -1e30f; }
                s0[t][r] = a; s1[t][r] = b; mx = fmaxf(mx, fmaxf(a, b));
            }
            mx = fmaxf(mx, __shfl_xor(mx, 16)); mx = fmaxf(mx, __shfl_xor(mx, 32));
            const float mn = fmaxf(m[t], mx); alpha[t] = __expf(m[t] - mn);
            float ps = 0.f;
#pragma unroll
            for (int r = 0; r < 4; ++r) { s0[t][r] = __expf(s0[t][r] - mn); s1[t][r] = __expf(s1[t][r] - mn); ps += s0[t][r] + s1[t][r]; }
            ps += __shfl_xor(ps, 16); ps += __shfl_xor(ps, 32);
            lsum[t] = lsum[t] * alpha[t] + ps; m[t] = mn;
            Pb[t] = pack8(s0[t], s1[t]);
        }
#pragma unroll
        for (int dt = 0; dt < HD / 16; ++dt) {
            const bf16x8 vf = lds_ld2x8((const LAS unsigned char*)(VTl + (16 * dt + i) * (NK + 8) + 32 * kp + 4 * q));
            O[0][dt] = MFMA16(vf, Pb[0], O[0][dt] * alpha[0]); O[1][dt] = MFMA16(vf, Pb[1], O[1][dt] * alpha[1]); }
    }
#pragma unroll
    for (int t = 0; t < 2; ++t) { const float inv = 1.f / lsum[t]; bf16_t* qp = t == 0 ? qpA : qpB;
#pragma unroll
        for (int dt = 0; dt < HD / 16; ++dt) { const int d = 16 * dt + 4 * q;
            const u32x2 zz = t == 0 ? ZfA[dt] : ZfB[dt];
            u32x2 w; w.x = cvt_pk_bf16(O[t][dt][0] * inv * lo_bf(zz.x), O[t][dt][1] * inv * hi_bf(zz.x)); w.y = cvt_pk_bf16(O[t][dt][2] * inv * lo_bf(zz.y), O[t][dt][3] * inv * hi_bf(zz.y));
            *(u32x2*)(qp + (size_t)i * NC + d) = w; } }
}

__device__ __forceinline__ void swa_unit(const Params& p, int l, int unit, LAS unsigned char* lds) {
    int tid_ = threadIdx.x; asm volatile("" : "+v"(tid_));
    const int tid = tid_, lane = tid & 63, wave = tid >> 6;
    const int kvh = unit & 1, bn = unit >> 1, n = bn & 15, b = bn >> 4;
    unsigned char* ws = p.ws; bf16_t* cols = (bf16_t*)(ws + WS_COLS);
    LAS bf16_t* Kl = (LAS bf16_t*)lds;
    LAS bf16_t* VTl = Kl + 256 * 72;
    const long krow0 = (long)b * T + (long)(n - 1) * 128;
    const int g = wave >> 1, hq = kvh * 4 + g;
    bf16x8 Qf[4][2]; u32x2 Zf[4][4];
#pragma unroll
    for (int qt = 0; qt < 4; ++qt) { const size_t qrow = (size_t)b * T + n * 128 + (wave & 1) * 64 + 16 * qt + (lane & 15);
#pragma unroll
        for (int kd = 0; kd < 2; ++kd) Qf[qt][kd] = *(const bf16x8*)(cols + qrow * NC + C_SWQ + hq * 64 + 32 * kd + 8 * (lane >> 4));
#pragma unroll
        for (int dt = 0; dt < 4; ++dt) Zf[qt][dt] = *(const u32x2*)(cols + qrow * NC + C_SWZ + hq * 64 + 16 * dt + 4 * (lane >> 4)); }
#pragma unroll
    for (int it = 0; it < 4; ++it) { const int pc = tid + 512 * it, kj = pc >> 3, cp = pc & 7;
        u32x4 kv = {0u, 0u, 0u, 0u}, vv = {0u, 0u, 0u, 0u};
        if (n > 0 || kj >= 128) { const bf16_t* rp = cols + (size_t)(krow0 + kj) * NC; kv = *(const u32x4*)(rp + C_SWK + kvh * 64 + cp * 8); vv = *(const u32x4*)(rp + C_SWV + kvh * 64 + cp * 8); }
        *(LAS u32x4*)(Kl + kj * 72 + cp * 8) = kv;
        const unsigned vw[4] = {vv.x, vv.y, vv.z, vv.w};
#pragma unroll
        for (int e = 0; e < 4; ++e) { VTl[(cp * 8 + 2 * e) * 264 + kj] = (bf16_t)(vw[e] & 0xffffu); VTl[(cp * 8 + 2 * e + 1) * 264 + kj] = (bf16_t)(vw[e] >> 16); } }
    LDS_BAR();
    {
        const float sink = p.sinks[l * 8 + hq];
#pragma unroll
        for (int qp2 = 0; qp2 < 2; ++qp2) {
            const int qi0 = (wave & 1) * 64 + 32 * qp2;
            const size_t qrow = (size_t)b * T + n * 128 + qi0;
            int kp_lo = (qi0 + 1) >> 5, kp_hi = (qi0 + 16 + 143) >> 5; if (kp_hi > 7) kp_hi = 7; if (n == 0 && kp_lo < 4) kp_lo = 4;
            attn_pair16<64, 256, true>(cols + qrow * NC + C_SWQ + hq * 64, cols + (qrow + 16) * NC + C_SWQ + hq * 64, Qf[2 * qp2], Qf[2 * qp2 + 1], Zf[2 * qp2], Zf[2 * qp2 + 1], Kl, VTl, kp_lo, kp_hi, 0.125f, sink, 1.f, qi0, qi0 + 16, n == 0, lane);
        }
    }
    LDS_BAR();
}

__device__ __forceinline__ void xmem_unit(const Params& p, int l, int unit, LAS unsigned char* lds) {
    int tid_ = threadIdx.x; asm volatile("" : "+v"(tid_));
    const int tid = tid_, lane = tid & 63, wave = tid >> 6;
    const int qb = unit & 7, hm = (unit >> 3) & 3, b = unit >> 5;
    unsigned char* ws = p.ws; bf16_t* cols = (bf16_t*)(ws + WS_COLS);
    const bf16_t* mkv = (const bf16_t*)(ws + WS_MEMKV) + (size_t)b * 256 * 1024;
    LAS bf16_t* Kl = (LAS bf16_t*)lds;
    LAS bf16_t* VTl = Kl + 256 * 136;
    bf16x8 Qf[2][4]; u32x2 Zf[2][8];
#pragma unroll
    for (int qt = 0; qt < 2; ++qt) { const size_t qrow = (size_t)b * T + qb * 256 + 32 * wave + 16 * qt + (lane & 15);
#pragma unroll
        for (int kd = 0; kd < 4; ++kd) Qf[qt][kd] = *(const bf16x8*)(cols + qrow * NC + C_XMQ + hm * 128 + 32 * kd + 8 * (lane >> 4));
#pragma unroll
        for (int dt = 0; dt < 8; ++dt) Zf[qt][dt] = *(const u32x2*)(cols + qrow * NC + C_XMZ + hm * 128 + 16 * dt + 4 * (lane >> 4)); }
#pragma unroll
    for (int it = 0; it < 8; ++it) { const int pc = tid + 512 * it, kj = pc >> 4, cp = pc & 15;
        const bf16_t* rp = mkv + (size_t)kj * 1024 + hm * 128 + cp * 8;
        const u32x4 kv = *(const u32x4*)rp, vv = *(const u32x4*)(rp + 512);
        *(LAS u32x4*)(Kl + kj * 136 + cp * 8) = kv;
        const unsigned vw[4] = {vv.x, vv.y, vv.z, vv.w};
#pragma unroll
        for (int e = 0; e < 4; ++e) { VTl[(cp * 8 + 2 * e) * 264 + kj] = (bf16_t)(vw[e] & 0xffffu); VTl[(cp * 8 + 2 * e + 1) * 264 + kj] = (bf16_t)(vw[e] >> 16); } }
    LDS_BAR();
    { const size_t qrow = (size_t)b * T + qb * 256 + 32 * wave;
      attn_pair16<128, 256, false>(cols + qrow * NC + C_XMQ + hm * 128, cols + (qrow + 16) * NC + C_XMQ + hm * 128, Qf[0], Qf[1], Zf[0], Zf[1], Kl, VTl, 0, 7, 0.08838834764831845f, -1e30f, 0.f, 0, 0, false, lane); }
    LDS_BAR();
}

#define XB_TMO      128
#define XB_XCNT(j)  (256  + 64 * (j))
#define XB_XSUB(j)  (1280 + 64 * (j))
#define XB_XGEN(j)  (2304 + 64 * (j))
#define XB_TOP      3328
#define XB_TOPGEN   3392
#define XCD_BAR_WORDS 3456
#define XB_SPIN_CAP (1u << 18)

__device__ __forceinline__ unsigned xb_ld(unsigned* p)              { return __hip_atomic_load(p, __ATOMIC_RELAXED, __HIP_MEMORY_SCOPE_AGENT); }
__device__ __forceinline__ unsigned xb_add(unsigned* p, unsigned v) { return __hip_atomic_fetch_add(p, v, __ATOMIC_RELAXED, __HIP_MEMORY_SCOPE_AGENT); }
__device__ __forceinline__ unsigned xb_xcc_id() { return (unsigned)__builtin_amdgcn_s_getreg((3 << 11) | 20) & 0xFu; }
#define XB_SPIN(cond, bar) do { unsigned _sp = 0; while (cond) { __builtin_amdgcn_s_sleep(1); \
    if ((++_sp & 255u) == 0u) { if (xb_ld(&(bar)[XB_TMO])) break; if (_sp > XB_SPIN_CAP) { atomicAdd(&(bar)[XB_TMO], 1u); break; } } } } while (0)

struct XcdBarrier {
    unsigned* bar; unsigned x;
    volatile LAS unsigned* st;
};

__device__ __forceinline__ XcdBarrier xcd_barrier_post(unsigned* bar, volatile LAS unsigned* st) {
    XcdBarrier b; b.bar = bar; b.x = xb_xcc_id(); b.st = st;
    if (threadIdx.x == 0) (void)xb_add(&bar[XB_XCNT(b.x)], 1u);
    return b;
}
__device__ __forceinline__ void xcd_barrier_complete(unsigned* bar, unsigned x, unsigned& nloc, unsigned& nx) {
    const unsigned G = gridDim.x * gridDim.y * gridDim.z;
    unsigned sum, cnt, mine, sp = 0u;
    for (;;) {
        sum = 0u; cnt = 0u; mine = 0u;
#pragma unroll
        for (unsigned j = 0; j < 16; ++j) { const unsigned c = xb_ld(&bar[XB_XCNT(j)]); sum += c; cnt += (c > 0u) ? 1u : 0u; mine = (j == x) ? c : mine; }
        if (sum == G) break;
        __builtin_amdgcn_s_sleep(1);
        if ((++sp & 255u) == 0u) { if (xb_ld(&bar[XB_TMO])) break; if (sp > XB_SPIN_CAP) { atomicAdd(&bar[XB_TMO], 1u); break; } }
    }
    nloc = mine > 0u ? mine : 1u; nx = cnt > 0u ? cnt : 1u;
}

__device__ __forceinline__ void xcd_barrier(const XcdBarrier& b) {
    asm volatile("s_waitcnt vmcnt(0)" ::: "memory");
    __syncthreads();
    if (threadIdx.x == 0) {
        unsigned* bar = b.bar;
        __builtin_amdgcn_s_waitcnt(0);
        unsigned nloc = b.st[0], nx = b.st[1];
        if (nloc == 0u) { xcd_barrier_complete(bar, b.x, nloc, nx); b.st[0] = nloc; b.st[1] = nx; }
        const unsigned old = xb_add(&bar[XB_XSUB(b.x)], 1u);
        const unsigned gen = old / nloc;
        if (old + 1u == (gen + 1u) * nloc) {
            __builtin_amdgcn_fence(__ATOMIC_RELEASE, "agent");
            asm volatile("s_waitcnt vmcnt(0)" ::: "memory");
            const unsigned og = xb_add(&bar[XB_TOP], 1u);
            const unsigned tg = og / nx;
            if (og + 1u == (tg + 1u) * nx) xb_add(&bar[XB_TOPGEN], 1u);
            else XB_SPIN(xb_ld(&bar[XB_TOPGEN]) == tg, bar);
            __builtin_amdgcn_fence(__ATOMIC_ACQUIRE, "agent");
            xb_add(&bar[XB_XGEN(b.x)], 1u);
            asm volatile("s_waitcnt vmcnt(0)" ::: "memory");
        } else {
            XB_SPIN(xb_ld(&bar[XB_XGEN(b.x)]) == gen, bar);
            __builtin_amdgcn_fence(__ATOMIC_ACQUIRE, "agent");
            asm volatile("s_waitcnt vmcnt(0)" ::: "memory");
        }
    }
    __syncthreads();
}


__global__ void __launch_bounds__(512) mega_fwd(Params p) {
    extern __shared__ __attribute__((aligned(16))) unsigned char lds_raw[];
    LAS unsigned char* lds = (LAS unsigned char*)lds_raw;
    const int G = gridDim.x, bx = blockIdx.x;
    const int vcu = (G % 8 == 0) ? (bx % 8) * (G / 8) + bx / 8 : bx;
    const Epi E{p.ws};
    unsigned* barw = (unsigned*)p.ws + 4096;
    volatile LAS unsigned* bst = (volatile LAS unsigned*)(lds + LDS_BYTES - 16);
    if (threadIdx.x == 0) { bst[0] = 0u; bst[1] = 0u; }
    __syncthreads();
    XcdBarrier bar = xcd_barrier_post(barw, bst);
#ifdef TSTAMP
    int nst = 0;
#define STAMP() do { if (bx == 0 && threadIdx.x == 0) ((unsigned long long*)p.ws)[nst] = __builtin_amdgcn_s_memrealtime(); ++nst; } while (0)
#else
#define STAMP() do {} while (0)
#endif
#define GRID_BAR() do { xcd_barrier(bar); STAMP(); } while (0)
    STAMP();
#pragma unroll 1
    for (int l = 0; l < 2; ++l) {
        p0_stage(p, l, lds);
        GRID_BAR();
#ifndef PROBE_REP
#define PROBE_REP 0
#endif
        for (int rep = 0; rep < ((PROBE_REP == 1 || PROBE_REP == 2) ? 2 : 1); ++rep) {
        { SchedA S{p.ws, G, bx}; pg8::gemm_phase<Epi, SchedA>(lds, S, E); }
        GRID_BAR();
        if (PROBE_REP == 1 && rep == 0) continue;
        for (int u = bx; u < 1024; u += G) delta_pre_unit(p, l, u, lds);
        GRID_BAR();
        if (G >= 64) {
            if (bx < 32) delta_scan_unit(p, l, bx, lds);
            else for (int u = bx - 32; u < 1024; u += G - 32) { if (u < 256) swa_unit(p, l, u, lds); else if (u < 512) xmem_unit(p, l, u - 256, lds); else gmlp_unit(p, l, u - 512, lds); }
        } else {
            for (int u = bx; u < 32 + 1024; u += G) { if (u < 32) delta_scan_unit(p, l, u, lds); else if (u < 288) swa_unit(p, l, u - 32, lds); else if (u < 544) xmem_unit(p, l, u - 288, lds); else gmlp_unit(p, l, u - 544, lds); }
        }
        GRID_BAR();
        }
        for (int rep = 0; rep < ((PROBE_REP == 3 || PROBE_REP == 4) ? 2 : 1); ++rep) {
        { SchedD S{p.ws, G, vcu}; pg8::gemm_phase<Epi, SchedD>(lds, S, E); }
        GRID_BAR();
        if (PROBE_REP == 3 && rep == 0) continue;
        { SchedE S{p.ws, G, vcu}; pg8::gemm_phase<Epi, SchedE>(lds, S, E); }
        GRID_BAR();
        }
    }
    p0_stage(p, 2, lds);
#ifdef TSTAMP
    __syncthreads();
    if (bx == 0 && threadIdx.x == 0) { const unsigned long long* st = (const unsigned long long*)p.ws; const float us = (float)(st[TS_B] - st[TS_A]) * 0.01f; p.out[0] += us * TS_SCALE; }
#endif
}

extern "C" void kernel_launch(void* const* d_in, const int* in_sizes, int n_in, void* d_out, int out_size, void* d_ws, size_t ws_size, hipStream_t stream) {
    static int grid = 0;
    if (grid == 0) {
        if (n_in != 17 || out_size != M * D || ws_size < WS_END) { fprintf(stderr, "kernel_launch: unexpected shapes / workspace (%d inputs, out %d, ws %zu)\n", n_in, out_size, ws_size); grid = -1; return; }
        int dev = 0, cus = 0, per_cu = 0;
        hipGetDevice(&dev);
        hipDeviceGetAttribute(&cus, hipDeviceAttributeMultiprocessorCount, dev);
        hipFuncSetAttribute((const void*)mega_fwd, hipFuncAttributeMaxDynamicSharedMemorySize, LDS_BYTES);
        hipOccupancyMaxActiveBlocksPerMultiprocessor(&per_cu, (const void*)mega_fwd, 512, LDS_BYTES);
        if (per_cu < 1) { fprintf(stderr, "kernel_launch: occupancy query reports %d blocks per CU\n", per_cu); (void)hipGetLastError(); per_cu = 1; }
        grid = cus * 1;
    }
    if (grid < 0) return;
    Params p{};
    p.x = (const float*)d_in[0]; p.mem = (const float*)d_in[1]; p.norm_pre = (const float*)d_in[2]; p.norm_post = (const float*)d_in[3]; p.norm_mem = (const float*)d_in[4];
    p.w_in = (const float*)d_in[5]; p.conv_w = (const float*)d_in[6]; p.a_log = (const float*)d_in[7]; p.dt_bias = (const float*)d_in[8]; p.dn_norm = (const float*)d_in[9];
    p.gm_norm = (const float*)d_in[10]; p.spatial_w = (const float*)d_in[11]; p.spatial_b = (const float*)d_in[12]; p.sinks = (const float*)d_in[13];
    p.w_mem_kv = (const float*)d_in[14]; p.w_up = (const float*)d_in[15]; p.w_out = (const float*)d_in[16];
    p.out = (float*)d_out; p.ws = (unsigned char*)d_ws;
    if (hipMemsetAsync((char*)d_ws + 16384, 0, XCD_BAR_WORDS * 4, stream) != hipSuccess) { fprintf(stderr, "kernel_launch: memset of the barrier words failed\n"); return; }
    void* args[] = {&p};
    hipError_t e = hipLaunchCooperativeKernel((const void*)mega_fwd, dim3(grid), dim3(512), args, LDS_BYTES, stream);
    if (e != hipSuccess) fprintf(stderr, "cooperative launch failed: %s (grid %d)\n", hipGetErrorString(e), grid);
}
```

```cpp
#include <hip/hip_runtime.h>
#include <hip/hip_cooperative_groups.h>
#include <cstdio>
#include <cstdint>
namespace cg = cooperative_groups;

#define LAS __attribute__((address_space(3)))
typedef unsigned short bf16_t;
typedef short bf16x8 __attribute__((ext_vector_type(8)));
typedef float f32x4 __attribute__((ext_vector_type(4)));
typedef unsigned u32x4 __attribute__((ext_vector_type(4)));
typedef unsigned u32x2 __attribute__((ext_vector_type(2)));

constexpr int NB = 8, T = 2048, M = NB * T, D = 1024, NC = 5888, DIN = 9992;
constexpr int C_DNQ = 0, C_DNK = 512, C_DNV = 1024, C_DNZ = 1536, C_GMU = 2048, C_GMV = 2560, C_GMZ = 3072, C_SWQ = 3584, C_SWK = 4096, C_SWV = 4224,
              C_SWZ = 4352, C_XMQ = 4864, C_XMZ = 5376;
constexpr float EPS = 1e-6f;
constexpr size_t MiB = 1u << 20;
constexpr size_t WS_WINT = 1 * MiB, WS_WGT = WS_WINT + 12058624, WS_WUPT = WS_WGT + 8 * MiB, WS_WOUTT = WS_WUPT + 4 * MiB, WS_WMKVT = WS_WOUTT + 2 * MiB,
                 WS_SPW = WS_WMKVT + 2 * MiB;
constexpr size_t WS_H = 29 * MiB, WS_COLS = 61 * MiB, WS_OUT = WS_COLS, WS_X = 245 * MiB;
constexpr size_t WS_WA_W = WS_X, WS_WA_A = WS_X + 16 * MiB, WS_HALO = WS_X + 24 * MiB, WS_SM = WS_X + 27 * MiB, WS_DL = WS_SM + 512 * 1024,
                 WS_MEMN = WS_X + 28 * MiB, WS_MEMKV = WS_X + 32 * MiB, WS_GSCR = WS_X, WS_MERGED = WS_X + 32 * MiB, WS_END = 309 * MiB;
constexpr int LDS_BYTES = 155648;

struct Params {
    const float *x, *mem, *norm_pre, *norm_post, *norm_mem, *w_in, *conv_w, *a_log, *dt_bias, *dn_norm, *gm_norm, *spatial_w, *spatial_b, *sinks, *w_mem_kv,
        *w_up, *w_out;
    float* out;
    unsigned char* ws;
};

__device__ __forceinline__ unsigned f2bf(float f) { unsigned u = __float_as_uint(f); return (u + 0x7fffu + ((u >> 16) & 1u)) >> 16; }
__device__ __forceinline__ float bf2f(unsigned b) { return __uint_as_float(b << 16); }
typedef float f32x2_t __attribute__((ext_vector_type(2)));
typedef __bf16 bf16x2_t __attribute__((ext_vector_type(2)));
__device__ __forceinline__ unsigned cvt_pk_bf16(float lo, float hi) { const f32x2_t v = {lo, hi}; return __builtin_bit_cast(unsigned, __builtin_convertvector(v, bf16x2_t)); }
__device__ __forceinline__ float lo_bf(unsigned w) { return __uint_as_float(w << 16); }
__device__ __forceinline__ float hi_bf(unsigned w) { return __uint_as_float(w & 0xffff0000u); }
__device__ __forceinline__ float wave_sum(float v) {
#pragma unroll
    for (int o = 1; o < 64; o <<= 1) v += __shfl_xor(v, o);
    return v;
}
__device__ __forceinline__ float silu_f(float y) { return y * __builtin_amdgcn_rcpf(1.f + __expf(-y)); }
__device__ __forceinline__ float sigmoid_f(float y) { return __builtin_amdgcn_rcpf(1.f + __expf(-y)); }
__device__ __forceinline__ float gelu_tanh_f(float x) {
    const float u = 0.7978845608f * (x + 0.044715f * x * x * x);
    return x * __builtin_amdgcn_rcpf(1.f + __expf(-2.f * u));
}
__device__ __forceinline__ float silu_fast(float y) { return y * __builtin_amdgcn_rcpf(1.f + __expf(-y)); }
__device__ __forceinline__ float sigmoid_fast(float y) { return __builtin_amdgcn_rcpf(1.f + __expf(-y)); }
__device__ __forceinline__ float gelu_fast(float x) { const float u = 0.7978845608f * (x + 0.044715f * x * x * x); return x * __builtin_amdgcn_rcpf(1.f + __expf(-2.f * u)); }
__device__ __forceinline__ bf16x8 pack8(const f32x4 a, const f32x4 b) {
    u32x4 w; w.x = cvt_pk_bf16(a[0], a[1]); w.y = cvt_pk_bf16(a[2], a[3]); w.z = cvt_pk_bf16(b[0], b[1]); w.w = cvt_pk_bf16(b[2], b[3]);
    return __builtin_bit_cast(bf16x8, w);
}
__device__ __forceinline__ bf16x8 lds_ld2x8(const LAS unsigned char* pl) {
    const u32x2 lo = *(const LAS u32x2*)pl, hi = *(const LAS u32x2*)(pl + 32);
    u32x4 w; w.x = lo.x; w.y = lo.y; w.z = hi.x; w.w = hi.y; return __builtin_bit_cast(bf16x8, w);
}
#define LDS_BAR() asm volatile("s_waitcnt lgkmcnt(0)\n\ts_barrier" ::: "memory")
__device__ __forceinline__ int kperm32(int o) { return (o < 16) ? (8 * (o >> 2) + (o & 3)) : (8 * ((o - 16) >> 2) + 4 + (o & 3)); }
#define MFMA16(a, b, c) __builtin_amdgcn_mfma_f32_16x16x32_bf16((a), (b), (c), 0, 0, 0)

namespace pg8 {
constexpr int BM = 256, BK = 64, HALF = 128, HTB = HALF * BK * 2, STAGE_BYTES = 8 * HTB;
__device__ __forceinline__ int lds_byte(int r, int c) { const int st = (r >> 4) * 2 + (c >> 5), rr = r & 15, cc = c & 31, ob = rr * 64 + cc * 2; return st * 1024 + (ob ^ (((ob >> 9) & 1) << 5)); }
__device__ __forceinline__ void stage_rc(int b, int& R, int& C) { const int st = b / 1024, sb = b % 1024, swz = sb ^ (((sb >> 9) & 1) << 5); R = (st >> 1) * 16 + swz / 64; C = (st & 1) * 32 + (swz % 64) / 2; }
__device__ __forceinline__ int perm32(int rho) { const int n = rho >> 4, i = rho & 15; return 8 * (i >> 2) + 4 * n + (i & 3); }

struct Unit { const char* a; const char* b; unsigned lda, ldb; int nt; int pm, pn, kind, sub; };

__device__ __forceinline__ void mkoff(const Unit& u, int tid, unsigned (&vA)[2], unsigned (&vB)[2]) {
#pragma unroll
    for (int i = 0; i < 2; ++i) { int R, C; stage_rc(tid * 16 + i * 8192, R, C); const int Rb = (R & ~31) + perm32(R & 31);
        vA[i] = (unsigned)(R * u.lda + C) * 2u; vB[i] = (unsigned)(Rb * u.ldb + C) * 2u; }
}

template <class Epi, class Sched>
__device__ __forceinline__ void gemm_phase(LAS unsigned char* lds, const Sched& S, const Epi& E) {
    int tid_ = threadIdx.x; asm volatile("" : "+v"(tid_));
    const int tid = tid_, wid = __builtin_amdgcn_readfirstlane(tid >> 6), lane = tid & 63, wr = wid >> 2, wc = wid & 3, fr = lane & 15, fq = lane >> 4;
    const size_t kstep = (size_t)(BK * 2);
    const unsigned ldsw = (unsigned)wid * 1024u;
    const int aoff = lds_byte(wr * 64 + fr, fq * 8), boff = lds_byte(wc * 32 + fr, fq * 8);
#define PG8_SA(b, h) (((b) * 2 + (h)) * HTB)
#define PG8_SB(b, h) ((4 + (b) * 2 + (h)) * HTB)
#define PG8_STAGE(bufoff, gbase, voff) do { _Pragma("unroll") for (int _i = 0; _i < 2; ++_i) \
        __builtin_amdgcn_global_load_lds((const unsigned*)((const char*)(gbase) + (voff)[_i]), (LAS unsigned*)(lds + (bufoff) + ldsw + _i * 8192), 16, 0, 0); } while (0)
#define PG8_LDA(dst, b, h) do { _Pragma("unroll") for (int m = 0; m < 4; ++m) _Pragma("unroll") for (int k = 0; k < 2; ++k) dst[m][k] = *(const LAS bf16x8*)(lds + PG8_SA(b, h) + aoff + m * 2048 + k * 1024); } while (0)
#define PG8_LDB(dst, b, h) do { _Pragma("unroll") for (int n = 0; n < 2; ++n) _Pragma("unroll") for (int k = 0; k < 2; ++k) dst[n][k] = *(const LAS bf16x8*)(lds + PG8_SB(b, h) + boff + n * 2048 + k * 1024); } while (0)
#define PG8_MMA(ai, bj, At, Bt) do { __builtin_amdgcn_s_setprio(1); _Pragma("unroll") for (int m = 0; m < 4; ++m) _Pragma("unroll") for (int n = 0; n < 2; ++n) _Pragma("unroll") for (int k = 0; k < 2; ++k) \
        acc[ai][bj][m][n] = __builtin_amdgcn_mfma_f32_16x16x32_bf16(Bt[n][k], At[m][k], acc[ai][bj][m][n], 0, 0, 0); __builtin_amdgcn_s_setprio(0); } while (0)
#define PG8_WAIT_V(n) asm volatile("s_waitcnt vmcnt(" #n ")" ::: "memory")
#define PG8_WAIT_L(n) asm volatile("s_waitcnt lgkmcnt(" #n ")" ::: "memory")
#define PG8_BAR __builtin_amdgcn_s_barrier()
#define PG8_SCHED __builtin_amdgcn_sched_barrier(0)
    Unit cur, nxt; int ui = 0;
    if (!S.next(0, cur)) return;
    f32x4 acc[2][2][4][2];
#pragma unroll
    for (int a = 0; a < 2; ++a)
#pragma unroll
        for (int b = 0; b < 2; ++b)
#pragma unroll
            for (int m = 0; m < 4; ++m)
#pragma unroll
                for (int n = 0; n < 2; ++n) acc[a][b][m][n] = (f32x4){0.f, 0.f, 0.f, 0.f};
    bf16x8 At[4][2], B0[2][2], B1[2][2];
    unsigned vAc[2], vBc[2], vAn[2], vBn[2];
    mkoff(cur, tid, vAc, vBc);
    const char* cA = cur.a; const char* cB = cur.b;
    size_t hAc = (size_t)HALF * cur.lda * 2, hBc = (size_t)HALF * cur.ldb * 2;
    PG8_STAGE(PG8_SB(0, 0), cB, vBc); PG8_STAGE(PG8_SB(0, 1), cB + hBc, vBc); PG8_STAGE(PG8_SA(0, 0), cA, vAc); PG8_STAGE(PG8_SA(0, 1), cA + hAc, vAc);
    if (wr == 1) PG8_BAR;
    PG8_WAIT_V(2); PG8_BAR;
    PG8_STAGE(PG8_SB(1, 0), cB + kstep, vBc); PG8_STAGE(PG8_SA(1, 0), cA + kstep, vAc); PG8_STAGE(PG8_SB(1, 1), cB + hBc + kstep, vBc);
    PG8_WAIT_V(6); PG8_BAR;
    for (;;) {
        const bool has_next = S.next(ui + 1, nxt);
        const char* nA = cA; const char* nB = cB; size_t hAn = hAc, hBn = hBc;
        vAn[0] = vAc[0]; vAn[1] = vAc[1]; vBn[0] = vBc[0]; vBn[1] = vBc[1];
        if (has_next) { nA = nxt.a; nB = nxt.b; mkoff(nxt, tid, vAn, vBn); hAn = (size_t)HALF * nxt.lda * 2; hBn = (size_t)HALF * nxt.ldb * 2; }
        const int nt = cur.nt;
        for (int t = 0; t < nt; t += 2) {
            const bool last = (t == nt - 2);
            const char* a1 = cA + (size_t)(t + 1) * kstep;
            const char* a2 = last ? nA : cA + (size_t)(t + 2) * kstep; const char* b2 = last ? nB : cB + (size_t)(t + 2) * kstep;
            const char* a3 = a2 + kstep; const char* b3 = b2 + kstep;
            unsigned vA2[2], vB2[2];
            vA2[0] = last ? vAn[0] : vAc[0]; vA2[1] = last ? vAn[1] : vAc[1]; vB2[0] = last ? vBn[0] : vBc[0]; vB2[1] = last ? vBn[1] : vBc[1];
            const size_t hA2 = last ? hAn : hAc, hB2 = last ? hBn : hBc;
            PG8_LDB(B0, 0, 0); PG8_LDB(B1, 0, 1); PG8_SCHED; PG8_LDA(At, 0, 0); PG8_STAGE(PG8_SA(1, 1), a1 + hAc, vAc);
            PG8_WAIT_V(8); PG8_WAIT_L(0); PG8_BAR; PG8_MMA(0, 0, At, B0); PG8_MMA(0, 1, At, B1); PG8_BAR; PG8_SCHED;
            PG8_LDA(At, 0, 1); PG8_STAGE(PG8_SB(0, 0), b2, vB2); PG8_STAGE(PG8_SB(0, 1), b2 + hB2, vB2); PG8_STAGE(PG8_SA(0, 0), a2, vA2);
            PG8_WAIT_V(8); PG8_WAIT_L(0); PG8_BAR; PG8_MMA(1, 0, At, B0); PG8_MMA(1, 1, At, B1); PG8_BAR; PG8_SCHED;
            PG8_LDB(B0, 1, 0); PG8_LDB(B1, 1, 1); PG8_SCHED; PG8_LDA(At, 1, 0); PG8_STAGE(PG8_SA(0, 1), a2 + hA2, vA2);
            PG8_WAIT_V(8); PG8_WAIT_L(0); PG8_BAR; PG8_MMA(0, 0, At, B0); PG8_MMA(0, 1, At, B1); PG8_BAR; PG8_SCHED;
            PG8_LDA(At, 1, 1); PG8_STAGE(PG8_SB(1, 0), b3, vB2); PG8_STAGE(PG8_SB(1, 1), b3 + hB2, vB2); PG8_STAGE(PG8_SA(1, 0), a3, vA2);
            PG8_WAIT_V(8); PG8_WAIT_L(0); PG8_BAR; PG8_MMA(1, 0, At, B0); PG8_MMA(1, 1, At, B1); PG8_BAR; PG8_SCHED;
        }
        if (wr == 0) PG8_BAR;
        E(acc, cur, wr, wc, fr, fq, tid);
        if (!has_next) break;
#pragma unroll
        for (int a = 0; a < 2; ++a)
#pragma unroll
            for (int b = 0; b < 2; ++b)
#pragma unroll
                for (int m = 0; m < 4; ++m)
#pragma unroll
                    for (int n = 0; n < 2; ++n) acc[a][b][m][n] = (f32x4){0.f, 0.f, 0.f, 0.f};
        cur = nxt; cA = nA; cB = nB; hAc = hAn; hBc = hBn; vAc[0] = vAn[0]; vAc[1] = vAn[1]; vBc[0] = vBn[0]; vBc[1] = vBn[1]; ++ui;
        if (wr == 1) PG8_BAR;
    }
    PG8_WAIT_V(0);
    PG8_BAR;
#undef PG8_SA
#undef PG8_SB
#undef PG8_STAGE
#undef PG8_LDA
#undef PG8_LDB
#undef PG8_MMA
#undef PG8_WAIT_V
#undef PG8_WAIT_L
#undef PG8_BAR
#undef PG8_SCHED
}
}
using pg8::Unit;

struct Epi {
    unsigned char* ws;
    __device__ __forceinline__ void operator()(const f32x4 (&acc)[2][2][4][2], const Unit& u, int wr, int wc, int fr, int fq, int tid) const {
        asm volatile("" : "+v"(tid), "+v"(fr), "+v"(fq));
        const int row0 = u.pm * 256 + wr * 64 + fr, col0 = u.pn * 256 + wc * 32 + 8 * fq;
        if (u.kind == 0) {
            bf16_t* cols = (bf16_t*)(ws + WS_COLS); bf16_t* halo = (bf16_t*)(ws + WS_HALO);
            const int pn = u.pn;
            const int act = (pn == 6 || pn == 7 || pn == 12 || pn == 13 || pn == 17 || pn == 18 || pn >= 21) ? 1 : ((pn >= 8 && pn <= 11) ? 2 : 0);
#pragma unroll
            for (int ai = 0; ai < 2; ++ai)
#pragma unroll
                for (int m = 0; m < 4; ++m) {
                    const int r = row0 + ai * 128 + m * 16;
                    bf16_t* rowp = cols + (size_t)r * NC + col0;
#pragma unroll
                    for (int bj = 0; bj < 2; ++bj) {
                        f32x4 v0 = acc[ai][bj][m][0], v1 = acc[ai][bj][m][1];
                        if (act == 1) {
#pragma unroll
                            for (int e = 0; e < 4; ++e) { v0[e] = silu_fast(v0[e]); v1[e] = silu_fast(v1[e]); }
                        } else if (act == 2) {
#pragma unroll
                            for (int e = 0; e < 4; ++e) { v0[e] = gelu_fast(v0[e]); v1[e] = gelu_fast(v1[e]); }
                        }
                        u32x4 w; w.x = cvt_pk_bf16(v0[0], v0[1]); w.y = cvt_pk_bf16(v0[2], v0[3]); w.z = cvt_pk_bf16(v1[0], v1[1]); w.w = cvt_pk_bf16(v1[2], v1[3]);
                        *(u32x4*)(rowp + bj * 128) = w;
                        if (pn < 6 && (r & 63) >= 61) *(u32x4*)(halo + ((size_t)(r >> 6) * 3 + ((r & 63) - 61)) * 1536 + col0 + bj * 128) = w;
                    }
                }
        } else if (u.kind == 1) {
            bf16_t* o = (bf16_t*)(ws + WS_MEMKV);
#pragma unroll
            for (int ai = 0; ai < 2; ++ai)
#pragma unroll
                for (int m = 0; m < 4; ++m) {
                    bf16_t* rowp = o + (size_t)(row0 + ai * 128 + m * 16) * 1024 + col0;
#pragma unroll
                    for (int bj = 0; bj < 2; ++bj) {
                        const f32x4 v0 = acc[ai][bj][m][0], v1 = acc[ai][bj][m][1];
                        u32x4 w; w.x = cvt_pk_bf16(v0[0], v0[1]); w.y = cvt_pk_bf16(v0[2], v0[3]); w.z = cvt_pk_bf16(v1[0], v1[1]); w.w = cvt_pk_bf16(v1[2], v1[3]);
                        *(u32x4*)(rowp + bj * 128) = w;
                    }
                }
        } else if (u.kind == 2) {
            u32x4* g = (u32x4*)(ws + WS_GSCR) + (size_t)(u.pm * 4 + u.pn) * 16 * 512 + tid;
#pragma unroll
            for (int ai = 0; ai < 2; ++ai)
#pragma unroll
                for (int m = 0; m < 4; ++m)
#pragma unroll
                    for (int bj = 0; bj < 2; ++bj) {
                        const f32x4 v0 = acc[ai][bj][m][0], v1 = acc[ai][bj][m][1];
                        u32x4 w; w.x = cvt_pk_bf16(v0[0], v0[1]); w.y = cvt_pk_bf16(v0[2], v0[3]);
                        w.z = cvt_pk_bf16(v1[0], v1[1]); w.w = cvt_pk_bf16(v1[2], v1[3]);
                        g[(size_t)((ai * 4 + m) * 2 + bj) * 512] = w;
                    }
        } else if (u.kind == 3) {
            const unsigned char* gb = ws + WS_GSCR + (size_t)(u.pm * 4 + u.pn) * 16 * 512 * 16;
            unsigned char* mb = ws + WS_MERGED + (size_t)u.pm * 256 * 2048 + (size_t)u.pn * 512;
            const unsigned gvo = (unsigned)tid * 16u, mvo = (unsigned)((wr * 64 + fr) * 2048 + (wc * 32 + 8 * fq) * 2);
            u32x4 gwn[2];
            gwn[0] = *(const u32x4*)(gb + gvo); gwn[1] = *(const u32x4*)(gb + 8192 + gvo);
#pragma unroll
            for (int sp = 0; sp < 8; ++sp) {
                const int ai = sp >> 2, m = sp & 3;
                u32x4 gw[2], pw[2];
                gw[0] = gwn[0]; gw[1] = gwn[1];
#pragma unroll
                for (int k = 0; k < 2; ++k) { pw[k] = (u32x4){0u, 0u, 0u, 0u};
                    if (u.sub > 0) pw[k] = *(const u32x4*)(mb + (size_t)(ai * 128 + m * 16) * 2048 + k * 256 + mvo); }
                if (sp + 1 < 8) { gwn[0] = *(const u32x4*)(gb + (size_t)(2 * (sp + 1)) * 8192 + gvo); gwn[1] = *(const u32x4*)(gb + (size_t)(2 * (sp + 1) + 1) * 8192 + gvo); }
#pragma unroll
                for (int k = 0; k < 2; ++k) { const int bj = k;
                    const f32x4 v0 = acc[ai][bj][m][0], v1 = acc[ai][bj][m][1];
                    const float r0 = sigmoid_fast(lo_bf(gw[k].x)) * v0[0] + lo_bf(pw[k].x), r1 = sigmoid_fast(hi_bf(gw[k].x)) * v0[1] + hi_bf(pw[k].x), r2 = sigmoid_fast(lo_bf(gw[k].y)) * v0[2] + lo_bf(pw[k].y), r3 = sigmoid_fast(hi_bf(gw[k].y)) * v0[3] + hi_bf(pw[k].y);
                    const float r4 = sigmoid_fast(lo_bf(gw[k].z)) * v1[0] + lo_bf(pw[k].z), r5 = sigmoid_fast(hi_bf(gw[k].z)) * v1[1] + hi_bf(pw[k].z), r6 = sigmoid_fast(lo_bf(gw[k].w)) * v1[2] + lo_bf(pw[k].w), r7 = sigmoid_fast(hi_bf(gw[k].w)) * v1[3] + hi_bf(pw[k].w);
                    u32x4 w; w.x = cvt_pk_bf16(r0, r1); w.y = cvt_pk_bf16(r2, r3); w.z = cvt_pk_bf16(r4, r5); w.w = cvt_pk_bf16(r6, r7);
                    *(u32x4*)(mb + (size_t)(ai * 128 + m * 16) * 2048 + bj * 256 + mvo) = w; }
                asm volatile("" ::: "memory");
            }
        } else {
            bf16_t* o = (bf16_t*)(ws + WS_OUT);
#pragma unroll
            for (int ai = 0; ai < 2; ++ai)
#pragma unroll
                for (int m = 0; m < 4; ++m) {
                    bf16_t* rowp = o + (size_t)(row0 + ai * 128 + m * 16) * 1024 + col0;
#pragma unroll
                    for (int bj = 0; bj < 2; ++bj) { const f32x4 v0 = acc[ai][bj][m][0], v1 = acc[ai][bj][m][1];
                        u32x4 w; w.x = cvt_pk_bf16(v0[0], v0[1]); w.y = cvt_pk_bf16(v0[2], v0[3]); w.z = cvt_pk_bf16(v1[0], v1[1]); w.w = cvt_pk_bf16(v1[2], v1[3]);
                        *(u32x4*)(rowp + bj * 128) = w; }
                }
        }
    }
};

struct SchedA {
    const unsigned char* ws; int G, c;
    __device__ __forceinline__ bool next(int i, Unit& u) const {
        const int L = i * G + c;
        constexpr int nN = 23, nwg = 64 * nN;
        if (L < nwg) {
            int wgid = L; { const int q = nwg / 8, xcd = wgid % 8, off = wgid / 8; wgid = xcd * q + off; }
            const int nig = 8 * nN, gid = wgid / nig, fm = gid * 8;
            u.pm = fm + ((wgid % nig) % 8); u.pn = (wgid % nig) / 8; u.kind = 0; u.sub = 0; u.lda = 1024; u.ldb = 1024; u.nt = 16;
            u.a = (const char*)(ws + WS_H) + (size_t)u.pm * 256 * 1024 * 2; u.b = (const char*)(ws + WS_WINT) + (size_t)u.pn * 256 * 1024 * 2;
            return true;
        }
        const int r = L - nwg; if (r >= 32) return false;
        u.pm = r >> 2; u.pn = r & 3; u.kind = 1; u.sub = 0; u.lda = 1024; u.ldb = 1024; u.nt = 16;
        u.a = (const char*)(ws + WS_MEMN) + (size_t)u.pm * 256 * 1024 * 2; u.b = (const char*)(ws + WS_WMKVT) + (size_t)u.pn * 256 * 1024 * 2;
        return true;
    }
};
struct SchedD {
    const unsigned char* ws; int G, vcu;
    __device__ __forceinline__ bool next(int i, Unit& u) const {
        const int tile = vcu + (i >> 3) * G; if (tile >= 256) return false;
        const int sub = i & 7, n = sub >> 1;
        u.pm = tile >> 2; u.pn = tile & 3; u.sub = n;
        if ((sub & 1) == 0) { u.kind = 2; u.lda = 1024; u.ldb = 1024; u.nt = 16;
            u.a = (const char*)(ws + WS_H) + (size_t)u.pm * 256 * 1024 * 2; u.b = (const char*)(ws + WS_WGT) + (size_t)(n * 1024 + u.pn * 256) * 1024 * 2;
        } else { u.kind = 3; u.lda = NC; u.ldb = 512; u.nt = 8;
            const int yoff = n == 0 ? C_DNZ : (n == 1 ? C_GMU : (n == 2 ? C_SWQ : C_XMQ));
            u.a = (const char*)(ws + WS_COLS) + ((size_t)u.pm * 256 * NC + yoff) * 2; u.b = (const char*)(ws + WS_WUPT) + (size_t)(n * 1024 + u.pn * 256) * 512 * 2; }
        return true;
    }
};
struct SchedE {
    const unsigned char* ws; int G, vcu;
    __device__ __forceinline__ bool next(int i, Unit& u) const {
        const int tile = vcu + i * G; if (tile >= 256) return false;
        u.pm = tile >> 2; u.pn = tile & 3; u.kind = 4; u.sub = 0; u.lda = 1024; u.ldb = 1024; u.nt = 16;
        u.a = (const char*)(ws + WS_MERGED) + (size_t)u.pm * 256 * 1024 * 2; u.b = (const char*)(ws + WS_WOUTT) + (size_t)u.pn * 256 * 1024 * 2;
        return true;
    }
};

__device__ __forceinline__ void tr_item(const float* W, int ldw, int k0, bf16_t* WT, int Kdst, LAS float* scr, int lane) {
    float tv[32];
#pragma unroll
    for (int i = 0; i < 32; ++i) tv[i] = __builtin_nontemporal_load(&W[(size_t)(k0 + 2 * i + (lane >> 5)) * ldw + (lane & 31)]);
#pragma unroll
    for (int i = 0; i < 32; ++i) scr[(2 * i + (lane >> 5)) * 33 + (lane & 31)] = tv[i];
    asm volatile("s_waitcnt lgkmcnt(0)" ::: "memory");
    const int c = lane & 7;
#pragma unroll
    for (int j = 0; j < 4; ++j) { const int n = (lane >> 3) + 8 * j; const LAS float* s = scr + (8 * c) * 33 + n;
        u32x4 o; o.x = cvt_pk_bf16(s[0 * 33], s[1 * 33]); o.y = cvt_pk_bf16(s[2 * 33], s[3 * 33]); o.z = cvt_pk_bf16(s[4 * 33], s[5 * 33]); o.w = cvt_pk_bf16(s[6 * 33], s[7 * 33]);
        *(u32x4*)(WT + (size_t)n * Kdst + k0 + 8 * c) = o; }
    asm volatile("s_waitcnt lgkmcnt(0)" ::: "memory");
}

__device__ __forceinline__ void p0_stage(const Params& p, int rk, LAS unsigned char* lds) {
    int tid_ = threadIdx.x; asm volatile("" : "+v"(tid_));
    const int tid = tid_, lane = tid & 63, wave = tid >> 6;
    const int gw = blockIdx.x * 8 + wave, NGW = gridDim.x * 8;
    unsigned char* ws = p.ws;
    LAS float* W8T = (LAS float*)(lds + 8 * 8448);
    if (rk <= 1) {
        const int l = rk;
        const float* win = p.w_in + (size_t)l * 1024 * DIN;
        {   f32x4 wv[4];
#pragma unroll
            for (int t2 = 0; t2 < 2; ++t2) { const float* wp = win + (size_t)(tid + 512 * t2) * DIN + 2048; wv[2 * t2] = *(const f32x4*)wp; wv[2 * t2 + 1] = *(const f32x4*)(wp + 4); }
#pragma unroll
            for (int t2 = 0; t2 < 2; ++t2)
#pragma unroll
                for (int j = 0; j < 8; ++j) W8T[j * 1024 + tid + 512 * t2] = wv[2 * t2 + (j >> 2)][j & 3]; }
        LAS float* scr = (LAS float*)(lds + wave * 8448);
        for (int it = gw; it < 7040; it += NGW) {
            if (it < 2944) { const int kb = it / 184, nb = it % 184, n0 = 32 * nb, sc = n0 < 2048 ? n0 : n0 + 8;
                tr_item(win + sc, DIN, 64 * kb, (bf16_t*)(ws + WS_WINT) + (size_t)n0 * 1024, 1024, scr, lane);
            } else if (it < 4992) { const int r = it - 2944, kb = r / 128, nb = r % 128;
                tr_item(win + 5896 + 32 * nb, DIN, 64 * kb, (bf16_t*)(ws + WS_WGT) + (size_t)(32 * nb) * 1024, 1024, scr, lane);
            } else if (it < 6016) { const int r = it - 4992, n = r / 256, r2 = r % 256, kb = r2 / 32, nb = r2 % 32;
                tr_item(p.w_up + (size_t)(l * 4 + n) * 512 * 1024 + 32 * nb, 1024, 64 * kb, (bf16_t*)(ws + WS_WUPT) + (size_t)(n * 1024 + 32 * nb) * 512, 512, scr, lane);
            } else if (it < 6528) { const int r = it - 6016, kb = r / 32, nb = r % 32;
                tr_item(p.w_out + (size_t)l * 1024 * 1024 + 32 * nb, 1024, 64 * kb, (bf16_t*)(ws + WS_WOUTT) + (size_t)(32 * nb) * 1024, 1024, scr, lane);
            } else { const int r = it - 6528, kb = r / 32, nb = r % 32;
                tr_item(p.w_mem_kv + (size_t)l * 1024 * 1024 + 32 * nb, 1024, 64 * kb, (bf16_t*)(ws + WS_WMKVT) + (size_t)(32 * nb) * 1024, 1024, scr, lane);
            }
        }
        for (int e = blockIdx.x * 512 + tid; e < 65536; e += gridDim.x * 512) { const int pp = (e >> 7) & 127, qq = e & 127;
            ((bf16_t*)(ws + WS_SPW))[e] = (bf16_t)(qq <= pp ? f2bf(p.spatial_w[(size_t)l * 65536 + e]) : 0u); }
        for (int r = gw; r < 2048; r += NGW) {
            const f32x4* xr = (const f32x4*)(p.mem + (size_t)r * D) + lane; const f32x4* gr = (const f32x4*)(p.norm_mem + l * D) + lane;
            f32x4 v[4]; float ss = 0.f;
#pragma unroll
            for (int j = 0; j < 4; ++j) { v[j] = __builtin_nontemporal_load(&xr[64 * j]); ss += v[j][0] * v[j][0] + v[j][1] * v[j][1] + v[j][2] * v[j][2] + v[j][3] * v[j][3]; }
            const float rstd = rsqrtf(wave_sum(ss) * (1.f / D) + EPS);
            u32x2* o = (u32x2*)((bf16_t*)(ws + WS_MEMN) + (size_t)r * D) + lane;
#pragma unroll
            for (int j = 0; j < 4; ++j) { const f32x4 g = gr[64 * j]; u32x2 w; w.x = cvt_pk_bf16(v[j][0] * rstd * g[0], v[j][1] * rstd * g[1]); w.y = cvt_pk_bf16(v[j][2] * rstd * g[2], v[j][3] * rstd * g[3]); o[64 * j] = w; }
        }
    }
    __syncthreads();
    const float* xin = rk == 2 ? p.out : p.x;
    for (int row0 = gw; row0 < M; row0 += 2 * NGW) {
        f32x4 v[2][4], o[2][4];
#pragma unroll
        for (int rr = 0; rr < 2; ++rr) { const int row = row0 + rr * NGW;
            const f32x4* xr = (const f32x4*)(xin + (size_t)row * D) + lane;
#pragma unroll
            for (int j = 0; j < 4; ++j) v[rr][j] = __builtin_nontemporal_load(&xr[64 * j]);
            if (rk >= 1) { const u32x2* orow = (const u32x2*)((const bf16_t*)(ws + WS_OUT) + (size_t)row * D) + lane;
#pragma unroll
                for (int j = 0; j < 4; ++j) { const u32x2 ow = __builtin_nontemporal_load(&orow[64 * j]); o[rr][j] = (f32x4){lo_bf(ow.x), hi_bf(ow.x), lo_bf(ow.y), hi_bf(ow.y)}; } } }
        if (rk >= 1) {
            const f32x4* gr = (const f32x4*)(p.norm_post + (rk - 1) * D) + lane;
            float ss[2] = {0.f, 0.f};
#pragma unroll
            for (int rr = 0; rr < 2; ++rr)
#pragma unroll
                for (int j = 0; j < 4; ++j) ss[rr] += o[rr][j][0] * o[rr][j][0] + o[rr][j][1] * o[rr][j][1] + o[rr][j][2] * o[rr][j][2] + o[rr][j][3] * o[rr][j][3];
#pragma unroll
            for (int of = 1; of < 64; of <<= 1) { ss[0] += __shfl_xor(ss[0], of); ss[1] += __shfl_xor(ss[1], of); }
#pragma unroll
            for (int rr = 0; rr < 2; ++rr) { const float rstd = rsqrtf(ss[rr] * (1.f / D) + EPS);
                f32x4* dst = (f32x4*)(p.out + (size_t)(row0 + rr * NGW) * D) + lane;
#pragma unroll
                for (int j = 0; j < 4; ++j) { const f32x4 g = gr[64 * j]; v[rr][j] = v[rr][j] + o[rr][j] * rstd * g; dst[64 * j] = v[rr][j]; } }
        }
        if (rk <= 1) {
            const f32x4* gr = (const f32x4*)(p.norm_pre + rk * D) + lane;
            float ss[2] = {0.f, 0.f};
#pragma unroll
            for (int rr = 0; rr < 2; ++rr)
#pragma unroll
                for (int j = 0; j < 4; ++j) ss[rr] += v[rr][j][0] * v[rr][j][0] + v[rr][j][1] * v[rr][j][1] + v[rr][j][2] * v[rr][j][2] + v[rr][j][3] * v[rr][j][3];
#pragma unroll
            for (int of = 1; of < 64; of <<= 1) { ss[0] += __shfl_xor(ss[0], of); ss[1] += __shfl_xor(ss[1], of); }
            LAS float* red = (LAS float*)(lds + 8 * 8448 + 32768) + wave * 1024;
#pragma unroll
            for (int rr = 0; rr < 2; ++rr) { const float rstd = rsqrtf(ss[rr] * (1.f / D) + EPS);
                u32x2* oh = (u32x2*)((bf16_t*)(ws + WS_H) + (size_t)(row0 + rr * NGW) * D) + lane;
#pragma unroll
                for (int j = 0; j < 4; ++j) { const f32x4 g = gr[64 * j]; v[rr][j] = v[rr][j] * rstd * g; u32x2 w; w.x = cvt_pk_bf16(v[rr][j][0], v[rr][j][1]); w.y = cvt_pk_bf16(v[rr][j][2], v[rr][j][3]); oh[64 * j] = w; }
#pragma unroll
                for (int jj = 0; jj < 8; ++jj) { float a = 0.f;
#pragma unroll
                    for (int j = 0; j < 4; ++j) { const f32x4 w = *(const LAS f32x4*)(W8T + jj * 1024 + 256 * j + 4 * lane); a += v[rr][j][0] * w[0] + v[rr][j][1] * w[1] + v[rr][j][2] * w[2] + v[rr][j][3] * w[3]; }
                    red[rr * 512 + jj * 64 + lane] = a; } }
            asm volatile("s_waitcnt lgkmcnt(0)" ::: "memory");
#pragma unroll
            for (int rr = 0; rr < 2; ++rr) { const f32x4 r0 = *(const LAS f32x4*)(red + rr * 512 + lane * 8), r1 = *(const LAS f32x4*)(red + rr * 512 + lane * 8 + 4);
                float a = (r0[0] + r0[1]) + (r0[2] + r0[3]) + (r1[0] + r1[1]) + (r1[2] + r1[3]);
                a += __shfl_xor(a, 1); a += __shfl_xor(a, 2); a += __shfl_xor(a, 4);
                if ((lane & 7) == 0) ((float*)(ws + WS_SM) + (size_t)(row0 + rr * NGW) * 8)[lane >> 3] = a; }
            asm volatile("s_waitcnt lgkmcnt(0)" ::: "memory");
        }
    }
    __syncthreads();
}

__device__ __forceinline__ void delta_pre_unit(const Params& p, int l, int unit, LAS unsigned char* lds) {
    int tid_ = threadIdx.x; asm volatile("" : "+v"(tid_));
    const int tid = tid_, lane = tid & 63, wave = tid >> 6;
    const int h = unit & 3, gch = unit >> 2, c = gch & 31;
    const size_t row0 = (size_t)gch * 64;
    unsigned char* ws = p.ws;
    bf16_t* cols = (bf16_t*)(ws + WS_COLS);
    LAS float* Qf = (LAS float*)lds; LAS float* Kf = Qf + 64 * 129; LAS float* Vf = Kf + 64 * 129; LAS float* Lf = Vf + 64 * 129;
    LAS bf16_t* Qb = (LAS bf16_t*)(Lf + 64 * 68); LAS bf16_t* Kb = Qb + 64 * 136;
    LAS float* gcs = (LAS float*)(lds + 154112); LAS float* betas = gcs + 64; LAS float* facs = betas + 64;
    LAS bf16_t* Rw = (LAS bf16_t*)Lf;
    {
#pragma unroll
        for (int it = 0; it < 6; ++it) { const int pc = tid + 512 * it, r = pc / 48, rem = pc % 48, part = rem >> 4, cp = rem & 15;
            const u32x4 v = *(const u32x4*)(cols + (row0 + r) * NC + part * 512 + h * 128 + cp * 8);
            *(LAS u32x4*)(Rw + (r + 3) * 384 + part * 128 + cp * 8) = v; }
        if (tid < 144) { const int r = tid / 48, rem = tid % 48, part = rem >> 4, cp = rem & 15;
            u32x4 v = {0u, 0u, 0u, 0u};
            if (c > 0) v = *(const u32x4*)((const bf16_t*)(ws + WS_HALO) + ((size_t)(gch - 1) * 3 + r) * 1536 + part * 512 + h * 128 + cp * 8);
            *(LAS u32x4*)(Rw + r * 384 + part * 128 + cp * 8) = v; }
        if (wave == 6) {
            const float* sm = (const float*)(ws + WS_SM) + (row0 + lane) * 8;
            const float a = sm[4 + h] + p.dt_bias[l * 4 + h];
            const float sp = a > 20.f ? a : __logf(1.f + __expf(a));
            float g = -__expf(p.a_log[l * 4 + h]) * sp;
#pragma unroll
            for (int o = 1; o < 64; o <<= 1) { const float t = __shfl_up(g, o); if (lane >= o) g += t; }
            gcs[lane] = g;
        } else if (wave == 7) {
            const float* sm = (const float*)(ws + WS_SM) + (row0 + lane) * 8;
            betas[lane] = sigmoid_f(sm[h]);
        }
    }
    LDS_BAR();
    if (tid < 384) {
        const int quad = tid % 96, seg = tid / 96, c4 = 4 * quad, part = c4 >> 7, cc = c4 & 127;
        const float* cw = p.conv_w + (size_t)l * 4 * 1536 + part * 512 + h * 128 + cc;
        const f32x4 w0 = *(const f32x4*)cw, w1 = *(const f32x4*)(cw + 1536), w2 = *(const f32x4*)(cw + 2 * 1536), w3 = *(const f32x4*)(cw + 3 * 1536);
        const LAS bf16_t* src = Rw + (16 * seg) * 384 + c4;
        u32x2 rv[19];
#pragma unroll
        for (int r = 0; r < 19; ++r) rv[r] = *(const LAS u32x2*)(src + r * 384);
        LAS float* dst = (part == 0 ? Qf : (part == 1 ? Kf : Vf)) + (16 * seg) * 129 + cc;
#pragma unroll
        for (int r = 0; r < 16; ++r) {
            const u32x2 a3 = rv[r], a2 = rv[r + 1], a1 = rv[r + 2], a0 = rv[r + 3];
            const float y0 = w0[0] * lo_bf(a3.x) + w1[0] * lo_bf(a2.x) + w2[0] * lo_bf(a1.x) + w3[0] * lo_bf(a0.x);
            const float y1 = w0[1] * hi_bf(a3.x) + w1[1] * hi_bf(a2.x) + w2[1] * hi_bf(a1.x) + w3[1] * hi_bf(a0.x);
            const float y2 = w0[2] * lo_bf(a3.y) + w1[2] * lo_bf(a2.y) + w2[2] * lo_bf(a1.y) + w3[2] * lo_bf(a0.y);
            const float y3 = w0[3] * hi_bf(a3.y) + w1[3] * hi_bf(a2.y) + w2[3] * hi_bf(a1.y) + w3[3] * hi_bf(a0.y);
            dst[r * 129 + 0] = silu_f(y0); dst[r * 129 + 1] = silu_f(y1); dst[r * 129 + 2] = silu_f(y2); dst[r * 129 + 3] = silu_f(y3);
        }
    }
    LDS_BAR();
    if (tid < 64) { facs[tid] = betas[tid]; facs[64 + tid] = betas[tid] * __expf(gcs[tid]); }
    {
        const int r = tid >> 3, sub = tid & 7; float sq = 0.f, sk = 0.f;
#pragma unroll
        for (int e = 0; e < 16; ++e) { const float a = Qf[r * 129 + sub * 16 + e]; sq += a * a; const float b = Kf[r * 129 + sub * 16 + e]; sk += b * b; }
        sq += __shfl_xor(sq, 1); sq += __shfl_xor(sq, 2); sq += __shfl_xor(sq, 4);
        sk += __shfl_xor(sk, 1); sk += __shfl_xor(sk, 2); sk += __shfl_xor(sk, 4);
        const float rq = rsqrtf(sq + EPS) * 0.08838834764831845f, rkk = rsqrtf(sk + EPS);
#pragma unroll
        for (int e = 0; e < 16; ++e) { const int o = sub * 16 + e; const float a = Qf[r * 129 + o] * rq; Qb[r * 136 + o] = (bf16_t)f2bf(a);
            const float b = Kf[r * 129 + o] * rkk; Kf[r * 129 + o] = b; Kb[r * 136 + o] = (bf16_t)f2bf(b); }
    }
    LDS_BAR();
    LAS bf16_t* Al = (LAS bf16_t*)Qf;
    LAS float* Db = Qf;
    LAS bf16_t* Lb = (LAS bf16_t*)(lds + 16640);
    LAS bf16_t* XT = Qb;
    LAS bf16_t* Wl = (LAS bf16_t*)Vf;
    {
        const int i = lane & 15, q = lane >> 4;
#pragma unroll
        for (int jb = 0; jb < 4; ++jb) { const int job = wave + 8 * jb;
            const int kind = job >> 4, ct = (job >> 2) & 3, st = job & 3;
            f32x4 acc = {0.f, 0.f, 0.f, 0.f};
            if (st <= ct) {
                const LAS bf16_t* Ab = kind == 0 ? Kb : Qb;
#pragma unroll
                for (int ks = 0; ks < 4; ++ks) { const bf16x8 a = *(const LAS bf16x8*)(Ab + (16 * ct + i) * 136 + 32 * ks + 8 * q); const bf16x8 b = *(const LAS bf16x8*)(Kb + (16 * st + i) * 136 + 32 * ks + 8 * q);
                    acc = MFMA16(a, b, acc); }
            }
            const int s = 16 * st + i; const float gs = gcs[s];
#pragma unroll
            for (int r = 0; r < 4; ++r) { const int cr = 16 * ct + 4 * q + r; const float e = __expf(fminf(gcs[cr] - gs, 0.f));
                if (kind == 0) { const float v = (cr > s) ? acc[r] * betas[cr] * e : 0.f; Lf[cr * 68 + s] = v; Lb[cr * 72 + s] = (bf16_t)f2bf(v); }
                else Al[cr * 72 + (s & ~31) + kperm32(s & 31)] = (bf16_t)f2bf(cr >= s ? acc[r] * e : 0.f); }
        }
    }
    LDS_BAR();
    {
        *(u32x4*)(ws + WS_WA_A + (size_t)unit * 8192 + tid * 16) = *(const LAS u32x4*)(Al + (tid >> 3) * 72 + (tid & 7) * 8);
        { const int cr = tid >> 3, d0 = (tid & 7) * 16; const float e = __expf(gcs[cr]);
            bf16_t* dst = cols + (row0 + cr) * NC + C_DNQ + h * 128 + d0;
#pragma unroll
            for (int g4 = 0; g4 < 2; ++g4) { const u32x4 v = *(const LAS u32x4*)(Qb + cr * 136 + d0 + 8 * g4); u32x4 w;
                w.x = cvt_pk_bf16(lo_bf(v.x) * e, hi_bf(v.x) * e); w.y = cvt_pk_bf16(lo_bf(v.y) * e, hi_bf(v.y) * e); w.z = cvt_pk_bf16(lo_bf(v.z) * e, hi_bf(v.z) * e); w.w = cvt_pk_bf16(lo_bf(v.w) * e, hi_bf(v.w) * e);
                const int o0 = (d0 + 8 * g4) & 31, gb = (d0 + 8 * g4) & ~31;
                *(u32x2*)(dst - d0 + gb + kperm32(o0)) = (u32x2){w.x, w.y}; *(u32x2*)(dst - d0 + gb + kperm32(o0 + 4)) = (u32x2){w.z, w.w}; } }
        { const int dk = tid & 127, c0 = (tid >> 7) * 16; const float gl = gcs[63];
            bf16_t* dst = cols + (row0 + (dk >> 1)) * NC + C_DNK + h * 128 + (dk & 1) * 64 + c0;
#pragma unroll
            for (int g4 = 0; g4 < 2; ++g4) { float v[8];
#pragma unroll
                for (int e = 0; e < 8; ++e) { const int cr = c0 + 8 * g4 + e; v[e] = Kf[cr * 129 + dk] * __expf(gl - gcs[cr]); }
                u32x4 w; w.x = cvt_pk_bf16(v[0], v[1]); w.y = cvt_pk_bf16(v[2], v[3]); w.z = cvt_pk_bf16(v[4], v[5]); w.w = cvt_pk_bf16(v[6], v[7]);
                const int cc0 = c0 + 8 * g4, gb = cc0 & ~31, o0 = cc0 & 31;
                *(u32x2*)(dst - c0 + gb + kperm32(o0)) = (u32x2){w.x, w.y}; *(u32x2*)(dst - c0 + gb + kperm32(o0 + 4)) = (u32x2){w.z, w.w}; } }
        if (tid == 0) ((float*)(ws + WS_DL))[unit] = __expf(gcs[63]);
    }
    LDS_BAR();
    for (int e = tid; e < 2304; e += 512) ((LAS u32x4*)XT)[e] = (u32x4){0u, 0u, 0u, 0u};
    LDS_BAR();
    {
        const int j = tid & 255; const bool isv = j < 128; const int jj = j & 127;
        const LAS float* src = (isv ? Vf : Kf) + jj;
        const LAS float* fac = facs + (isv ? 0 : 64);
        const int i16 = lane & 15, q = lane >> 4;
        float x[64];
#pragma unroll
        for (int bb = 0; bb < 4; ++bb) {
            if (bb > 0) {
#pragma unroll
                for (int tt = 0; tt < 2; ++tt) { const int ct = 2 * wave + tt; f32x4 acc = {0.f, 0.f, 0.f, 0.f};
#pragma unroll
                    for (int ks = 0; ks < 2; ++ks) if (32 * ks < 16 * bb) acc = MFMA16(*(const LAS bf16x8*)(Lb + (16 * bb + i16) * 72 + 32 * ks + 8 * q), *(const LAS bf16x8*)(XT + (16 * ct + i16) * 72 + 32 * ks + 8 * q), acc);
#pragma unroll
                    for (int r = 0; r < 4; ++r) Db[(4 * q + r) * 260 + 16 * ct + i16] = acc[r]; }
                LDS_BAR();
            }
            if (tid < 256) {
                int Lr[16]; float rh[16];
#pragma unroll
                for (int i = 0; i < 16; ++i) { const int row = 16 * bb + i;
                    Lr[i] = __float_as_int(Lf[row * 68 + 16 * bb + i16]);
                    rh[i] = src[row * 129] * fac[row] - (bb > 0 ? Db[i * 260 + j] : 0.f); }
#pragma unroll
                for (int i = 0; i < 16; ++i) { const int row = 16 * bb + i;
                    float sa[4] = {rh[i], 0.f, 0.f, 0.f};
#pragma unroll
                    for (int jx = 0; jx < i; ++jx) sa[jx & 3] -= __int_as_float(__builtin_amdgcn_readlane(Lr[i], jx)) * x[16 * bb + jx];
                    x[row] = (sa[0] + sa[1]) + (sa[2] + sa[3]); }
                u32x4 w0, w1;
                w0.x = cvt_pk_bf16(x[16 * bb + 0], x[16 * bb + 1]); w0.y = cvt_pk_bf16(x[16 * bb + 2], x[16 * bb + 3]); w0.z = cvt_pk_bf16(x[16 * bb + 4], x[16 * bb + 5]); w0.w = cvt_pk_bf16(x[16 * bb + 6], x[16 * bb + 7]);
                w1.x = cvt_pk_bf16(x[16 * bb + 8], x[16 * bb + 9]); w1.y = cvt_pk_bf16(x[16 * bb + 10], x[16 * bb + 11]); w1.z = cvt_pk_bf16(x[16 * bb + 12], x[16 * bb + 13]); w1.w = cvt_pk_bf16(x[16 * bb + 14], x[16 * bb + 15]);
                *(LAS u32x4*)(XT + j * 72 + 16 * bb) = w0; *(LAS u32x4*)(XT + j * 72 + 16 * bb + 8) = w1;
            }
            LDS_BAR();
        }
#pragma unroll
        for (int it = 0; it < 2; ++it) { const int pc = tid + 512 * it, dv = pc >> 3, cp = pc & 7;
            *(u32x4*)(cols + (row0 + (dv >> 1)) * NC + C_DNV + h * 128 + (dv & 1) * 64 + cp * 8) = *(const LAS u32x4*)(XT + dv * 72 + cp * 8); }
        if (tid >= 128 && tid < 256) {
#pragma unroll
            for (int i = 0; i < 64; ++i) Wl[i * 136 + (jj & ~31) + kperm32(jj & 31)] = (bf16_t)f2bf(x[i]); }
    }
    LDS_BAR();
    {   unsigned char* wo = ws + WS_WA_W + (size_t)unit * 16384;
#pragma unroll
        for (int it = 0; it < 2; ++it) { const int pc = tid + 512 * it; *(u32x4*)(wo + pc * 16) = *(const LAS u32x4*)(Wl + (pc >> 4) * 136 + (pc & 15) * 8); }
    }
    LDS_BAR();
}

__device__ __forceinline__ void delta_scan_unit(const Params& p, int l, int bh, LAS unsigned char* lds) {
    int tid_ = threadIdx.x; asm volatile("" : "+v"(tid_));
    const int tid = tid_, lane = tid & 63, wave = tid >> 6, i = lane & 15, q = lane >> 4;
    const int b = bh >> 2, h = bh & 3;
    unsigned char* ws = p.ws;
    unsigned char* colsb = ws + WS_COLS;
    constexpr int BUFB = 62464, O_W = 0, O_QG = 17408, O_KD = 34816, O_A = 53248;
    LAS bf16_t* Ot = (LAS bf16_t*)(lds + 2 * BUFB);
    if (wave < 4) {
        __builtin_amdgcn_s_setprio(3);
        f32x4 S[2][8];
#pragma unroll
        for (int s2 = 0; s2 < 2; ++s2)
#pragma unroll
            for (int t = 0; t < 8; ++t) S[s2][t] = (f32x4){0.f, 0.f, 0.f, 0.f};
        u32x2 uraw[2][4]; float dl;
        const float dlv = ((const float*)(ws + WS_DL))[(b * 32 + (lane & 31)) * 4 + h];
#define SCAN_ULOAD(cidx, dstu, dstd) do { const int gch_ = b * 32 + (cidx); const size_t r0_ = (size_t)gch_ * 64; \
            _Pragma("unroll") for (int s2 = 0; s2 < 2; ++s2) { const int dv_ = 32 * wave + 16 * s2 + i; \
                const unsigned char* ub_ = colsb + ((r0_ + (dv_ >> 1)) * NC + C_DNV + h * 128 + (dv_ & 1) * 64 + 4 * q) * 2; \
                _Pragma("unroll") for (int mt = 0; mt < 4; ++mt) dstu[s2][mt] = *(const u32x2*)(ub_ + mt * 32); } } while (0)
#define SCAN_LD16(pp) (*(const LAS bf16x8*)(pp))
#define SCAN_FRAG(f) ( (f) < 16 ? SCAN_LD16(buf + O_W + (16 * ((f) >> 2) + i) * 272 + (32 * ((f) & 3) + 8 * q) * 2) \
                     : (f) < 32 ? SCAN_LD16(buf + O_QG + (16 * (((f) - 16) >> 2) + i) * 272 + (32 * (((f) - 16) & 3) + 8 * q) * 2) \
                     : (f) < 38 ? SCAN_LD16(buf + O_A + (16 * ((f) == 32 ? 0 : (f) == 33 ? 1 : (f) <= 35 ? 2 : 3) + i) * 144 + (32 * (((f) == 35 || (f) == 37) ? 1 : 0) + 8 * q) * 2) \
                     : SCAN_LD16(buf + O_KD + (16 * (((f) - 38) >> 1) + i) * 144 + (32 * (((f) - 38) & 1) + 8 * q) * 2) )
        SCAN_ULOAD(0, uraw, dl);
        __syncthreads();
#pragma unroll 1
        for (int c = 0; c < 32; ++c) {
            const LAS unsigned char* buf = lds + (c & 1) * BUFB;
            dl = __int_as_float(__builtin_amdgcn_readlane(__float_as_int(dlv), c));
            bf16x8 Sb[2][4];
#pragma unroll
            for (int s2 = 0; s2 < 2; ++s2)
#pragma unroll
                for (int ks = 0; ks < 4; ++ks) Sb[s2][ks] = pack8(S[s2][2 * ks], S[s2][2 * ks + 1]);
            f32x4 aw[2][4], o[2][4];
            bf16x8 Vb[2][2];
            bf16x8 Fq[8];
            constexpr int DEPTH = 6;
            Fq[0] = SCAN_FRAG(0); Fq[1] = SCAN_FRAG(1); Fq[2] = SCAN_FRAG(2); Fq[3] = SCAN_FRAG(3); Fq[4] = SCAN_FRAG(4); Fq[5] = SCAN_FRAG(5);
#define SCAN_STEP(f) { \
                if ((f) + DEPTH < 54) Fq[((f) + DEPTH) & 7] = SCAN_FRAG(((f) + DEPTH < 54 ? (f) + DEPTH : 53)); \
                const bf16x8 A = Fq[(f) & 7]; \
                if ((f) < 16) { constexpr int mt = ((f) >> 2) & 3, ks = (f) & 3; \
                    if (ks == 0) { aw[0][mt] = (f32x4){0.f, 0.f, 0.f, 0.f}; aw[1][mt] = (f32x4){0.f, 0.f, 0.f, 0.f}; } \
                    aw[0][mt] = MFMA16(A, Sb[0][ks], aw[0][mt]); aw[1][mt] = MFMA16(A, Sb[1][ks], aw[1][mt]); \
                } else if ((f) < 32) { constexpr int mt = (((f) - 16) >> 2) & 3, ks = (f) & 3; \
                    if (ks == 0) { o[0][mt] = (f32x4){0.f, 0.f, 0.f, 0.f}; o[1][mt] = (f32x4){0.f, 0.f, 0.f, 0.f}; } \
                    o[0][mt] = MFMA16(A, Sb[0][ks], o[0][mt]); o[1][mt] = MFMA16(A, Sb[1][ks], o[1][mt]); \
                } else if ((f) < 38) { constexpr int mt = (f) == 32 ? 0 : ((f) == 33 ? 1 : ((f) <= 35 ? 2 : 3)), k2 = ((f) == 35 || (f) == 37) ? 1 : 0; \
                    o[0][mt] = MFMA16(A, Vb[0][k2], o[0][mt]); o[1][mt] = MFMA16(A, Vb[1][k2], o[1][mt]); \
                } else { constexpr int t = (((f) - 38) >> 1) & 7, k2 = (f) & 1; \
                    if (k2 == 0) { S[0][t] = S[0][t] * dl; S[1][t] = S[1][t] * dl; } \
                    S[0][t] = MFMA16(A, Vb[0][k2], S[0][t]); S[1][t] = MFMA16(A, Vb[1][k2], S[1][t]); } \
                if ((f) == 19) { \
                    f32x4 vn[2][4]; \
                    _Pragma("unroll") for (int s2 = 0; s2 < 2; ++s2) \
                    _Pragma("unroll") for (int mt = 0; mt < 4; ++mt) vn[s2][mt] = (f32x4){lo_bf(uraw[s2][mt].x) - aw[s2][mt][0], hi_bf(uraw[s2][mt].x) - aw[s2][mt][1], lo_bf(uraw[s2][mt].y) - aw[s2][mt][2], hi_bf(uraw[s2][mt].y) - aw[s2][mt][3]}; \
                    _Pragma("unroll") for (int s2 = 0; s2 < 2; ++s2) { Vb[s2][0] = pack8(vn[s2][0], vn[s2][1]); Vb[s2][1] = pack8(vn[s2][2], vn[s2][3]); } \
                    if (c + 1 < 32) SCAN_ULOAD(c + 1, uraw, dl); \
                } \
                __builtin_amdgcn_sched_barrier(0); }
#define SCAN_STEP6(f) SCAN_STEP(f) SCAN_STEP((f) + 1) SCAN_STEP((f) + 2) SCAN_STEP((f) + 3) SCAN_STEP((f) + 4) SCAN_STEP((f) + 5)
            SCAN_STEP6(0) SCAN_STEP6(6) SCAN_STEP6(12) SCAN_STEP6(18) SCAN_STEP6(24) SCAN_STEP6(30) SCAN_STEP6(36) SCAN_STEP6(42) SCAN_STEP6(48)
#undef SCAN_STEP6
#undef SCAN_STEP
            __syncthreads();
#pragma unroll
            for (int s2 = 0; s2 < 2; ++s2)
#pragma unroll
                for (int mt = 0; mt < 4; ++mt)
#pragma unroll
                    for (int r = 0; r < 4; ++r) Ot[(16 * mt + 4 * q + r) * 136 + 32 * wave + 16 * s2 + i] = (bf16_t)f2bf(o[s2][mt][r]);
            __syncthreads();
        }
#undef SCAN_FRAG
#undef SCAN_LD16
#undef SCAN_ULOAD
        __builtin_amdgcn_s_setprio(0);
        __syncthreads();
    } else {
        const int t2 = tid - 256, fr_ = t2 >> 2, fs_ = t2 & 3;
        float gn[32];
#pragma unroll
        for (int e = 0; e < 32; ++e) gn[e] = p.dn_norm[l * 128 + fs_ * 32 + e];
        u32x4 pre[14], zc[4], zn[4];
#define SCAN_LOAD(cidx) do { const int gch_ = b * 32 + (cidx); const size_t r0_ = (size_t)gch_ * 64; const int un2_ = gch_ * 4 + h; \
            const unsigned char* wsrc_ = ws + WS_WA_W + (size_t)un2_ * 16384; const unsigned char* asrc_ = ws + WS_WA_A + (size_t)un2_ * 8192; \
            _Pragma("unroll") for (int k = 0; k < 4; ++k) { const int pc_ = t2 + 256 * k; \
                pre[k] = __builtin_nontemporal_load((const u32x4*)(wsrc_ + pc_ * 16)); \
                pre[4 + k] = __builtin_nontemporal_load((const u32x4*)(colsb + ((r0_ + (pc_ >> 4)) * NC + C_DNQ + h * 128) * 2 + (pc_ & 15) * 16)); \
                pre[8 + k] = __builtin_nontemporal_load((const u32x4*)(colsb + ((r0_ + (pc_ >> 4)) * NC + C_DNK + h * 128) * 2 + (pc_ & 15) * 16)); } \
            pre[12] = __builtin_nontemporal_load((const u32x4*)(asrc_ + t2 * 16)); pre[13] = __builtin_nontemporal_load((const u32x4*)(asrc_ + (t2 + 256) * 16)); } while (0)
#define SCAN_ZLOAD(cidx, dst) do { const unsigned char* zb_ = colsb + (((size_t)(b * 32 + (cidx)) * 64 + fr_) * NC + C_DNZ + h * 128 + fs_ * 32) * 2; \
            _Pragma("unroll") for (int k = 0; k < 4; ++k) dst[k] = *(const u32x4*)(zb_ + 16 * k); } while (0)
#define SCAN_STORE(bufp) do { LAS unsigned char* b_ = (bufp); \
            _Pragma("unroll") for (int k = 0; k < 4; ++k) { const int pc_ = t2 + 256 * k; \
                *(LAS u32x4*)(b_ + O_W + (pc_ >> 4) * 272 + (pc_ & 15) * 16) = pre[k]; \
                *(LAS u32x4*)(b_ + O_QG + (pc_ >> 4) * 272 + (pc_ & 15) * 16) = pre[4 + k]; \
                *(LAS u32x4*)(b_ + O_KD + (pc_ >> 3) * 144 + (pc_ & 7) * 16) = pre[8 + k]; } \
            *(LAS u32x4*)(b_ + O_A + (t2 >> 3) * 144 + (t2 & 7) * 16) = pre[12]; *(LAS u32x4*)(b_ + O_A + ((t2 + 256) >> 3) * 144 + (t2 & 7) * 16) = pre[13]; } while (0)
#define SCAN_FINAL(cidx) do { \
            float ss_ = 0.f; u32x4 ov_[4]; \
            _Pragma("unroll") for (int k = 0; k < 4; ++k) { ov_[k] = *(const LAS u32x4*)(Ot + fr_ * 136 + fs_ * 32 + 8 * k); \
                ss_ += lo_bf(ov_[k].x) * lo_bf(ov_[k].x) + hi_bf(ov_[k].x) * hi_bf(ov_[k].x) + lo_bf(ov_[k].y) * lo_bf(ov_[k].y) + hi_bf(ov_[k].y) * hi_bf(ov_[k].y) \
                     + lo_bf(ov_[k].z) * lo_bf(ov_[k].z) + hi_bf(ov_[k].z) * hi_bf(ov_[k].z) + lo_bf(ov_[k].w) * lo_bf(ov_[k].w) + hi_bf(ov_[k].w) * hi_bf(ov_[k].w); } \
            ss_ += __shfl_xor(ss_, 1); ss_ += __shfl_xor(ss_, 2); \
            const float rstd_ = rsqrtf(ss_ * (1.f / 128.f) + EPS); \
            unsigned char* yb_ = colsb + (((size_t)(b * 32 + (cidx)) * 64 + fr_) * NC + C_DNZ + h * 128 + fs_ * 32) * 2; \
            _Pragma("unroll") for (int k = 0; k < 4; ++k) { u32x4 w_; \
                w_.x = cvt_pk_bf16(lo_bf(ov_[k].x) * rstd_ * gn[8 * k + 0] * lo_bf(zc[k].x), hi_bf(ov_[k].x) * rstd_ * gn[8 * k + 1] * hi_bf(zc[k].x)); \
                w_.y = cvt_pk_bf16(lo_bf(ov_[k].y) * rstd_ * gn[8 * k + 2] * lo_bf(zc[k].y), hi_bf(ov_[k].y) * rstd_ * gn[8 * k + 3] * hi_bf(zc[k].y)); \
                w_.z = cvt_pk_bf16(lo_bf(ov_[k].z) * rstd_ * gn[8 * k + 4] * lo_bf(zc[k].z), hi_bf(ov_[k].z) * rstd_ * gn[8 * k + 5] * hi_bf(zc[k].z)); \
                w_.w = cvt_pk_bf16(lo_bf(ov_[k].w) * rstd_ * gn[8 * k + 6] * lo_bf(zc[k].w), hi_bf(ov_[k].w) * rstd_ * gn[8 * k + 7] * hi_bf(zc[k].w)); \
                *(u32x4*)(yb_ + 16 * k) = w_; } } while (0)
        SCAN_LOAD(0); SCAN_STORE(lds);
        __syncthreads();
#pragma unroll 1
        for (int c = 0; c < 32; ++c) {
            if (c + 1 < 32) SCAN_LOAD(c + 1);
            SCAN_ZLOAD(c, zn);
            if (c > 0) SCAN_FINAL(c - 1);
            __syncthreads();
            if (c + 1 < 32) SCAN_STORE(lds + ((c + 1) & 1) * BUFB);
            __syncthreads();
#pragma unroll
            for (int k = 0; k < 4; ++k) zc[k] = zn[k];
        }
        SCAN_FINAL(31);
#undef SCAN_LOAD
#undef SCAN_ZLOAD
#undef SCAN_STORE
#undef SCAN_FINAL
        __syncthreads();
    }
}

__device__ __forceinline__ void gmlp_unit(const Params& p, int l, int unit, LAS unsigned char* lds) {
    int tid_ = threadIdx.x; asm volatile("" : "+v"(tid_));
    const int tid = tid_, lane = tid & 63, wave = tid >> 6, i = lane & 15, q = lane >> 4;
    const int g = unit & 3, bn = unit >> 2;
    const size_t row0 = (size_t)bn * 128;
    unsigned char* ws = p.ws;
    bf16_t* cols = (bf16_t*)(ws + WS_COLS);
    LAS float* rstd = (LAS float*)lds;
    LAS bf16_t* vT = (LAS bf16_t*)(lds + 512);
    {   u32x4 rv[16];
#pragma unroll
        for (int tt = 0; tt < 16; ++tt) rv[tt] = *(const u32x4*)(cols + (row0 + 16 * wave + tt) * NC + C_GMV + lane * 8);
#pragma unroll
        for (int tt = 0; tt < 16; ++tt) { const u32x4 v = rv[tt];
            float ss = lo_bf(v.x) * lo_bf(v.x) + hi_bf(v.x) * hi_bf(v.x) + lo_bf(v.y) * lo_bf(v.y) + hi_bf(v.y) * hi_bf(v.y) + lo_bf(v.z) * lo_bf(v.z) + hi_bf(v.z) * hi_bf(v.z) + lo_bf(v.w) * lo_bf(v.w) + hi_bf(v.w) * hi_bf(v.w);
            ss = wave_sum(ss); if (lane == 0) rstd[16 * wave + tt] = rsqrtf(ss * (1.f / 512.f) + EPS); } }
    LDS_BAR();
#pragma unroll
    for (int it = 0; it < 4; ++it) { const int pc = tid + 512 * it, qrow = pc >> 4, cp = pc & 15;
        const u32x4 v = *(const u32x4*)(cols + (row0 + qrow) * NC + C_GMV + g * 128 + cp * 8);
        const float* gp = p.gm_norm + l * 512 + g * 128 + cp * 8; const float rs = rstd[qrow];
        const float f[8] = {lo_bf(v.x), hi_bf(v.x), lo_bf(v.y), hi_bf(v.y), lo_bf(v.z), hi_bf(v.z), lo_bf(v.w), hi_bf(v.w)};
#pragma unroll
        for (int e = 0; e < 8; ++e) vT[(cp * 8 + e) * 136 + qrow] = (bf16_t)f2bf(f[e] * rs * gp[e]); }
    LDS_BAR();
    {
        const int pt = wave; const int nks = (pt >> 1) + 1;
        const bf16_t* spw = (const bf16_t*)(ws + WS_SPW) + (size_t)g * 16384 + (16 * pt + i) * 128 + 8 * q;
        bf16x8 Bf[4];
#pragma unroll
        for (int ks = 0; ks < 4; ++ks) Bf[ks] = *(const bf16x8*)(spw + 32 * ks);
        const float bias = p.spatial_b[l * 512 + g * 128 + 16 * pt + i];
        const size_t prow = row0 + 16 * pt + i;
        u32x2 uu8[8], zz8[8];
#pragma unroll
        for (int ct = 0; ct < 8; ++ct) { const int ch = g * 128 + 16 * ct + 4 * q; uu8[ct] = *(const u32x2*)(cols + prow * NC + C_GMU + ch); zz8[ct] = *(const u32x2*)(cols + prow * NC + C_GMZ + ch); }
#pragma unroll
        for (int ct = 0; ct < 8; ++ct) { f32x4 acc = {0.f, 0.f, 0.f, 0.f};
#pragma unroll
            for (int ks = 0; ks < 4; ++ks) if (ks < nks) acc = MFMA16(*(const LAS bf16x8*)(vT + (16 * ct + i) * 136 + 32 * ks + 8 * q), Bf[ks], acc);
            const int ch = g * 128 + 16 * ct + 4 * q;
            u32x2* up = (u32x2*)(cols + prow * NC + C_GMU + ch); const u32x2 uu = uu8[ct]; const u32x2 zz = zz8[ct];
            u32x2 w; w.x = cvt_pk_bf16(lo_bf(uu.x) * (acc[0] + bias) * lo_bf(zz.x), hi_bf(uu.x) * (acc[1] + bias) * hi_bf(zz.x));
            w.y = cvt_pk_bf16(lo_bf(uu.y) * (acc[2] + bias) * lo_bf(zz.y), hi_bf(uu.y) * (acc[3] + bias) * hi_bf(zz.y));
            *up = w; }
    }
    LDS_BAR();
}

template <int HD, int NK, bool SWA>
__device__ __forceinline__ void attn_pair16(bf16_t* qpA, bf16_t* qpB, const bf16x8 (&QfA)[HD / 32], const bf16x8 (&QfB)[HD / 32], const u32x2 (&ZfA)[HD / 16], const u32x2 (&ZfB)[HD / 16],
                                            const LAS bf16_t* Kl, const LAS bf16_t* VTl, int kp_lo, int kp_hi, float scale, float m0, float l0, int qi0A, int qi0B, bool blk0, int lane) {
    const int i = lane & 15, q = lane >> 4;
    float m[2] = {m0, m0}, lsum[2] = {l0, l0};
    f32x4 O[2][HD / 16];
#pragma unroll
    for (int t = 0; t < 2; ++t)
#pragma unroll
        for (int dt = 0; dt < HD / 16; ++dt) O[t][dt] = (f32x4){0.f, 0.f, 0.f, 0.f};
    const int qi[2] = {qi0A + i, qi0B + i};
    for (int kp = kp_lo; kp <= kp_hi; ++kp) {
        f32x4 s0[2], s1[2];
#pragma unroll
        for (int t = 0; t < 2; ++t) { s0[t] = (f32x4){0.f, 0.f, 0.f, 0.f}; s1[t] = (f32x4){0.f, 0.f, 0.f, 0.f}; }
#pragma unroll
        for (int kd = 0; kd < HD / 32; ++kd) {
            const bf16x8 k0f = *(const LAS bf16x8*)(Kl + (32 * kp + i) * (HD + 8) + 32 * kd + 8 * q), k1f = *(const LAS bf16x8*)(Kl + (32 * kp + 16 + i) * (HD + 8) + 32 * kd + 8 * q);
            s0[0] = MFMA16(k0f, QfA[kd], s0[0]); s1[0] = MFMA16(k1f, QfA[kd], s1[0]);
            s0[1] = MFMA16(k0f, QfB[kd], s0[1]); s1[1] = MFMA16(k1f, QfB[kd], s1[1]);
        }
        bf16x8 Pb[2]; float alpha[2];
#pragma unroll
        for (int t = 0; t < 2; ++t) {
            float mx = -1e30f;
#pragma unroll
            for (int r = 0; r < 4; ++r) {
                float a = s0[t][r] * scale, b = s1[t][r] * scale;
                if (SWA) { const int k0 = 32 * kp + 4 * q + r, k1 = k0 + 16;
                    if (!(k0 >= qi[t] + 1 && k0 <= qi[t] + 128 && (!blk0 || k0 >= 128))) a = -1e30f;
                    if (!(k1 >= qi[t] + 1 && k1 <= qi[t] + 128 && (!blk0 || k1 >= 128))) b = -1e30f; }
                s0[t][r] = a; s1[t][r] = b; mx = fmaxf(mx, fmaxf(a, b));
            }
            mx = fmaxf(mx, __shfl_xor(mx, 16)); mx = fmaxf(mx, __shfl_xor(mx, 32));
            const float mn = fmaxf(m[t], mx); alpha[t] = __expf(m[t] - mn);
            float ps = 0.f;
#pragma unroll
            for (int r = 0; r < 4; ++r) { s0[t][r] = __expf(s0[t][r] - mn); s1[t][r] = __expf(s1[t][r] - mn); ps += s0[t][r] + s1[t][r]; }
            ps += __shfl_xor(ps, 16); ps += __shfl_xor(ps, 32);
            lsum[t] = lsum[t] * alpha[t] + ps; m[t] = mn;
            Pb[t] = pack8(s0[t], s1[t]);
        }
#pragma unroll
        for (int dt = 0; dt < HD / 16; ++dt) {
            const bf16x8 vf = lds_ld2x8((const LAS unsigned char*)(VTl + (16 * dt + i) * (NK + 8) + 32 * kp + 4 * q));
            O[0][dt] = MFMA16(vf, Pb[0], O[0][dt] * alpha[0]); O[1][dt] = MFMA16(vf, Pb[1], O[1][dt] * alpha[1]); }
    }
#pragma unroll
    for (int t = 0; t < 2; ++t) { const float inv = 1.f / lsum[t]; bf16_t* qp = t == 0 ? qpA : qpB;
#pragma unroll
        for (int dt = 0; dt < HD / 16; ++dt) { const int d = 16 * dt + 4 * q;
            const u32x2 zz = t == 0 ? ZfA[dt] : ZfB[dt];
            u32x2 w; w.x = cvt_pk_bf16(O[t][dt][0] * inv * lo_bf(zz.x), O[t][dt][1] * inv * hi_bf(zz.x)); w.y = cvt_pk_bf16(O[t][dt][2] * inv * lo_bf(zz.y), O[t][dt][3] * inv * hi_bf(zz.y));
            *(u32x2*)(qp + (size_t)i * NC + d) = w; } }
}

__device__ __forceinline__ void swa_unit(const Params& p, int l, int unit, LAS unsigned char* lds) {
    int tid_ = threadIdx.x; asm volatile("" : "+v"(tid_));
    const int tid = tid_, lane = tid & 63, wave = tid >> 6;
    const int kvh = unit & 1, bn = unit >> 1, n = bn & 15, b = bn >> 4;
    unsigned char* ws = p.ws; bf16_t* cols = (bf16_t*)(ws + WS_COLS);
    LAS bf16_t* Kl = (LAS bf16_t*)lds;
    LAS bf16_t* VTl = Kl + 256 * 72;
    const long krow0 = (long)b * T + (long)(n - 1) * 128;
    const int g = wave >> 1, hq = kvh * 4 + g;
    bf16x8 Qf[4][2]; u32x2 Zf[4][4];
#pragma unroll
    for (int qt = 0; qt < 4; ++qt) { const size_t qrow = (size_t)b * T + n * 128 + (wave & 1) * 64 + 16 * qt + (lane & 15);
#pragma unroll
        for (int kd = 0; kd < 2; ++kd) Qf[qt][kd] = *(const bf16x8*)(cols + qrow * NC + C_SWQ + hq * 64 + 32 * kd + 8 * (lane >> 4));
#pragma unroll
        for (int dt = 0; dt < 4; ++dt) Zf[qt][dt] = *(const u32x2*)(cols + qrow * NC + C_SWZ + hq * 64 + 16 * dt + 4 * (lane >> 4)); }
#pragma unroll
    for (int it = 0; it < 4; ++it) { const int pc = tid + 512 * it, kj = pc >> 3, cp = pc & 7;
        u32x4 kv = {0u, 0u, 0u, 0u}, vv = {0u, 0u, 0u, 0u};
        if (n > 0 || kj >= 128) { const bf16_t* rp = cols + (size_t)(krow0 + kj) * NC; kv = *(const u32x4*)(rp + C_SWK + kvh * 64 + cp * 8); vv = *(const u32x4*)(rp + C_SWV + kvh * 64 + cp * 8); }
        *(LAS u32x4*)(Kl + kj * 72 + cp * 8) = kv;
        const unsigned vw[4] = {vv.x, vv.y, vv.z, vv.w};
#pragma unroll
        for (int e = 0; e < 4; ++e) { VTl[(cp * 8 + 2 * e) * 264 + kj] = (bf16_t)(vw[e] & 0xffffu); VTl[(cp * 8 + 2 * e + 1) * 264 + kj] = (bf16_t)(vw[e] >> 16); } }
    LDS_BAR();
    {
        const float sink = p.sinks[l * 8 + hq];
#pragma unroll
        for (int qp2 = 0; qp2 < 2; ++qp2) {
            const int qi0 = (wave & 1) * 64 + 32 * qp2;
            const size_t qrow = (size_t)b * T + n * 128 + qi0;
            int kp_lo = (qi0 + 1) >> 5, kp_hi = (qi0 + 16 + 143) >> 5; if (kp_hi > 7) kp_hi = 7; if (n == 0 && kp_lo < 4) kp_lo = 4;
            attn_pair16<64, 256, true>(cols + qrow * NC + C_SWQ + hq * 64, cols + (qrow + 16) * NC + C_SWQ + hq * 64, Qf[2 * qp2], Qf[2 * qp2 + 1], Zf[2 * qp2], Zf[2 * qp2 + 1], Kl, VTl, kp_lo, kp_hi, 0.125f, sink, 1.f, qi0, qi0 + 16, n == 0, lane);
        }
    }
    LDS_BAR();
}

__device__ __forceinline__ void xmem_unit(const Params& p, int l, int unit, LAS unsigned char* lds) {
    int tid_ = threadIdx.x; asm volatile("" : "+v"(tid_));
    const int tid = tid_, lane = tid & 63, wave = tid >> 6;
    const int qb = unit & 7, hm = (unit >> 3) & 3, b = unit >> 5;
    unsigned char* ws = p.ws; bf16_t* cols = (bf16_t*)(ws + WS_COLS);
    const bf16_t* mkv = (const bf16_t*)(ws + WS_MEMKV) + (size_t)b * 256 * 1024;
    LAS bf16_t* Kl = (LAS bf16_t*)lds;
    LAS bf16_t* VTl = Kl + 256 * 136;
    bf16x8 Qf[2][4]; u32x2 Zf[2][8];
#pragma unroll
    for (int qt = 0; qt < 2; ++qt) { const size_t qrow = (size_t)b * T + qb * 256 + 32 * wave + 16 * qt + (lane & 15);
#pragma unroll
        for (int kd = 0; kd < 4; ++kd) Qf[qt][kd] = *(const bf16x8*)(cols + qrow * NC + C_XMQ + hm * 128 + 32 * kd + 8 * (lane >> 4));
#pragma unroll
        for (int dt = 0; dt < 8; ++dt) Zf[qt][dt] = *(const u32x2*)(cols + qrow * NC + C_XMZ + hm * 128 + 16 * dt + 4 * (lane >> 4)); }
#pragma unroll
    for (int it = 0; it < 8; ++it) { const int pc = tid + 512 * it, kj = pc >> 4, cp = pc & 15;
        const bf16_t* rp = mkv + (size_t)kj * 1024 + hm * 128 + cp * 8;
        const u32x4 kv = *(const u32x4*)rp, vv = *(const u32x4*)(rp + 512);
        *(LAS u32x4*)(Kl + kj * 136 + cp * 8) = kv;
        const unsigned vw[4] = {vv.x, vv.y, vv.z, vv.w};
#pragma unroll
        for (int e = 0; e < 4; ++e) { VTl[(cp * 8 + 2 * e) * 264 + kj] = (bf16_t)(vw[e] & 0xffffu); VTl[(cp * 8 + 2 * e + 1) * 264 + kj] = (bf16_t)(vw[e] >> 16); } }
    LDS_BAR();
    { const size_t qrow = (size_t)b * T + qb * 256 + 32 * wave;
      attn_pair16<128, 256, false>(cols + qrow * NC + C_XMQ + hm * 128, cols + (qrow + 16) * NC + C_XMQ + hm * 128, Qf[0], Qf[1], Zf[0], Zf[1], Kl, VTl, 0, 7, 0.08838834764831845f, -1e30f, 0.f, 0, 0, false, lane); }
    LDS_BAR();
}

#define XB_TMO      128
#define XB_XCNT(j)  (256  + 64 * (j))
#define XB_XSUB(j)  (1280 + 64 * (j))
#define XB_XGEN(j)  (2304 + 64 * (j))
#define XB_TOP      3328
#define XB_TOPGEN   3392
#define XCD_BAR_WORDS 3456
#define XB_SPIN_CAP (1u << 18)

__device__ __forceinline__ unsigned xb_ld(unsigned* p)              { return __hip_atomic_load(p, __ATOMIC_RELAXED, __HIP_MEMORY_SCOPE_AGENT); }
__device__ __forceinline__ unsigned xb_add(unsigned* p, unsigned v) { return __hip_atomic_fetch_add(p, v, __ATOMIC_RELAXED, __HIP_MEMORY_SCOPE_AGENT); }
__device__ __forceinline__ unsigned xb_xcc_id() { return (unsigned)__builtin_amdgcn_s_getreg((3 << 11) | 20) & 0xFu; }
#define XB_SPIN(cond, bar) do { unsigned _sp = 0; while (cond) { __builtin_amdgcn_s_sleep(1); \
    if ((++_sp & 255u) == 0u) { if (xb_ld(&(bar)[XB_TMO])) break; if (_sp > XB_SPIN_CAP) { atomicAdd(&(bar)[XB_TMO], 1u); break; } } } } while (0)

struct XcdBarrier {
    unsigned* bar; unsigned x;
    volatile LAS unsigned* st;
};

__device__ __forceinline__ XcdBarrier xcd_barrier_post(unsigned* bar, volatile LAS unsigned* st) {
    XcdBarrier b; b.bar = bar; b.x = xb_xcc_id(); b.st = st;
    if (threadIdx.x == 0) (void)xb_add(&bar[XB_XCNT(b.x)], 1u);
    return b;
}
__device__ __forceinline__ void xcd_barrier_complete(unsigned* bar, unsigned x, unsigned& nloc, unsigned& nx) {
    const unsigned G = gridDim.x * gridDim.y * gridDim.z;
    unsigned sum, cnt, mine, sp = 0u;
    for (;;) {
        sum = 0u; cnt = 0u; mine = 0u;
#pragma unroll
        for (unsigned j = 0; j < 16; ++j) { const unsigned c = xb_ld(&bar[XB_XCNT(j)]); sum += c; cnt += (c > 0u) ? 1u : 0u; mine = (j == x) ? c : mine; }
        if (sum == G) break;
        __builtin_amdgcn_s_sleep(1);
        if ((++sp & 255u) == 0u) { if (xb_ld(&bar[XB_TMO])) break; if (sp > XB_SPIN_CAP) { atomicAdd(&bar[XB_TMO], 1u); break; } }
    }
    nloc = mine > 0u ? mine : 1u; nx = cnt > 0u ? cnt : 1u;
}

__device__ __forceinline__ void xcd_barrier(const XcdBarrier& b) {
    asm volatile("s_waitcnt vmcnt(0)" ::: "memory");
    __syncthreads();
    if (threadIdx.x == 0) {
        unsigned* bar = b.bar;
        __builtin_amdgcn_s_waitcnt(0);
        unsigned nloc = b.st[0], nx = b.st[1];
        if (nloc == 0u) { xcd_barrier_complete(bar, b.x, nloc, nx); b.st[0] = nloc; b.st[1] = nx; }
        const unsigned old = xb_add(&bar[XB_XSUB(b.x)], 1u);
        const unsigned gen = old / nloc;
        if (old + 1u == (gen + 1u) * nloc) {
            __builtin_amdgcn_fence(__ATOMIC_RELEASE, "agent");
            asm volatile("s_waitcnt vmcnt(0)" ::: "memory");
            const unsigned og = xb_add(&bar[XB_TOP], 1u);
            const unsigned tg = og / nx;
            if (og + 1u == (tg + 1u) * nx) xb_add(&bar[XB_TOPGEN], 1u);
            else XB_SPIN(xb_ld(&bar[XB_TOPGEN]) == tg, bar);
            __builtin_amdgcn_fence(__ATOMIC_ACQUIRE, "agent");
            xb_add(&bar[XB_XGEN(b.x)], 1u);
            asm volatile("s_waitcnt vmcnt(0)" ::: "memory");
        } else {
            XB_SPIN(xb_ld(&bar[XB_XGEN(b.x)]) == gen, bar);
            __builtin_amdgcn_fence(__ATOMIC_ACQUIRE, "agent");
            asm volatile("s_waitcnt vmcnt(0)" ::: "memory");
        }
    }
    __syncthreads();
}


__global__ void __launch_bounds__(512) mega_fwd(Params p) {
    extern __shared__ __attribute__((aligned(16))) unsigned char lds_raw[];
    LAS unsigned char* lds = (LAS unsigned char*)lds_raw;
    const int G = gridDim.x, bx = blockIdx.x;
    const int vcu = (G % 8 == 0) ? (bx % 8) * (G / 8) + bx / 8 : bx;
    const Epi E{p.ws};
    unsigned* barw = (unsigned*)p.ws + 4096;
    volatile LAS unsigned* bst = (volatile LAS unsigned*)(lds + LDS_BYTES - 16);
    if (threadIdx.x == 0) { bst[0] = 0u; bst[1] = 0u; }
    __syncthreads();
    XcdBarrier bar = xcd_barrier_post(barw, bst);
#ifdef TSTAMP
    int nst = 0;
#define STAMP() do { if (bx == 0 && threadIdx.x == 0) ((unsigned long long*)p.ws)[nst] = __builtin_amdgcn_s_memrealtime(); ++nst; } while (0)
#else
#define STAMP() do {} while (0)
#endif
#define GRID_BAR() do { xcd_barrier(bar); STAMP(); } while (0)
    STAMP();
#pragma unroll 1
    for (int l = 0; l < 2; ++l) {
        p0_stage(p, l, lds);
        GRID_BAR();
#ifndef PROBE_REP
#define PROBE_REP 0
#endif
        for (int rep = 0; rep < ((PROBE_REP == 1 || PROBE_REP == 2) ? 2 : 1); ++rep) {
        { SchedA S{p.ws, G, bx}; pg8::gemm_phase<Epi, SchedA>(lds, S, E); }
        GRID_BAR();
        if (PROBE_REP == 1 && rep == 0) continue;
        for (int u = bx; u < 1024; u += G) delta_pre_unit(p, l, u, lds);
        GRID_BAR();
        if (G >= 64) {
            if (bx < 32) delta_scan_unit(p, l, bx, lds);
            else for (int u = bx - 32; u < 1024; u += G - 32) { if (u < 256) swa_unit(p, l, u, lds); else if (u < 512) xmem_unit(p, l, u - 256, lds); else gmlp_unit(p, l, u - 512, lds); }
        } else {
            for (int u = bx; u < 32 + 1024; u += G) { if (u < 32) delta_scan_unit(p, l, u, lds); else if (u < 288) swa_unit(p, l, u - 32, lds); else if (u < 544) xmem_unit(p, l, u - 288, lds); else gmlp_unit(p, l, u - 544, lds); }
        }
        GRID_BAR();
        }
        for (int rep = 0; rep < ((PROBE_REP == 3 || PROBE_REP == 4) ? 2 : 1); ++rep) {
        { SchedD S{p.ws, G, vcu}; pg8::gemm_phase<Epi, SchedD>(lds, S, E); }
        GRID_BAR();
        if (PROBE_REP == 3 && rep == 0) continue;
        { SchedE S{p.ws, G, vcu}; pg8::gemm_phase<Epi, SchedE>(lds, S, E); }
        GRID_BAR();
        }
    }
    p0_stage(p, 2, lds);
#ifdef TSTAMP
    __syncthreads();
    if (bx == 0 && threadIdx.x == 0) { const unsigned long long* st = (const unsigned long long*)p.ws; const float us = (float)(st[TS_B] - st[TS_A]) * 0.01f; p.out[0] += us * TS_SCALE; }
#endif
}

extern "C" void kernel_launch(void* const* d_in, const int* in_sizes, int n_in, void* d_out, int out_size, void* d_ws, size_t ws_size, hipStream_t stream) {
    static int grid = 0;
    if (grid == 0) {
        if (n_in != 17 || out_size != M * D || ws_size < WS_END) { fprintf(stderr, "kernel_launch: unexpected shapes / workspace (%d inputs, out %d, ws %zu)\n", n_in, out_size, ws_size); grid = -1; return; }
        int dev = 0, cus = 0, per_cu = 0;
        hipGetDevice(&dev);
        hipDeviceGetAttribute(&cus, hipDeviceAttributeMultiprocessorCount, dev);
        hipFuncSetAttribute((const void*)mega_fwd, hipFuncAttributeMaxDynamicSharedMemorySize, LDS_BYTES);
        hipOccupancyMaxActiveBlocksPerMultiprocessor(&per_cu, (const void*)mega_fwd, 512, LDS_BYTES);
        if (per_cu < 1) { fprintf(stderr, "kernel_launch: occupancy query reports %d blocks per CU\n", per_cu); (void)hipGetLastError(); per_cu = 1; }
        grid = cus * 1;
    }
    if (grid < 0) return;
    Params p{};
    p.x = (const float*)d_in[0]; p.mem = (const float*)d_in[1]; p.norm_pre = (const float*)d_in[2]; p.norm_post = (const float*)d_in[3]; p.norm_mem = (const float*)d_in[4];
    p.w_in = (const float*)d_in[5]; p.conv_w = (const float*)d_in[6]; p.a_log = (const float*)d_in[7]; p.dt_bias = (const float*)d_in[8]; p.dn_norm = (const float*)d_in[9];
    p.gm_norm = (const float*)d_in[10]; p.spatial_w = (const float*)d_in[11]; p.spatial_b = (const float*)d_in[12]; p.sinks = (const float*)d_in[13];
    p.w_mem_kv = (const float*)d_in[14]; p.w_up = (const float*)d_in[15]; p.w_out = (const float*)d_in[16];
    p.out = (float*)d_out; p.ws = (unsigned char*)d_ws;
    if (hipMemsetAsync((char*)d_ws + 16384, 0, XCD_BAR_WORDS * 4, stream) != hipSuccess) { fprintf(stderr, "kernel_launch: memset of the barrier words failed\n"); return; }
    void* args[] = {&p};
    hipError_t e = hipLaunchCooperativeKernel((const void*)mega_fwd, dim3(grid), dim3(512), args, LDS_BYTES, stream);
    if (e != hipSuccess) fprintf(stderr, "cooperative launch failed: %s (grid %d)\n", hipGetErrorString(e), grid);
}
```

```cpp
#include <hip/hip_runtime.h>
#include <hip/hip_cooperative_groups.h>
#include <cstdio>
#include <cstdint>
namespace cg = cooperative_groups;

#define LAS __attribute__((address_space(3)))
typedef unsigned short bf16_t;
typedef short bf16x8 __attribute__((ext_vector_type(8)));
typedef float f32x4 __attribute__((ext_vector_type(4)));
typedef unsigned u32x4 __attribute__((ext_vector_type(4)));
typedef unsigned u32x2 __attribute__((ext_vector_type(2)));

constexpr int NB = 8, T = 2048, M = NB * T, D = 1024, NC = 5888, DIN = 9992;
constexpr int C_DNQ = 0, C_DNK = 512, C_DNV = 1024, C_DNZ = 1536, C_GMU = 2048, C_GMV = 2560, C_GMZ = 3072, C_SWQ = 3584, C_SWK = 4096, C_SWV = 4224,
              C_SWZ = 4352, C_XMQ = 4864, C_XMZ = 5376;
constexpr float EPS = 1e-6f;
constexpr size_t MiB = 1u << 20;
constexpr size_t WS_WINT = 1 * MiB, WS_WGT = WS_WINT + 12058624, WS_WUPT = WS_WGT + 8 * MiB, WS_WOUTT = WS_WUPT + 4 * MiB, WS_WMKVT = WS_WOUTT + 2 * MiB,
                 WS_SPW = WS_WMKVT + 2 * MiB;
constexpr size_t WS_H = 29 * MiB, WS_COLS = 61 * MiB, WS_OUT = WS_COLS, WS_X = 245 * MiB;
constexpr size_t WS_WA_W = WS_X, WS_WA_A = WS_X + 16 * MiB, WS_HALO = WS_X + 24 * MiB, WS_SM = WS_X + 27 * MiB, WS_DL = WS_SM + 512 * 1024,
                 WS_MEMN = WS_X + 28 * MiB, WS_MEMKV = WS_X + 32 * MiB, WS_GSCR = WS_X, WS_MERGED = WS_X + 32 * MiB, WS_END = 309 * MiB;
constexpr int LDS_BYTES = 155648;

struct Params {
    const float *x, *mem, *norm_pre, *norm_post, *norm_mem, *w_in, *conv_w, *a_log, *dt_bias, *dn_norm, *gm_norm, *spatial_w, *spatial_b, *sinks, *w_mem_kv,
        *w_up, *w_out;
    float* out;
    unsigned char* ws;
};

__device__ __forceinline__ unsigned f2bf(float f) { unsigned u = __float_as_uint(f); return (u + 0x7fffu + ((u >> 16) & 1u)) >> 16; }
__device__ __forceinline__ float bf2f(unsigned b) { return __uint_as_float(b << 16); }
typedef float f32x2_t __attribute__((ext_vector_type(2)));
typedef __bf16 bf16x2_t __attribute__((ext_vector_type(2)));
__device__ __forceinline__ unsigned cvt_pk_bf16(float lo, float hi) { const f32x2_t v = {lo, hi}; return __builtin_bit_cast(unsigned, __builtin_convertvector(v, bf16x2_t)); }
__device__ __forceinline__ float lo_bf(unsigned w) { return __uint_as_float(w << 16); }
__device__ __forceinline__ float hi_bf(unsigned w) { return __uint_as_float(w & 0xffff0000u); }
__device__ __forceinline__ float wave_sum(float v) {
#pragma unroll
    for (int o = 1; o < 64; o <<= 1) v += __shfl_xor(v, o);
    return v;
}
__device__ __forceinline__ float silu_f(float y) { return y * __builtin_amdgcn_rcpf(1.f + __expf(-y)); }
__device__ __forceinline__ float sigmoid_f(float y) { return __builtin_amdgcn_rcpf(1.f + __expf(-y)); }
__device__ __forceinline__ float gelu_tanh_f(float x) {
    const float u = 0.7978845608f * (x + 0.044715f * x * x * x);
    return x * __builtin_amdgcn_rcpf(1.f + __expf(-2.f * u));
}
__device__ __forceinline__ float silu_fast(float y) { return y * __builtin_amdgcn_rcpf(1.f + __expf(-y)); }
__device__ __forceinline__ float sigmoid_fast(float y) { return __builtin_amdgcn_rcpf(1.f + __expf(-y)); }
__device__ __forceinline__ float gelu_fast(float x) { const float u = 0.7978845608f * (x + 0.044715f * x * x * x); return x * __builtin_amdgcn_rcpf(1.f + __expf(-2.f * u)); }
__device__ __forceinline__ bf16x8 pack8(const f32x4 a, const f32x4 b) {
    u32x4 w; w.x = cvt_pk_bf16(a[0], a[1]); w.y = cvt_pk_bf16(a[2], a[3]); w.z = cvt_pk_bf16(b[0], b[1]); w.w = cvt_pk_bf16(b[2], b[3]);
    return __builtin_bit_cast(bf16x8, w);
}
__device__ __forceinline__ bf16x8 lds_ld2x8(const LAS unsigned char* pl) {
    const u32x2 lo = *(const LAS u32x2*)pl, hi = *(const LAS u32x2*)(pl + 32);
    u32x4 w; w.x = lo.x; w.y = lo.y; w.z = hi.x; w.w = hi.y; return __builtin_bit_cast(bf16x8, w);
}
#define LDS_BAR() asm volatile("s_waitcnt lgkmcnt(0)\n\ts_barrier" ::: "memory")
__device__ __forceinline__ int kperm32(int o) { return (o < 16) ? (8 * (o >> 2) + (o & 3)) : (8 * ((o - 16) >> 2) + 4 + (o & 3)); }
#define MFMA16(a, b, c) __builtin_amdgcn_mfma_f32_16x16x32_bf16((a), (b), (c), 0, 0, 0)

namespace pg8 {
constexpr int BM = 256, BK = 64, HALF = 128, HTB = HALF * BK * 2, STAGE_BYTES = 8 * HTB;
__device__ __forceinline__ int lds_byte(int r, int c) { const int st = (r >> 4) * 2 + (c >> 5), rr = r & 15, cc = c & 31, ob = rr * 64 + cc * 2; return st * 1024 + (ob ^ (((ob >> 9) & 1) << 5)); }
__device__ __forceinline__ void stage_rc(int b, int& R, int& C) { const int st = b / 1024, sb = b % 1024, swz = sb ^ (((sb >> 9) & 1) << 5); R = (st >> 1) * 16 + swz / 64; C = (st & 1) * 32 + (swz % 64) / 2; }
__device__ __forceinline__ int perm32(int rho) { const int n = rho >> 4, i = rho & 15; return 8 * (i >> 2) + 4 * n + (i & 3); }

struct Unit { const char* a; const char* b; unsigned lda, ldb; int nt; int pm, pn, kind, sub; };

__device__ __forceinline__ void mkoff(const Unit& u, int tid, unsigned (&vA)[2], unsigned (&vB)[2]) {
#pragma unroll
    for (int i = 0; i < 2; ++i) { int R, C; stage_rc(tid * 16 + i * 8192, R, C); const int Rb = (R & ~31) + perm32(R & 31);
        vA[i] = (unsigned)(R * u.lda + C) * 2u; vB[i] = (unsigned)(Rb * u.ldb + C) * 2u; }
}

template <class Epi, class Sched>
__device__ __forceinline__ void gemm_phase(LAS unsigned char* lds, const Sched& S, const Epi& E) {
    int tid_ = threadIdx.x; asm volatile("" : "+v"(tid_));
    const int tid = tid_, wid = __builtin_amdgcn_readfirstlane(tid >> 6), lane = tid & 63, wr = wid >> 2, wc = wid & 3, fr = lane & 15, fq = lane >> 4;
    const size_t kstep = (size_t)(BK * 2);
    const unsigned ldsw = (unsigned)wid * 1024u;
    const int aoff = lds_byte(wr * 64 + fr, fq * 8), boff = lds_byte(wc * 32 + fr, fq * 8);
#define PG8_SA(b, h) (((b) * 2 + (h)) * HTB)
#define PG8_SB(b, h) ((4 + (b) * 2 + (h)) * HTB)
#define PG8_STAGE(bufoff, gbase, voff) do { _Pragma("unroll") for (int _i = 0; _i < 2; ++_i) \
        __builtin_amdgcn_global_load_lds((const unsigned*)((const char*)(gbase) + (voff)[_i]), (LAS unsigned*)(lds + (bufoff) + ldsw + _i * 8192), 16, 0, 0); } while (0)
#define PG8_LDA(dst, b, h) do { _Pragma("unroll") for (int m = 0; m < 4; ++m) _Pragma("unroll") for (int k = 0; k < 2; ++k) dst[m][k] = *(const LAS bf16x8*)(lds + PG8_SA(b, h) + aoff + m * 2048 + k * 1024); } while (0)
#define PG8_LDB(dst, b, h) do { _Pragma("unroll") for (int n = 0; n < 2; ++n) _Pragma("unroll") for (int k = 0; k < 2; ++k) dst[n][k] = *(const LAS bf16x8*)(lds + PG8_SB(b, h) + boff + n * 2048 + k * 1024); } while (0)
#define PG8_MMA(ai, bj, At, Bt) do { __builtin_amdgcn_s_setprio(1); _Pragma("unroll") for (int m = 0; m < 4; ++m) _Pragma("unroll") for (int n = 0; n < 2; ++n) _Pragma("unroll") for (int k = 0; k < 2; ++k) \
        acc[ai][bj][m][n] = __builtin_amdgcn_mfma_f32_16x16x32_bf16(Bt[n][k], At[m][k], acc[ai][bj][m][n], 0, 0, 0); __builtin_amdgcn_s_setprio(0); } while (0)
#define PG8_WAIT_V(n) asm volatile("s_waitcnt vmcnt(" #n ")" ::: "memory")
#define PG8_WAIT_L(n) asm volatile("s_waitcnt lgkmcnt(" #n ")" ::: "memory")
#define PG8_BAR __builtin_amdgcn_s_barrier()
#define PG8_SCHED __builtin_amdgcn_sched_barrier(0)
    Unit cur, nxt; int ui = 0;
    if (!S.next(0, cur)) return;
    f32x4 acc[2][2][4][2];
#pragma unroll
    for (int a = 0; a < 2; ++a)
#pragma unroll
        for (int b = 0; b < 2; ++b)
#pragma unroll
            for (int m = 0; m < 4; ++m)
#pragma unroll
                for (int n = 0; n < 2; ++n) acc[a][b][m][n] = (f32x4){0.f, 0.f, 0.f, 0.f};
    bf16x8 At[4][2], B0[2][2], B1[2][2];
    unsigned vAc[2], vBc[2], vAn[2], vBn[2];
    mkoff(cur, tid, vAc, vBc);
    const char* cA = cur.a; const char* cB = cur.b;
    size_t hAc = (size_t)HALF * cur.lda * 2, hBc = (size_t)HALF * cur.ldb * 2;
    PG8_STAGE(PG8_SB(0, 0), cB, vBc); PG8_STAGE(PG8_SB(0, 1), cB + hBc, vBc); PG8_STAGE(PG8_SA(0, 0), cA, vAc); PG8_STAGE(PG8_SA(0, 1), cA + hAc, vAc);
    if (wr == 1) PG8_BAR;
    PG8_WAIT_V(2); PG8_BAR;
    PG8_STAGE(PG8_SB(1, 0), cB + kstep, vBc); PG8_STAGE(PG8_SA(1, 0), cA + kstep, vAc); PG8_STAGE(PG8_SB(1, 1), cB + hBc + kstep, vBc);
    PG8_WAIT_V(6); PG8_BAR;
    for (;;) {
        const bool has_next = S.next(ui + 1, nxt);
        const char* nA = cA; const char* nB = cB; size_t hAn = hAc, hBn = hBc;
        vAn[0] = vAc[0]; vAn[1] = vAc[1]; vBn[0] = vBc[0]; vBn[1] = vBc[1];
        if (has_next) { nA = nxt.a; nB = nxt.b; mkoff(nxt, tid, vAn, vBn); hAn = (size_t)HALF * nxt.lda * 2; hBn = (size_t)HALF * nxt.ldb * 2; }
        const int nt = cur.nt;
        for (int t = 0; t < nt; t += 2) {
            const bool last = (t == nt - 2);
            const char* a1 = cA + (size_t)(t + 1) * kstep;
            const char* a2 = last ? nA : cA + (size_t)(t + 2) * kstep; const char* b2 = last ? nB : cB + (size_t)(t + 2) * kstep;
            const char* a3 = a2 + kstep; const char* b3 = b2 + kstep;
            unsigned vA2[2], vB2[2];
            vA2[0] = last ? vAn[0] : vAc[0]; vA2[1] = last ? vAn[1] : vAc[1]; vB2[0] = last ? vBn[0] : vBc[0]; vB2[1] = last ? vBn[1] : vBc[1];
            const size_t hA2 = last ? hAn : hAc, hB2 = last ? hBn : hBc;
            PG8_LDB(B0, 0, 0); PG8_LDB(B1, 0, 1); PG8_SCHED; PG8_LDA(At, 0, 0); PG8_STAGE(PG8_SA(1, 1), a1 + hAc, vAc);
            PG8_WAIT_V(8); PG8_WAIT_L(0); PG8_BAR; PG8_MMA(0, 0, At, B0); PG8_MMA(0, 1, At, B1); PG8_BAR; PG8_SCHED;
            PG8_LDA(At, 0, 1); PG8_STAGE(PG8_SB(0, 0), b2, vB2); PG8_STAGE(PG8_SB(0, 1), b2 + hB2, vB2); PG8_STAGE(PG8_SA(0, 0), a2, vA2);
            PG8_WAIT_V(8); PG8_WAIT_L(0); PG8_BAR; PG8_MMA(1, 0, At, B0); PG8_MMA(1, 1, At, B1); PG8_BAR; PG8_SCHED;
            PG8_LDB(B0, 1, 0); PG8_LDB(B1, 1, 1); PG8_SCHED; PG8_LDA(At, 1, 0); PG8_STAGE(PG8_SA(0, 1), a2 + hA2, vA2);
            PG8_WAIT_V(8); PG8_WAIT_L(0); PG8_BAR; PG8_MMA(0, 0, At, B0); PG8_MMA(0, 1, At, B1); PG8_BAR; PG8_SCHED;
            PG8_LDA(At, 1, 1); PG8_STAGE(PG8_SB(1, 0), b3, vB2); PG8_STAGE(PG8_SB(1, 1), b3 + hB2, vB2); PG8_STAGE(PG8_SA(1, 0), a3, vA2);
            PG8_WAIT_V(8); PG8_WAIT_L(0); PG8_BAR; PG8_MMA(1, 0, At, B0); PG8_MMA(1, 1, At, B1); PG8_BAR; PG8_SCHED;
        }
        if (wr == 0) PG8_BAR;
        E(acc, cur, wr, wc, fr, fq, tid);
        if (!has_next) break;
#pragma unroll
        for (int a = 0; a < 2; ++a)
#pragma unroll
            for (int b = 0; b < 2; ++b)
#pragma unroll
                for (int m = 0; m < 4; ++m)
#pragma unroll
                    for (int n = 0; n < 2; ++n) acc[a][b][m][n] = (f32x4){0.f, 0.f, 0.f, 0.f};
        cur = nxt; cA = nA; cB = nB; hAc = hAn; hBc = hBn; vAc[0] = vAn[0]; vAc[1] = vAn[1]; vBc[0] = vBn[0]; vBc[1] = vBn[1]; ++ui;
        if (wr == 1) PG8_BAR;
    }
    PG8_WAIT_V(0);
    PG8_BAR;
#undef PG8_SA
#undef PG8_SB
#undef PG8_STAGE
#undef PG8_LDA
#undef PG8_LDB
#undef PG8_MMA
#undef PG8_WAIT_V
#undef PG8_WAIT_L
#undef PG8_BAR
#undef PG8_SCHED
}
}
using pg8::Unit;

struct Epi {
    unsigned char* ws;
    __device__ __forceinline__ void operator()(const f32x4 (&acc)[2][2][4][2], const Unit& u, int wr, int wc, int fr, int fq, int tid) const {
        asm volatile("" : "+v"(tid), "+v"(fr), "+v"(fq));
        const int row0 = u.pm * 256 + wr * 64 + fr, col0 = u.pn * 256 + wc * 32 + 8 * fq;
        if (u.kind == 0) {
            bf16_t* cols = (bf16_t*)(ws + WS_COLS); bf16_t* halo = (bf16_t*)(ws + WS_HALO);
            const int pn = u.pn;
            const int act = (pn == 6 || pn == 7 || pn == 12 || pn == 13 || pn == 17 || pn == 18 || pn >= 21) ? 1 : ((pn >= 8 && pn <= 11) ? 2 : 0);
#pragma unroll
            for (int ai = 0; ai < 2; ++ai)
#pragma unroll
                for (int m = 0; m < 4; ++m) {
                    const int r = row0 + ai * 128 + m * 16;
                    bf16_t* rowp = cols + (size_t)r * NC + col0;
#pragma unroll
                    for (int bj = 0; bj < 2; ++bj) {
                        f32x4 v0 = acc[ai][bj][m][0], v1 = acc[ai][bj][m][1];
                        if (act == 1) {
#pragma unroll
                            for (int e = 0; e < 4; ++e) { v0[e] = silu_fast(v0[e]); v1[e] = silu_fast(v1[e]); }
                        } else if (act == 2) {
#pragma unroll
                            for (int e = 0; e < 4; ++e) { v0[e] = gelu_fast(v0[e]); v1[e] = gelu_fast(v1[e]); }
                        }
                        u32x4 w; w.x = cvt_pk_bf16(v0[0], v0[1]); w.y = cvt_pk_bf16(v0[2], v0[3]); w.z = cvt_pk_bf16(v1[0], v1[1]); w.w = cvt_pk_bf16(v1[2], v1[3]);
                        *(u32x4*)(rowp + bj * 128) = w;
                        if (pn < 6 && (r & 63) >= 61) *(u32x4*)(halo + ((size_t)(r >> 6) * 3 + ((r & 63) - 61)) * 1536 + col0 + bj * 128) = w;
                    }
                }
        } else if (u.kind == 1) {
            bf16_t* o = (bf16_t*)(ws + WS_MEMKV);
#pragma unroll
            for (int ai = 0; ai < 2; ++ai)
#pragma unroll
                for (int m = 0; m < 4; ++m) {
                    bf16_t* rowp = o + (size_t)(row0 + ai * 128 + m * 16) * 1024 + col0;
#pragma unroll
                    for (int bj = 0; bj < 2; ++bj) {
                        const f32x4 v0 = acc[ai][bj][m][0], v1 = acc[ai][bj][m][1];
                        u32x4 w; w.x = cvt_pk_bf16(v0[0], v0[1]); w.y = cvt_pk_bf16(v0[2], v0[3]); w.z = cvt_pk_bf16(v1[0], v1[1]); w.w = cvt_pk_bf16(v1[2], v1[3]);
                        *(u32x4*)(rowp + bj * 128) = w;
                    }
                }
        } else if (u.kind == 2) {
            u32x4* g = (u32x4*)(ws + WS_GSCR) + (size_t)(u.pm * 4 + u.pn) * 16 * 512 + tid;
#pragma unroll
            for (int ai = 0; ai < 2; ++ai)
#pragma unroll
                for (int m = 0; m < 4; ++m)
#pragma unroll
                    for (int bj = 0; bj < 2; ++bj) {
                        const f32x4 v0 = acc[ai][bj][m][0], v1 = acc[ai][bj][m][1];
                        u32x4 w; w.x = cvt_pk_bf16(v0[0], v0[1]); w.y = cvt_pk_bf16(v0[2], v0[3]);
                        w.z = cvt_pk_bf16(v1[0], v1[1]); w.w = cvt_pk_bf16(v1[2], v1[3]);
                        g[(size_t)((ai * 4 + m) * 2 + bj) * 512] = w;
                    }
        } else if (u.kind == 3) {
            const unsigned char* gb = ws + WS_GSCR + (size_t)(u.pm * 4 + u.pn) * 16 * 512 * 16;
            unsigned char* mb = ws + WS_MERGED + (size_t)u.pm * 256 * 2048 + (size_t)u.pn * 512;
            const unsigned gvo = (unsigned)tid * 16u, mvo = (unsigned)((wr * 64 + fr) * 2048 + (wc * 32 + 8 * fq) * 2);
            u32x4 gwn[2];
            gwn[0] = *(const u32x4*)(gb + gvo); gwn[1] = *(const u32x4*)(gb + 8192 + gvo);
#pragma unroll
            for (int sp = 0; sp < 8; ++sp) {
                const int ai = sp >> 2, m = sp & 3;
                u32x4 gw[2], pw[2];
                gw[0] = gwn[0]; gw[1] = gwn[1];
#pragma unroll
                for (int k = 0; k < 2; ++k) { pw[k] = (u32x4){0u, 0u, 0u, 0u};
                    if (u.sub > 0) pw[k] = *(const u32x4*)(mb + (size_t)(ai * 128 + m * 16) * 2048 + k * 256 + mvo); }
                if (sp + 1 < 8) { gwn[0] = *(const u32x4*)(gb + (size_t)(2 * (sp + 1)) * 8192 + gvo); gwn[1] = *(const u32x4*)(gb + (size_t)(2 * (sp + 1) + 1) * 8192 + gvo); }
#pragma unroll
                for (int k = 0; k < 2; ++k) { const int bj = k;
                    const f32x4 v0 = acc[ai][bj][m][0], v1 = acc[ai][bj][m][1];
                    const float r0 = sigmoid_fast(lo_bf(gw[k].x)) * v0[0] + lo_bf(pw[k].x), r1 = sigmoid_fast(hi_bf(gw[k].x)) * v0[1] + hi_bf(pw[k].x), r2 = sigmoid_fast(lo_bf(gw[k].y)) * v0[2] + lo_bf(pw[k].y), r3 = sigmoid_fast(hi_bf(gw[k].y)) * v0[3] + hi_bf(pw[k].y);
                    const float r4 = sigmoid_fast(lo_bf(gw[k].z)) * v1[0] + lo_bf(pw[k].z), r5 = sigmoid_fast(hi_bf(gw[k].z)) * v1[1] + hi_bf(pw[k].z), r6 = sigmoid_fast(lo_bf(gw[k].w)) * v1[2] + lo_bf(pw[k].w), r7 = sigmoid_fast(hi_bf(gw[k].w)) * v1[3] + hi_bf(pw[k].w);
                    u32x4 w; w.x = cvt_pk_bf16(r0, r1); w.y = cvt_pk_bf16(r2, r3); w.z = cvt_pk_bf16(r4, r5); w.w = cvt_pk_bf16(r6, r7);
                    *(u32x4*)(mb + (size_t)(ai * 128 + m * 16) * 2048 + bj * 256 + mvo) = w; }
                asm volatile("" ::: "memory");
            }
        } else {
            bf16_t* o = (bf16_t*)(ws + WS_OUT);
#pragma unroll
            for (int ai = 0; ai < 2; ++ai)
#pragma unroll
                for (int m = 0; m < 4; ++m) {
                    bf16_t* rowp = o + (size_t)(row0 + ai * 128 + m * 16) * 1024 + col0;
#pragma unroll
                    for (int bj = 0; bj < 2; ++bj) { const f32x4 v0 = acc[ai][bj][m][0], v1 = acc[ai][bj][m][1];
                        u32x4 w; w.x = cvt_pk_bf16(v0[0], v0[1]); w.y = cvt_pk_bf16(v0[2], v0[3]); w.z = cvt_pk_bf16(v1[0], v1[1]); w.w = cvt_pk_bf16(v1[2], v1[3]);
                        *(u32x4*)(rowp + bj * 128) = w; }
                }
        }
    }
};

struct SchedA {
    const unsigned char* ws; int G, c;
    __device__ __forceinline__ bool next(int i, Unit& u) const {
        const int L = i * G + c;
        constexpr int nN = 23, nwg = 64 * nN;
        if (L < nwg) {
            int wgid = L; { const int q = nwg / 8, xcd = wgid % 8, off = wgid / 8; wgid = xcd * q + off; }
            const int nig = 8 * nN, gid = wgid / nig, fm = gid * 8;
            u.pm = fm + ((wgid % nig) % 8); u.pn = (wgid % nig) / 8; u.kind = 0; u.sub = 0; u.lda = 1024; u.ldb = 1024; u.nt = 16;
            u.a = (const char*)(ws + WS_H) + (size_t)u.pm * 256 * 1024 * 2; u.b = (const char*)(ws + WS_WINT) + (size_t)u.pn * 256 * 1024 * 2;
            return true;
        }
        const int r = L - nwg; if (r >= 32) return false;
        u.pm = r >> 2; u.pn = r & 3; u.kind = 1; u.sub = 0; u.lda = 1024; u.ldb = 1024; u.nt = 16;
        u.a = (const char*)(ws + WS_MEMN) + (size_t)u.pm * 256 * 1024 * 2; u.b = (const char*)(ws + WS_WMKVT) + (size_t)u.pn * 256 * 1024 * 2;
        return true;
    }
};
struct SchedD {
    const unsigned char* ws; int G, vcu;
    __device__ __forceinline__ bool next(int i, Unit& u) const {
        const int tile = vcu + (i >> 3) * G; if (tile >= 256) return false;
        const int sub = i & 7, n = sub >> 1;
        u.pm = tile >> 2; u.pn = tile & 3; u.sub = n;
        if ((sub & 1) == 0) { u.kind = 2; u.lda = 1024; u.ldb = 1024; u.nt = 16;
            u.a = (const char*)(ws + WS_H) + (size_t)u.pm * 256 * 1024 * 2; u.b = (const char*)(ws + WS_WGT) + (size_t)(n * 1024 + u.pn * 256) * 1024 * 2;
        } else { u.kind = 3; u.lda = NC; u.ldb = 512; u.nt = 8;
            const int yoff = n == 0 ? C_DNZ : (n == 1 ? C_GMU : (n == 2 ? C_SWQ : C_XMQ));
            u.a = (const char*)(ws + WS_COLS) + ((size_t)u.pm * 256 * NC + yoff) * 2; u.b = (const char*)(ws + WS_WUPT) + (size_t)(n * 1024 + u.pn * 256) * 512 * 2; }
        return true;
    }
};
struct SchedE {
    const unsigned char* ws; int G, vcu;
    __device__ __forceinline__ bool next(int i, Unit& u) const {
        const int tile = vcu + i * G; if (tile >= 256) return false;
        u.pm = tile >> 2; u.pn = tile & 3; u.kind = 4; u.sub = 0; u.lda = 1024; u.ldb = 1024; u.nt = 16;
        u.a = (const char*)(ws + WS_MERGED) + (size_t)u.pm * 256 * 1024 * 2; u.b = (const char*)(ws + WS_WOUTT) + (size_t)u.pn * 256 * 1024 * 2;
        return true;
    }
};

__device__ __forceinline__ void tr_item(const float* W, int ldw, int k0, bf16_t* WT, int Kdst, LAS float* scr, int lane) {
    float tv[32];
#pragma unroll
    for (int i = 0; i < 32; ++i) tv[i] = __builtin_nontemporal_load(&W[(size_t)(k0 + 2 * i + (lane >> 5)) * ldw + (lane & 31)]);
#pragma unroll
    for (int i = 0; i < 32; ++i) scr[(2 * i + (lane >> 5)) * 33 + (lane & 31)] = tv[i];
    asm volatile("s_waitcnt lgkmcnt(0)" ::: "memory");
    const int c = lane & 7;
#pragma unroll
    for (int j = 0; j < 4; ++j) { const int n = (lane >> 3) + 8 * j; const LAS float* s = scr + (8 * c) * 33 + n;
        u32x4 o; o.x = cvt_pk_bf16(s[0 * 33], s[1 * 33]); o.y = cvt_pk_bf16(s[2 * 33], s[3 * 33]); o.z = cvt_pk_bf16(s[4 * 33], s[5 * 33]); o.w = cvt_pk_bf16(s[6 * 33], s[7 * 33]);
        *(u32x4*)(WT + (size_t)n * Kdst + k0 + 8 * c) = o; }
    asm volatile("s_waitcnt lgkmcnt(0)" ::: "memory");
}

__device__ __forceinline__ void p0_stage(const Params& p, int rk, LAS unsigned char* lds) {
    int tid_ = threadIdx.x; asm volatile("" : "+v"(tid_));
    const int tid = tid_, lane = tid & 63, wave = tid >> 6;
    const int gw = blockIdx.x * 8 + wave, NGW = gridDim.x * 8;
    unsigned char* ws = p.ws;
    LAS float* W8T = (LAS float*)(lds + 8 * 8448);
    if (rk <= 1) {
        const int l = rk;
        const float* win = p.w_in + (size_t)l * 1024 * DIN;
        {   f32x4 wv[4];
#pragma unroll
            for (int t2 = 0; t2 < 2; ++t2) { const float* wp = win + (size_t)(tid + 512 * t2) * DIN + 2048; wv[2 * t2] = *(const f32x4*)wp; wv[2 * t2 + 1] = *(const f32x4*)(wp + 4); }
#pragma unroll
            for (int t2 = 0; t2 < 2; ++t2)
#pragma unroll
                for (int j = 0; j < 8; ++j) W8T[j * 1024 + tid + 512 * t2] = wv[2 * t2 + (j >> 2)][j & 3]; }
        LAS float* scr = (LAS float*)(lds + wave * 8448);
        for (int it = gw; it < 7040; it += NGW) {
            if (it < 2944) { const int kb = it / 184, nb = it % 184, n0 = 32 * nb, sc = n0 < 2048 ? n0 : n0 + 8;
                tr_item(win + sc, DIN, 64 * kb, (bf16_t*)(ws + WS_WINT) + (size_t)n0 * 1024, 1024, scr, lane);
            } else if (it < 4992) { const int r = it - 2944, kb = r / 128, nb = r % 128;
                tr_item(win + 5896 + 32 * nb, DIN, 64 * kb, (bf16_t*)(ws + WS_WGT) + (size_t)(32 * nb) * 1024, 1024, scr, lane);
            } else if (it < 6016) { const int r = it - 4992, n = r / 256, r2 = r % 256, kb = r2 / 32, nb = r2 % 32;
                tr_item(p.w_up + (size_t)(l * 4 + n) * 512 * 1024 + 32 * nb, 1024, 64 * kb, (bf16_t*)(ws + WS_WUPT) + (size_t)(n * 1024 + 32 * nb) * 512, 512, scr, lane);
            } else if (it < 6528) { const int r = it - 6016, kb = r / 32, nb = r % 32;
                tr_item(p.w_out + (size_t)l * 1024 * 1024 + 32 * nb, 1024, 64 * kb, (bf16_t*)(ws + WS_WOUTT) + (size_t)(32 * nb) * 1024, 1024, scr, lane);
            } else { const int r = it - 6528, kb = r / 32, nb = r % 32;
                tr_item(p.w_mem_kv + (size_t)l * 1024 * 1024 + 32 * nb, 1024, 64 * kb, (bf16_t*)(ws + WS_WMKVT) + (size_t)(32 * nb) * 1024, 1024, scr, lane);
            }
        }
        for (int e = blockIdx.x * 512 + tid; e < 65536; e += gridDim.x * 512) { const int pp = (e >> 7) & 127, qq = e & 127;
            ((bf16_t*)(ws + WS_SPW))[e] = (bf16_t)(qq <= pp ? f2bf(p.spatial_w[(size_t)l * 65536 + e]) : 0u); }
        for (int r = gw; r < 2048; r += NGW) {
            const f32x4* xr = (const f32x4*)(p.mem + (size_t)r * D) + lane; const f32x4* gr = (const f32x4*)(p.norm_mem + l * D) + lane;
            f32x4 v[4]; float ss = 0.f;
#pragma unroll
            for (int j = 0; j < 4; ++j) { v[j] = __builtin_nontemporal_load(&xr[64 * j]); ss += v[j][0] * v[j][0] + v[j][1] * v[j][1] + v[j][2] * v[j][2] + v[j][3] * v[j][3]; }
            const float rstd = rsqrtf(wave_sum(ss) * (1.f / D) + EPS);
            u32x2* o = (u32x2*)((bf16_t*)(ws + WS_MEMN) + (size_t)r * D) + lane;
#pragma unroll
            for (int j = 0; j < 4; ++j) { const f32x4 g = gr[64 * j]; u32x2 w; w.x = cvt_pk_bf16(v[j][0] * rstd * g[0], v[j][1] * rstd * g[1]); w.y = cvt_pk_bf16(v[j][2] * rstd * g[2], v[j][3] * rstd * g[3]); o[64 * j] = w; }
        }
    }
    __syncthreads();
    const float* xin = rk == 2 ? p.out : p.x;
    for (int row0 = gw; row0 < M; row0 += 2 * NGW) {
        f32x4 v[2][4], o[2][4];
#pragma unroll
        for (int rr = 0; rr < 2; ++rr) { const int row = row0 + rr * NGW;
            const f32x4* xr = (const f32x4*)(xin + (size_t)row * D) + lane;
#pragma unroll
            for (int j = 0; j < 4; ++j) v[rr][j] = __builtin_nontemporal_load(&xr[64 * j]);
            if (rk >= 1) { const u32x2* orow = (const u32x2*)((const bf16_t*)(ws + WS_OUT) + (size_t)row * D) + lane;
#pragma unroll
                for (int j = 0; j < 4; ++j) { const u32x2 ow = __builtin_nontemporal_load(&orow[64 * j]); o[rr][j] = (f32x4){lo_bf(ow.x), hi_bf(ow.x), lo_bf(ow.y), hi_bf(ow.y)}; } } }
        if (rk >= 1) {
            const f32x4* gr = (const f32x4*)(p.norm_post + (rk - 1) * D) + lane;
            float ss[2] = {0.f, 0.f};
#pragma unroll
            for (int rr = 0; rr < 2; ++rr)
#pragma unroll
                for (int j = 0; j < 4; ++j) ss[rr] += o[rr][j][0] * o[rr][j][0] + o[rr][j][1] * o[rr][j][1] + o[rr][j][2] * o[rr][j][2] + o[rr][j][3] * o[rr][j][3];
#pragma unroll
            for (int of = 1; of < 64; of <<= 1) { ss[0] += __shfl_xor(ss[0], of); ss[1] += __shfl_xor(ss[1], of); }
#pragma unroll
            for (int rr = 0; rr < 2; ++rr) { const float rstd = rsqrtf(ss[rr] * (1.f / D) + EPS);
                f32x4* dst = (f32x4*)(p.out + (size_t)(row0 + rr * NGW) * D) + lane;
#pragma unroll
                for (int j = 0; j < 4; ++j) { const f32x4 g = gr[64 * j]; v[rr][j] = v[rr][j] + o[rr][j] * rstd * g; if (rk == 2) __builtin_nontemporal_store(v[rr][j], &dst[64 * j]); else dst[64 * j] = v[rr][j]; } }
        }
        if (rk <= 1) {
            const f32x4* gr = (const f32x4*)(p.norm_pre + rk * D) + lane;
            float ss[2] = {0.f, 0.f};
#pragma unroll
            for (int rr = 0; rr < 2; ++rr)
#pragma unroll
                for (int j = 0; j < 4; ++j) ss[rr] += v[rr][j][0] * v[rr][j][0] + v[rr][j][1] * v[rr][j][1] + v[rr][j][2] * v[rr][j][2] + v[rr][j][3] * v[rr][j][3];
#pragma unroll
            for (int of = 1; of < 64; of <<= 1) { ss[0] += __shfl_xor(ss[0], of); ss[1] += __shfl_xor(ss[1], of); }
            LAS float* red = (LAS float*)(lds + 8 * 8448 + 32768) + wave * 1024;
#pragma unroll
            for (int rr = 0; rr < 2; ++rr) { const float rstd = rsqrtf(ss[rr] * (1.f / D) + EPS);
                u32x2* oh = (u32x2*)((bf16_t*)(ws + WS_H) + (size_t)(row0 + rr * NGW) * D) + lane;
#pragma unroll
                for (int j = 0; j < 4; ++j) { const f32x4 g = gr[64 * j]; v[rr][j] = v[rr][j] * rstd * g; u32x2 w; w.x = cvt_pk_bf16(v[rr][j][0], v[rr][j][1]); w.y = cvt_pk_bf16(v[rr][j][2], v[rr][j][3]); oh[64 * j] = w; }
#pragma unroll
                for (int jj = 0; jj < 8; ++jj) { float a = 0.f;
#pragma unroll
                    for (int j = 0; j < 4; ++j) { const f32x4 w = *(const LAS f32x4*)(W8T + jj * 1024 + 256 * j + 4 * lane); a += v[rr][j][0] * w[0] + v[rr][j][1] * w[1] + v[rr][j][2] * w[2] + v[rr][j][3] * w[3]; }
                    red[rr * 512 + jj * 64 + lane] = a; } }
            asm volatile("s_waitcnt lgkmcnt(0)" ::: "memory");
#pragma unroll
            for (int rr = 0; rr < 2; ++rr) { const f32x4 r0 = *(const LAS f32x4*)(red + rr * 512 + lane * 8), r1 = *(const LAS f32x4*)(red + rr * 512 + lane * 8 + 4);
                float a = (r0[0] + r0[1]) + (r0[2] + r0[3]) + (r1[0] + r1[1]) + (r1[2] + r1[3]);
                a += __shfl_xor(a, 1); a += __shfl_xor(a, 2); a += __shfl_xor(a, 4);
                if ((lane & 7) == 0) ((float*)(ws + WS_SM) + (size_t)(row0 + rr * NGW) * 8)[lane >> 3] = a; }
            asm volatile("s_waitcnt lgkmcnt(0)" ::: "memory");
        }
    }
    __syncthreads();
}

__device__ __forceinline__ void delta_pre_unit(const Params& p, int l, int unit, LAS unsigned char* lds) {
    int tid_ = threadIdx.x; asm volatile("" : "+v"(tid_));
    const int tid = tid_, lane = tid & 63, wave = tid >> 6;
    const int h = unit & 3, gch = unit >> 2, c = gch & 31;
    const size_t row0 = (size_t)gch * 64;
    unsigned char* ws = p.ws;
    bf16_t* cols = (bf16_t*)(ws + WS_COLS);
    LAS float* Qf = (LAS float*)lds; LAS float* Kf = Qf + 64 * 129; LAS float* Vf = Kf + 64 * 129; LAS float* Lf = Vf + 64 * 129;
    LAS bf16_t* Qb = (LAS bf16_t*)(Lf + 64 * 68); LAS bf16_t* Kb = Qb + 64 * 136;
    LAS float* gcs = (LAS float*)(lds + 154112); LAS float* betas = gcs + 64; LAS float* facs = betas + 64;
    LAS bf16_t* Rw = (LAS bf16_t*)Lf;
    {
#pragma unroll
        for (int it = 0; it < 6; ++it) { const int pc = tid + 512 * it, r = pc / 48, rem = pc % 48, part = rem >> 4, cp = rem & 15;
            const u32x4 v = *(const u32x4*)(cols + (row0 + r) * NC + part * 512 + h * 128 + cp * 8);
            *(LAS u32x4*)(Rw + (r + 3) * 384 + part * 128 + cp * 8) = v; }
        if (tid < 144) { const int r = tid / 48, rem = tid % 48, part = rem >> 4, cp = rem & 15;
            u32x4 v = {0u, 0u, 0u, 0u};
            if (c > 0) v = *(const u32x4*)((const bf16_t*)(ws + WS_HALO) + ((size_t)(gch - 1) * 3 + r) * 1536 + part * 512 + h * 128 + cp * 8);
            *(LAS u32x4*)(Rw + r * 384 + part * 128 + cp * 8) = v; }
        if (wave == 6) {
            const float* sm = (const float*)(ws + WS_SM) + (row0 + lane) * 8;
            const float a = sm[4 + h] + p.dt_bias[l * 4 + h];
            const float sp = a > 20.f ? a : __logf(1.f + __expf(a));
            float g = -__expf(p.a_log[l * 4 + h]) * sp;
#pragma unroll
            for (int o = 1; o < 64; o <<= 1) { const float t = __shfl_up(g, o); if (lane >= o) g += t; }
            gcs[lane] = g;
        } else if (wave == 7) {
            const float* sm = (const float*)(ws + WS_SM) + (row0 + lane) * 8;
            betas[lane] = sigmoid_f(sm[h]);
        }
    }
    LDS_BAR();
    if (tid < 384) {
        const int quad = tid % 96, seg = tid / 96, c4 = 4 * quad, part = c4 >> 7, cc = c4 & 127;
        const float* cw = p.conv_w + (size_t)l * 4 * 1536 + part * 512 + h * 128 + cc;
        const f32x4 w0 = *(const f32x4*)cw, w1 = *(const f32x4*)(cw + 1536), w2 = *(const f32x4*)(cw + 2 * 1536), w3 = *(const f32x4*)(cw + 3 * 1536);
        const LAS bf16_t* src = Rw + (16 * seg) * 384 + c4;
        u32x2 rv[19];
#pragma unroll
        for (int r = 0; r < 19; ++r) rv[r] = *(const LAS u32x2*)(src + r * 384);
        LAS float* dst = (part == 0 ? Qf : (part == 1 ? Kf : Vf)) + (16 * seg) * 129 + cc;
#pragma unroll
        for (int r = 0; r < 16; ++r) {
            const u32x2 a3 = rv[r], a2 = rv[r + 1], a1 = rv[r + 2], a0 = rv[r + 3];
            const float y0 = w0[0] * lo_bf(a3.x) + w1[0] * lo_bf(a2.x) + w2[0] * lo_bf(a1.x) + w3[0] * lo_bf(a0.x);
            const float y1 = w0[1] * hi_bf(a3.x) + w1[1] * hi_bf(a2.x) + w2[1] * hi_bf(a1.x) + w3[1] * hi_bf(a0.x);
            const float y2 = w0[2] * lo_bf(a3.y) + w1[2] * lo_bf(a2.y) + w2[2] * lo_bf(a1.y) + w3[2] * lo_bf(a0.y);
            const float y3 = w0[3] * hi_bf(a3.y) + w1[3] * hi_bf(a2.y) + w2[3] * hi_bf(a1.y) + w3[3] * hi_bf(a0.y);
            dst[r * 129 + 0] = silu_f(y0); dst[r * 129 + 1] = silu_f(y1); dst[r * 129 + 2] = silu_f(y2); dst[r * 129 + 3] = silu_f(y3);
        }
    }
    LDS_BAR();
    if (tid < 64) { facs[tid] = betas[tid]; facs[64 + tid] = betas[tid] * __expf(gcs[tid]); }
    {
        const int r = tid >> 3, sub = tid & 7; float sq = 0.f, sk = 0.f;
#pragma unroll
        for (int e = 0; e < 16; ++e) { const float a = Qf[r * 129 + sub * 16 + e]; sq += a * a; const float b = Kf[r * 129 + sub * 16 + e]; sk += b * b; }
        sq += __shfl_xor(sq, 1); sq += __shfl_xor(sq, 2); sq += __shfl_xor(sq, 4);
        sk += __shfl_xor(sk, 1); sk += __shfl_xor(sk, 2); sk += __shfl_xor(sk, 4);
        const float rq = rsqrtf(sq + EPS) * 0.08838834764831845f, rkk = rsqrtf(sk + EPS);
#pragma unroll
        for (int e = 0; e < 16; ++e) { const int o = sub * 16 + e; const float a = Qf[r * 129 + o] * rq; Qb[r * 136 + o] = (bf16_t)f2bf(a);
            const float b = Kf[r * 129 + o] * rkk; Kf[r * 129 + o] = b; Kb[r * 136 + o] = (bf16_t)f2bf(b); }
    }
    LDS_BAR();
    LAS bf16_t* Al = (LAS bf16_t*)Qf;
    LAS float* Db = Qf;
    LAS bf16_t* Lb = (LAS bf16_t*)(lds + 16640);
    LAS bf16_t* XT = Qb;
    LAS bf16_t* Wl = (LAS bf16_t*)Vf;
    {
        const int i = lane & 15, q = lane >> 4;
#pragma unroll
        for (int jb = 0; jb < 4; ++jb) { const int job = wave + 8 * jb;
            const int kind = job >> 4, ct = (job >> 2) & 3, st = job & 3;
            f32x4 acc = {0.f, 0.f, 0.f, 0.f};
            if (st <= ct) {
                const LAS bf16_t* Ab = kind == 0 ? Kb : Qb;
#pragma unroll
                for (int ks = 0; ks < 4; ++ks) { const bf16x8 a = *(const LAS bf16x8*)(Ab + (16 * ct + i) * 136 + 32 * ks + 8 * q); const bf16x8 b = *(const LAS bf16x8*)(Kb + (16 * st + i) * 136 + 32 * ks + 8 * q);
                    acc = MFMA16(a, b, acc); }
            }
            const int s = 16 * st + i; const float gs = gcs[s];
#pragma unroll
            for (int r = 0; r < 4; ++r) { const int cr = 16 * ct + 4 * q + r; const float e = __expf(fminf(gcs[cr] - gs, 0.f));
                if (kind == 0) { const float v = (cr > s) ? acc[r] * betas[cr] * e : 0.f; Lf[cr * 68 + s] = v; Lb[cr * 72 + s] = (bf16_t)f2bf(v); }
                else Al[cr * 72 + (s & ~31) + kperm32(s & 31)] = (bf16_t)f2bf(cr >= s ? acc[r] * e : 0.f); }
        }
    }
    LDS_BAR();
    {
        *(u32x4*)(ws + WS_WA_A + (size_t)unit * 8192 + tid * 16) = *(const LAS u32x4*)(Al + (tid >> 3) * 72 + (tid & 7) * 8);
        { const int cr = tid >> 3, d0 = (tid & 7) * 16; const float e = __expf(gcs[cr]);
            bf16_t* dst = cols + (row0 + cr) * NC + C_DNQ + h * 128 + d0;
#pragma unroll
            for (int g4 = 0; g4 < 2; ++g4) { const u32x4 v = *(const LAS u32x4*)(Qb + cr * 136 + d0 + 8 * g4); u32x4 w;
                w.x = cvt_pk_bf16(lo_bf(v.x) * e, hi_bf(v.x) * e); w.y = cvt_pk_bf16(lo_bf(v.y) * e, hi_bf(v.y) * e); w.z = cvt_pk_bf16(lo_bf(v.z) * e, hi_bf(v.z) * e); w.w = cvt_pk_bf16(lo_bf(v.w) * e, hi_bf(v.w) * e);
                const int o0 = (d0 + 8 * g4) & 31, gb = (d0 + 8 * g4) & ~31;
                *(u32x2*)(dst - d0 + gb + kperm32(o0)) = (u32x2){w.x, w.y}; *(u32x2*)(dst - d0 + gb + kperm32(o0 + 4)) = (u32x2){w.z, w.w}; } }
        { const int dk = tid & 127, c0 = (tid >> 7) * 16; const float gl = gcs[63];
            bf16_t* dst = cols + (row0 + (dk >> 1)) * NC + C_DNK + h * 128 + (dk & 1) * 64 + c0;
#pragma unroll
            for (int g4 = 0; g4 < 2; ++g4) { float v[8];
#pragma unroll
                for (int e = 0; e < 8; ++e) { const int cr = c0 + 8 * g4 + e; v[e] = Kf[cr * 129 + dk] * __expf(gl - gcs[cr]); }
                u32x4 w; w.x = cvt_pk_bf16(v[0], v[1]); w.y = cvt_pk_bf16(v[2], v[3]); w.z = cvt_pk_bf16(v[4], v[5]); w.w = cvt_pk_bf16(v[6], v[7]);
                const int cc0 = c0 + 8 * g4, gb = cc0 & ~31, o0 = cc0 & 31;
                *(u32x2*)(dst - c0 + gb + kperm32(o0)) = (u32x2){w.x, w.y}; *(u32x2*)(dst - c0 + gb + kperm32(o0 + 4)) = (u32x2){w.z, w.w}; } }
        if (tid == 0) ((float*)(ws + WS_DL))[unit] = __expf(gcs[63]);
    }
    LDS_BAR();
    for (int e = tid; e < 2304; e += 512) ((LAS u32x4*)XT)[e] = (u32x4){0u, 0u, 0u, 0u};
    LDS_BAR();
    {
        const int j = tid & 255; const bool isv = j < 128; const int jj = j & 127;
        const LAS float* src = (isv ? Vf : Kf) + jj;
        const LAS float* fac = facs + (isv ? 0 : 64);
        const int i16 = lane & 15, q = lane >> 4;
        float x[64];
#pragma unroll
        for (int bb = 0; bb < 4; ++bb) {
            if (bb > 0) {
#pragma unroll
                for (int tt = 0; tt < 2; ++tt) { const int ct = 2 * wave + tt; f32x4 acc = {0.f, 0.f, 0.f, 0.f};
#pragma unroll
                    for (int ks = 0; ks < 2; ++ks) if (32 * ks < 16 * bb) acc = MFMA16(*(const LAS bf16x8*)(Lb + (16 * bb + i16) * 72 + 32 * ks + 8 * q), *(const LAS bf16x8*)(XT + (16 * ct + i16) * 72 + 32 * ks + 8 * q), acc);
#pragma unroll
                    for (int r = 0; r < 4; ++r) Db[(4 * q + r) * 260 + 16 * ct + i16] = acc[r]; }
                LDS_BAR();
            }
            if (tid < 256) {
                int Lr[16]; float rh[16];
#pragma unroll
                for (int i = 0; i < 16; ++i) { const int row = 16 * bb + i;
                    Lr[i] = __float_as_int(Lf[row * 68 + 16 * bb + i16]);
                    rh[i] = src[row * 129] * fac[row] - (bb > 0 ? Db[i * 260 + j] : 0.f); }
#pragma unroll
                for (int i = 0; i < 16; ++i) { const int row = 16 * bb + i;
                    float sa[4] = {rh[i], 0.f, 0.f, 0.f};
#pragma unroll
                    for (int jx = 0; jx < i; ++jx) sa[jx & 3] -= __int_as_float(__builtin_amdgcn_readlane(Lr[i], jx)) * x[16 * bb + jx];
                    x[row] = (sa[0] + sa[1]) + (sa[2] + sa[3]); }
                u32x4 w0, w1;
                w0.x = cvt_pk_bf16(x[16 * bb + 0], x[16 * bb + 1]); w0.y = cvt_pk_bf16(x[16 * bb + 2], x[16 * bb + 3]); w0.z = cvt_pk_bf16(x[16 * bb + 4], x[16 * bb + 5]); w0.w = cvt_pk_bf16(x[16 * bb + 6], x[16 * bb + 7]);
                w1.x = cvt_pk_bf16(x[16 * bb + 8], x[16 * bb + 9]); w1.y = cvt_pk_bf16(x[16 * bb + 10], x[16 * bb + 11]); w1.z = cvt_pk_bf16(x[16 * bb + 12], x[16 * bb + 13]); w1.w = cvt_pk_bf16(x[16 * bb + 14], x[16 * bb + 15]);
                *(LAS u32x4*)(XT + j * 72 + 16 * bb) = w0; *(LAS u32x4*)(XT + j * 72 + 16 * bb + 8) = w1;
            }
            LDS_BAR();
        }
#pragma unroll
        for (int it = 0; it < 2; ++it) { const int pc = tid + 512 * it, dv = pc >> 3, cp = pc & 7;
            *(u32x4*)(cols + (row0 + (dv >> 1)) * NC + C_DNV + h * 128 + (dv & 1) * 64 + cp * 8) = *(const LAS u32x4*)(XT + dv * 72 + cp * 8); }
        if (tid >= 128 && tid < 256) {
#pragma unroll
            for (int i = 0; i < 64; ++i) Wl[i * 136 + (jj & ~31) + kperm32(jj & 31)] = (bf16_t)f2bf(x[i]); }
    }
    LDS_BAR();
    {   unsigned char* wo = ws + WS_WA_W + (size_t)unit * 16384;
#pragma unroll
        for (int it = 0; it < 2; ++it) { const int pc = tid + 512 * it; *(u32x4*)(wo + pc * 16) = *(const LAS u32x4*)(Wl + (pc >> 4) * 136 + (pc & 15) * 8); }
    }
    LDS_BAR();
}

__device__ __forceinline__ void delta_scan_unit(const Params& p, int l, int bh, LAS unsigned char* lds) {
    int tid_ = threadIdx.x; asm volatile("" : "+v"(tid_));
    const int tid = tid_, lane = tid & 63, wave = tid >> 6, i = lane & 15, q = lane >> 4;
    const int b = bh >> 2, h = bh & 3;
    unsigned char* ws = p.ws;
    unsigned char* colsb = ws + WS_COLS;
    constexpr int BUFB = 62464, O_W = 0, O_QG = 17408, O_KD = 34816, O_A = 53248;
    LAS bf16_t* Ot = (LAS bf16_t*)(lds + 2 * BUFB);
    if (wave < 4) {
        __builtin_amdgcn_s_setprio(3);
        f32x4 S[2][8];
#pragma unroll
        for (int s2 = 0; s2 < 2; ++s2)
#pragma unroll
            for (int t = 0; t < 8; ++t) S[s2][t] = (f32x4){0.f, 0.f, 0.f, 0.f};
        u32x2 uraw[2][4]; float dl;
        const float dlv = ((const float*)(ws + WS_DL))[(b * 32 + (lane & 31)) * 4 + h];
#define SCAN_ULOAD(cidx, dstu, dstd) do { const int gch_ = b * 32 + (cidx); const size_t r0_ = (size_t)gch_ * 64; \
            _Pragma("unroll") for (int s2 = 0; s2 < 2; ++s2) { const int dv_ = 32 * wave + 16 * s2 + i; \
                const unsigned char* ub_ = colsb + ((r0_ + (dv_ >> 1)) * NC + C_DNV + h * 128 + (dv_ & 1) * 64 + 4 * q) * 2; \
                _Pragma("unroll") for (int mt = 0; mt < 4; ++mt) dstu[s2][mt] = *(const u32x2*)(ub_ + mt * 32); } } while (0)
#define SCAN_LD16(pp) (*(const LAS bf16x8*)(pp))
#define SCAN_FRAG(f) ( (f) < 16 ? SCAN_LD16(buf + O_W + (16 * ((f) >> 2) + i) * 272 + (32 * ((f) & 3) + 8 * q) * 2) \
                     : (f) < 32 ? SCAN_LD16(buf + O_QG + (16 * (((f) - 16) >> 2) + i) * 272 + (32 * (((f) - 16) & 3) + 8 * q) * 2) \
                     : (f) < 38 ? SCAN_LD16(buf + O_A + (16 * ((f) == 32 ? 0 : (f) == 33 ? 1 : (f) <= 35 ? 2 : 3) + i) * 144 + (32 * (((f) == 35 || (f) == 37) ? 1 : 0) + 8 * q) * 2) \
                     : SCAN_LD16(buf + O_KD + (16 * (((f) - 38) >> 1) + i) * 144 + (32 * (((f) - 38) & 1) + 8 * q) * 2) )
        SCAN_ULOAD(0, uraw, dl);
        __syncthreads();
#pragma unroll 1
        for (int c = 0; c < 32; ++c) {
            const LAS unsigned char* buf = lds + (c & 1) * BUFB;
            dl = __int_as_float(__builtin_amdgcn_readlane(__float_as_int(dlv), c));
            bf16x8 Sb[2][4];
#pragma unroll
            for (int s2 = 0; s2 < 2; ++s2)
#pragma unroll
                for (int ks = 0; ks < 4; ++ks) Sb[s2][ks] = pack8(S[s2][2 * ks], S[s2][2 * ks + 1]);
            f32x4 aw[2][4], o[2][4];
            bf16x8 Vb[2][2];
            bf16x8 Fq[8];
            constexpr int DEPTH = 6;
            Fq[0] = SCAN_FRAG(0); Fq[1] = SCAN_FRAG(1); Fq[2] = SCAN_FRAG(2); Fq[3] = SCAN_FRAG(3); Fq[4] = SCAN_FRAG(4); Fq[5] = SCAN_FRAG(5);
#define SCAN_STEP(f) { \
                if ((f) + DEPTH < 54) Fq[((f) + DEPTH) & 7] = SCAN_FRAG(((f) + DEPTH < 54 ? (f) + DEPTH : 53)); \
                const bf16x8 A = Fq[(f) & 7]; \
                if ((f) < 16) { constexpr int mt = ((f) >> 2) & 3, ks = (f) & 3; \
                    if (ks == 0) { aw[0][mt] = (f32x4){0.f, 0.f, 0.f, 0.f}; aw[1][mt] = (f32x4){0.f, 0.f, 0.f, 0.f}; } \
                    aw[0][mt] = MFMA16(A, Sb[0][ks], aw[0][mt]); aw[1][mt] = MFMA16(A, Sb[1][ks], aw[1][mt]); \
                } else if ((f) < 32) { constexpr int mt = (((f) - 16) >> 2) & 3, ks = (f) & 3; \
                    if (ks == 0) { o[0][mt] = (f32x4){0.f, 0.f, 0.f, 0.f}; o[1][mt] = (f32x4){0.f, 0.f, 0.f, 0.f}; } \
                    o[0][mt] = MFMA16(A, Sb[0][ks], o[0][mt]); o[1][mt] = MFMA16(A, Sb[1][ks], o[1][mt]); \
                } else if ((f) < 38) { constexpr int mt = (f) == 32 ? 0 : ((f) == 33 ? 1 : ((f) <= 35 ? 2 : 3)), k2 = ((f) == 35 || (f) == 37) ? 1 : 0; \
                    o[0][mt] = MFMA16(A, Vb[0][k2], o[0][mt]); o[1][mt] = MFMA16(A, Vb[1][k2], o[1][mt]); \
                } else { constexpr int t = (((f) - 38) >> 1) & 7, k2 = (f) & 1; \
                    if (k2 == 0) { S[0][t] = S[0][t] * dl; S[1][t] = S[1][t] * dl; } \
                    S[0][t] = MFMA16(A, Vb[0][k2], S[0][t]); S[1][t] = MFMA16(A, Vb[1][k2], S[1][t]); } \
                if ((f) == 19) { \
                    f32x4 vn[2][4]; \
                    _Pragma("unroll") for (int s2 = 0; s2 < 2; ++s2) \
                    _Pragma("unroll") for (int mt = 0; mt < 4; ++mt) vn[s2][mt] = (f32x4){lo_bf(uraw[s2][mt].x) - aw[s2][mt][0], hi_bf(uraw[s2][mt].x) - aw[s2][mt][1], lo_bf(uraw[s2][mt].y) - aw[s2][mt][2], hi_bf(uraw[s2][mt].y) - aw[s2][mt][3]}; \
                    _Pragma("unroll") for (int s2 = 0; s2 < 2; ++s2) { Vb[s2][0] = pack8(vn[s2][0], vn[s2][1]); Vb[s2][1] = pack8(vn[s2][2], vn[s2][3]); } \
                    if (c + 1 < 32) SCAN_ULOAD(c + 1, uraw, dl); \
                } \
                __builtin_amdgcn_sched_barrier(0); }
#define SCAN_STEP6(f) SCAN_STEP(f) SCAN_STEP((f) + 1) SCAN_STEP((f) + 2) SCAN_STEP((f) + 3) SCAN_STEP((f) + 4) SCAN_STEP((f) + 5)
            SCAN_STEP6(0) SCAN_STEP6(6) SCAN_STEP6(12) SCAN_STEP6(18) SCAN_STEP6(24) SCAN_STEP6(30) SCAN_STEP6(36) SCAN_STEP6(42) SCAN_STEP6(48)
#undef SCAN_STEP6
#undef SCAN_STEP
            __syncthreads();
#pragma unroll
            for (int s2 = 0; s2 < 2; ++s2)
#pragma unroll
                for (int mt = 0; mt < 4; ++mt)
#pragma unroll
                    for (int r = 0; r < 4; ++r) Ot[(16 * mt + 4 * q + r) * 136 + 32 * wave + 16 * s2 + i] = (bf16_t)f2bf(o[s2][mt][r]);
            __syncthreads();
        }
#undef SCAN_FRAG
#undef SCAN_LD16
#undef SCAN_ULOAD
        __builtin_amdgcn_s_setprio(0);
        __syncthreads();
    } else {
        const int t2 = tid - 256, fr_ = t2 >> 2, fs_ = t2 & 3;
        float gn[32];
#pragma unroll
        for (int e = 0; e < 32; ++e) gn[e] = p.dn_norm[l * 128 + fs_ * 32 + e];
        u32x4 pre[14], zc[4], zn[4];
#define SCAN_LOAD(cidx) do { const int gch_ = b * 32 + (cidx); const size_t r0_ = (size_t)gch_ * 64; const int un2_ = gch_ * 4 + h; \
            const unsigned char* wsrc_ = ws + WS_WA_W + (size_t)un2_ * 16384; const unsigned char* asrc_ = ws + WS_WA_A + (size_t)un2_ * 8192; \
            _Pragma("unroll") for (int k = 0; k < 4; ++k) { const int pc_ = t2 + 256 * k; \
                pre[k] = __builtin_nontemporal_load((const u32x4*)(wsrc_ + pc_ * 16)); \
                pre[4 + k] = __builtin_nontemporal_load((const u32x4*)(colsb + ((r0_ + (pc_ >> 4)) * NC + C_DNQ + h * 128) * 2 + (pc_ & 15) * 16)); \
                pre[8 + k] = __builtin_nontemporal_load((const u32x4*)(colsb + ((r0_ + (pc_ >> 4)) * NC + C_DNK + h * 128) * 2 + (pc_ & 15) * 16)); } \
            pre[12] = __builtin_nontemporal_load((const u32x4*)(asrc_ + t2 * 16)); pre[13] = __builtin_nontemporal_load((const u32x4*)(asrc_ + (t2 + 256) * 16)); } while (0)
#define SCAN_ZLOAD(cidx, dst) do { const unsigned char* zb_ = colsb + (((size_t)(b * 32 + (cidx)) * 64 + fr_) * NC + C_DNZ + h * 128 + fs_ * 32) * 2; \
            _Pragma("unroll") for (int k = 0; k < 4; ++k) dst[k] = *(const u32x4*)(zb_ + 16 * k); } while (0)
#define SCAN_STORE(bufp) do { LAS unsigned char* b_ = (bufp); \
            _Pragma("unroll") for (int k = 0; k < 4; ++k) { const int pc_ = t2 + 256 * k; \
                *(LAS u32x4*)(b_ + O_W + (pc_ >> 4) * 272 + (pc_ & 15) * 16) = pre[k]; \
                *(LAS u32x4*)(b_ + O_QG + (pc_ >> 4) * 272 + (pc_ & 15) * 16) = pre[4 + k]; \
                *(LAS u32x4*)(b_ + O_KD + (pc_ >> 3) * 144 + (pc_ & 7) * 16) = pre[8 + k]; } \
            *(LAS u32x4*)(b_ + O_A + (t2 >> 3) * 144 + (t2 & 7) * 16) = pre[12]; *(LAS u32x4*)(b_ + O_A + ((t2 + 256) >> 3) * 144 + (t2 & 7) * 16) = pre[13]; } while (0)
#define SCAN_FINAL(cidx) do { \
            float ss_ = 0.f; u32x4 ov_[4]; \
            _Pragma("unroll") for (int k = 0; k < 4; ++k) { ov_[k] = *(const LAS u32x4*)(Ot + fr_ * 136 + fs_ * 32 + 8 * k); \
                ss_ += lo_bf(ov_[k].x) * lo_bf(ov_[k].x) + hi_bf(ov_[k].x) * hi_bf(ov_[k].x) + lo_bf(ov_[k].y) * lo_bf(ov_[k].y) + hi_bf(ov_[k].y) * hi_bf(ov_[k].y) \
                     + lo_bf(ov_[k].z) * lo_bf(ov_[k].z) + hi_bf(ov_[k].z) * hi_bf(ov_[k].z) + lo_bf(ov_[k].w) * lo_bf(ov_[k].w) + hi_bf(ov_[k].w) * hi_bf(ov_[k].w); } \
            ss_ += __shfl_xor(ss_, 1); ss_ += __shfl_xor(ss_, 2); \
            const float rstd_ = rsqrtf(ss_ * (1.f / 128.f) + EPS); \
            unsigned char* yb_ = colsb + (((size_t)(b * 32 + (cidx)) * 64 + fr_) * NC + C_DNZ + h * 128 + fs_ * 32) * 2; \
            _Pragma("unroll") for (int k = 0; k < 4; ++k) { u32x4 w_; \
                w_.x = cvt_pk_bf16(lo_bf(ov_[k].x) * rstd_ * gn[8 * k + 0] * lo_bf(zc[k].x), hi_bf(ov_[k].x) * rstd_ * gn[8 * k + 1] * hi_bf(zc[k].x)); \
                w_.y = cvt_pk_bf16(lo_bf(ov_[k].y) * rstd_ * gn[8 * k + 2] * lo_bf(zc[k].y), hi_bf(ov_[k].y) * rstd_ * gn[8 * k + 3] * hi_bf(zc[k].y)); \
                w_.z = cvt_pk_bf16(lo_bf(ov_[k].z) * rstd_ * gn[8 * k + 4] * lo_bf(zc[k].z), hi_bf(ov_[k].z) * rstd_ * gn[8 * k + 5] * hi_bf(zc[k].z)); \
                w_.w = cvt_pk_bf16(lo_bf(ov_[k].w) * rstd_ * gn[8 * k + 6] * lo_bf(zc[k].w), hi_bf(ov_[k].w) * rstd_ * gn[8 * k + 7] * hi_bf(zc[k].w)); \
                *(u32x4*)(yb_ + 16 * k) = w_; } } while (0)
        SCAN_LOAD(0); SCAN_STORE(lds);
        __syncthreads();
#pragma unroll 1
        for (int c = 0; c < 32; ++c) {
            if (c + 1 < 32) SCAN_LOAD(c + 1);
            SCAN_ZLOAD(c, zn);
            if (c > 0) SCAN_FINAL(c - 1);
            __syncthreads();
            if (c + 1 < 32) SCAN_STORE(lds + ((c + 1) & 1) * BUFB);
            __syncthreads();
#pragma unroll
            for (int k = 0; k < 4; ++k) zc[k] = zn[k];
        }
        SCAN_FINAL(31);
#undef SCAN_LOAD
#undef SCAN_ZLOAD
#undef SCAN_STORE
#undef SCAN_FINAL
        __syncthreads();
    }
}

__device__ __forceinline__ void gmlp_unit(const Params& p, int l, int unit, LAS unsigned char* lds) {
    int tid_ = threadIdx.x; asm volatile("" : "+v"(tid_));
    const int tid = tid_, lane = tid & 63, wave = tid >> 6, i = lane & 15, q = lane >> 4;
    const int g = unit & 3, bn = unit >> 2;
    const size_t row0 = (size_t)bn * 128;
    unsigned char* ws = p.ws;
    bf16_t* cols = (bf16_t*)(ws + WS_COLS);
    LAS float* rstd = (LAS float*)lds;
    LAS bf16_t* vT = (LAS bf16_t*)(lds + 512);
    {   u32x4 rv[16];
#pragma unroll
        for (int tt = 0; tt < 16; ++tt) rv[tt] = *(const u32x4*)(cols + (row0 + 16 * wave + tt) * NC + C_GMV + lane * 8);
#pragma unroll
        for (int tt = 0; tt < 16; ++tt) { const u32x4 v = rv[tt];
            float ss = lo_bf(v.x) * lo_bf(v.x) + hi_bf(v.x) * hi_bf(v.x) + lo_bf(v.y) * lo_bf(v.y) + hi_bf(v.y) * hi_bf(v.y) + lo_bf(v.z) * lo_bf(v.z) + hi_bf(v.z) * hi_bf(v.z) + lo_bf(v.w) * lo_bf(v.w) + hi_bf(v.w) * hi_bf(v.w);
            ss = wave_sum(ss); if (lane == 0) rstd[16 * wave + tt] = rsqrtf(ss * (1.f / 512.f) + EPS); } }
    LDS_BAR();
#pragma unroll
    for (int it = 0; it < 4; ++it) { const int pc = tid + 512 * it, qrow = pc >> 4, cp = pc & 15;
        const u32x4 v = *(const u32x4*)(cols + (row0 + qrow) * NC + C_GMV + g * 128 + cp * 8);
        const float* gp = p.gm_norm + l * 512 + g * 128 + cp * 8; const float rs = rstd[qrow];
        const float f[8] = {lo_bf(v.x), hi_bf(v.x), lo_bf(v.y), hi_bf(v.y), lo_bf(v.z), hi_bf(v.z), lo_bf(v.w), hi_bf(v.w)};
#pragma unroll
        for (int e = 0; e < 8; ++e) vT[(cp * 8 + e) * 136 + qrow] = (bf16_t)f2bf(f[e] * rs * gp[e]); }
    LDS_BAR();
    {
        const int pt = wave; const int nks = (pt >> 1) + 1;
        const bf16_t* spw = (const bf16_t*)(ws + WS_SPW) + (size_t)g * 16384 + (16 * pt + i) * 128 + 8 * q;
        bf16x8 Bf[4];
#pragma unroll
        for (int ks = 0; ks < 4; ++ks) Bf[ks] = *(const bf16x8*)(spw + 32 * ks);
        const float bias = p.spatial_b[l * 512 + g * 128 + 16 * pt + i];
        const size_t prow = row0 + 16 * pt + i;
        u32x2 uu8[8], zz8[8];
#pragma unroll
        for (int ct = 0; ct < 8; ++ct) { const int ch = g * 128 + 16 * ct + 4 * q; uu8[ct] = *(const u32x2*)(cols + prow * NC + C_GMU + ch); zz8[ct] = *(const u32x2*)(cols + prow * NC + C_GMZ + ch); }
#pragma unroll
        for (int ct = 0; ct < 8; ++ct) { f32x4 acc = {0.f, 0.f, 0.f, 0.f};
#pragma unroll
            for (int ks = 0; ks < 4; ++ks) if (ks < nks) acc = MFMA16(*(const LAS bf16x8*)(vT + (16 * ct + i) * 136 + 32 * ks + 8 * q), Bf[ks], acc);
            const int ch = g * 128 + 16 * ct + 4 * q;
            u32x2* up = (u32x2*)(cols + prow * NC + C_GMU + ch); const u32x2 uu = uu8[ct]; const u32x2 zz = zz8[ct];
            u32x2 w; w.x = cvt_pk_bf16(lo_bf(uu.x) * (acc[0] + bias) * lo_bf(zz.x), hi_bf(uu.x) * (acc[1] + bias) * hi_bf(zz.x));
            w.y = cvt_pk_bf16(lo_bf(uu.y) * (acc[2] + bias) * lo_bf(zz.y), hi_bf(uu.y) * (acc[3] + bias) * hi_bf(zz.y));
            *up = w; }
    }
    LDS_BAR();
}

template <int HD, int NK, bool SWA>
__device__ __forceinline__ void attn_pair16(bf16_t* qpA, bf16_t* qpB, const bf16x8 (&QfA)[HD / 32], const bf16x8 (&QfB)[HD / 32], const u32x2 (&ZfA)[HD / 16], const u32x2 (&ZfB)[HD / 16],
                                            const LAS bf16_t* Kl, const LAS bf16_t* VTl, int kp_lo, int kp_hi, float scale, float m0, float l0, int qi0A, int qi0B, bool blk0, int lane) {
    const int i = lane & 15, q = lane >> 4;
    float m[2] = {m0, m0}, lsum[2] = {l0, l0};
    f32x4 O[2][HD / 16];
#pragma unroll
    for (int t = 0; t < 2; ++t)
#pragma unroll
        for (int dt = 0; dt < HD / 16; ++dt) O[t][dt] = (f32x4){0.f, 0.f, 0.f, 0.f};
    const int qi[2] = {qi0A + i, qi0B + i};
    for (int kp = kp_lo; kp <= kp_hi; ++kp) {
        f32x4 s0[2], s1[2];
#pragma unroll
        for (int t = 0; t < 2; ++t) { s0[t] = (f32x4){0.f, 0.f, 0.f, 0.f}; s1[t] = (f32x4){0.f, 0.f, 0.f, 0.f}; }
#pragma unroll
        for (int kd = 0; kd < HD / 32; ++kd) {
            const bf16x8 k0f = *(const LAS bf16x8*)(Kl + (32 * kp + i) * (HD + 8) + 32 * kd + 8 * q), k1f = *(const LAS bf16x8*)(Kl + (32 * kp + 16 + i) * (HD + 8) + 32 * kd + 8 * q);
            s0[0] = MFMA16(k0f, QfA[kd], s0[0]); s1[0] = MFMA16(k1f, QfA[kd], s1[0]);
            s0[1] = MFMA16(k0f, QfB[kd], s0[1]); s1[1] = MFMA16(k1f, QfB[kd], s1[1]);
        }
        bf16x8 Pb[2]; float alpha[2];
#pragma unroll
        for (int t = 0; t < 2; ++t) {
            float mx = -1e30f;
#pragma unroll
            for (int r = 0; r < 4; ++r) {
                float a = s0[t][r] * scale, b = s1[t][r] * scale;
                if (SWA) { const int k0 = 32 * kp + 4 * q + r, k1 = k0 + 16;
                    if (!(k0 >= qi[t] + 1 && k0 <= qi[t] + 128 && (!blk0 || k0 >= 128))) a = -1e30f;
                    if (!(k1 >= qi[t] + 1 && k1 <= qi[t] + 128 && (!blk0 || k1 >= 128))) b = -1e30f; }
                s0[t][r] = a; s1[t][r] = b; mx = fmaxf(mx, fmaxf(a, b));
            }
            mx = fmaxf(mx, __shfl_xor(mx, 16)); mx = fmaxf(mx, __shfl_xor(mx, 32));
            const float mn = fmaxf(m[t], mx); alpha[t] = __expf(m[t] - mn);
            float ps = 0.f;
#pragma unroll
            for (int r = 0; r < 4; ++r) { s0[t][r] = __expf(s0[t][r] - mn); s1[t][r] = __expf(s1[t][r] - mn); ps += s0[t][r] + s1[t][r]; }
            ps += __shfl_xor(ps, 16); ps += __shfl_xor(ps, 32);
            lsum[t] = lsum[t] * alpha[t] + ps; m[t] = mn;
            Pb[t] = pack8(s0[t], s1[t]);
        }
#pragma unroll
        for (int dt = 0; dt < HD / 16; ++dt) {
            const bf16x8 vf = lds_ld2x8((const LAS unsigned char*)(VTl + (16 * dt + i) * (NK + 8) + 32 * kp + 4 * q));
            O[0][dt] = MFMA16(vf, Pb[0], O[0][dt] * alpha[0]); O[1][dt] = MFMA16(vf, Pb[1], O[1][dt] * alpha[1]); }
    }
#pragma unroll
    for (int t = 0; t < 2; ++t) { const float inv = 1.f / lsum[t]; bf16_t* qp = t == 0 ? qpA : qpB;
#pragma unroll
        for (int dt = 0; dt < HD / 16; ++dt) { const int d = 16 * dt + 4 * q;
            const u32x2 zz = t == 0 ? ZfA[dt] : ZfB[dt];
            u32x2 w; w.x = cvt_pk_bf16(O[t][dt][0] * inv * lo_bf(zz.x), O[t][dt][1] * inv * hi_bf(zz.x)); w.y = cvt_pk_bf16(O[t][dt][2] * inv * lo_bf(zz.y), O[t][dt][3] * inv * hi_bf(zz.y));
            *(u32x2*)(qp + (size_t)i * NC + d) = w; } }
}

__device__ __forceinline__ void swa_unit(const Params& p, int l, int unit, LAS unsigned char* lds) {
    int tid_ = threadIdx.x; asm volatile("" : "+v"(tid_));
    const int tid = tid_, lane = tid & 63, wave = tid >> 6;
    const int kvh = unit & 1, bn = unit >> 1, n = bn & 15, b = bn >> 4;
    unsigned char* ws = p.ws; bf16_t* cols = (bf16_t*)(ws + WS_COLS);
    LAS bf16_t* Kl = (LAS bf16_t*)lds;
    LAS bf16_t* VTl = Kl + 256 * 72;
    const long krow0 = (long)b * T + (long)(n - 1) * 128;
    const int g = wave >> 1, hq = kvh * 4 + g;
    bf16x8 Qf[4][2]; u32x2 Zf[4][4];
#pragma unroll
    for (int qt = 0; qt < 4; ++qt) { const size_t qrow = (size_t)b * T + n * 128 + (wave & 1) * 64 + 16 * qt + (lane & 15);
#pragma unroll
        for (int kd = 0; kd < 2; ++kd) Qf[qt][kd] = *(const bf16x8*)(cols + qrow * NC + C_SWQ + hq * 64 + 32 * kd + 8 * (lane >> 4));
#pragma unroll
        for (int dt = 0; dt < 4; ++dt) Zf[qt][dt] = *(const u32x2*)(cols + qrow * NC + C_SWZ + hq * 64 + 16 * dt + 4 * (lane >> 4)); }
#pragma unroll
    for (int it = 0; it < 4; ++it) { const int pc = tid + 512 * it, kj = pc >> 3, cp = pc & 7;
        u32x4 kv = {0u, 0u, 0u, 0u}, vv = {0u, 0u, 0u, 0u};
        if (n > 0 || kj >= 128) { const bf16_t* rp = cols + (size_t)(krow0 + kj) * NC; kv = *(const u32x4*)(rp + C_SWK + kvh * 64 + cp * 8); vv = *(const u32x4*)(rp + C_SWV + kvh * 64 + cp * 8); }
        *(LAS u32x4*)(Kl + kj * 72 + cp * 8) = kv;
        const unsigned vw[4] = {vv.x, vv.y, vv.z, vv.w};
#pragma unroll
        for (int e = 0; e < 4; ++e) { VTl[(cp * 8 + 2 * e) * 264 + kj] = (bf16_t)(vw[e] & 0xffffu); VTl[(cp * 8 + 2 * e + 1) * 264 + kj] = (bf16_t)(vw[e] >> 16); } }
    LDS_BAR();
    {
        const float sink = p.sinks[l * 8 + hq];
#pragma unroll
        for (int qp2 = 0; qp2 < 2; ++qp2) {
            const int qi0 = (wave & 1) * 64 + 32 * qp2;
            const size_t qrow = (size_t)b * T + n * 128 + qi0;
            int kp_lo = (qi0 + 1) >> 5, kp_hi = (qi0 + 16 + 143) >> 5; if (kp_hi > 7) kp_hi = 7; if (n == 0 && kp_lo < 4) kp_lo = 4;
            attn_pair16<64, 256, true>(cols + qrow * NC + C_SWQ + hq * 64, cols + (qrow + 16) * NC + C_SWQ + hq * 64, Qf[2 * qp2], Qf[2 * qp2 + 1], Zf[2 * qp2], Zf[2 * qp2 + 1], Kl, VTl, kp_lo, kp_hi, 0.125f, sink, 1.f, qi0, qi0 + 16, n == 0, lane);
        }
    }
    LDS_BAR();
}

__device__ __forceinline__ void xmem_unit(const Params& p, int l, int unit, LAS unsigned char* lds) {
    int tid_ = threadIdx.x; asm volatile("" : "+v"(tid_));
    const int tid = tid_, lane = tid & 63, wave = tid >> 6;
    const int qb = unit & 7, hm = (unit >> 3) & 3, b = unit >> 5;
    unsigned char* ws = p.ws; bf16_t* cols = (bf16_t*)(ws + WS_COLS);
    const bf16_t* mkv = (const bf16_t*)(ws + WS_MEMKV) + (size_t)b * 256 * 1024;
    LAS bf16_t* Kl = (LAS bf16_t*)lds;
    LAS bf16_t* VTl = Kl + 256 * 136;
    bf16x8 Qf[2][4]; u32x2 Zf[2][8];
#pragma unroll
    for (int qt = 0; qt < 2; ++qt) { const size_t qrow = (size_t)b * T + qb * 256 + 32 * wave + 16 * qt + (lane & 15);
#pragma unroll
        for (int kd = 0; kd < 4; ++kd) Qf[qt][kd] = *(const bf16x8*)(cols + qrow * NC + C_XMQ + hm * 128 + 32 * kd + 8 * (lane >> 4));
#pragma unroll
        for (int dt = 0; dt < 8; ++dt) Zf[qt][dt] = *(const u32x2*)(cols + qrow * NC + C_XMZ + hm * 128 + 16 * dt + 4 * (lane >> 4)); }
#pragma unroll
    for (int it = 0; it < 8; ++it) { const int pc = tid + 512 * it, kj = pc >> 4, cp = pc & 15;
        const bf16_t* rp = mkv + (size_t)kj * 1024 + hm * 128 + cp * 8;
        const u32x4 kv = *(const u32x4*)rp, vv = *(const u32x4*)(rp + 512);
        *(LAS u32x4*)(Kl + kj * 136 + cp * 8) = kv;
        const unsigned vw[4] = {vv.x, vv.y, vv.z, vv.w};
#pragma unroll
        for (int e = 0; e < 4; ++e) { VTl[(cp * 8 + 2 * e) * 264 + kj] = (bf16_t)(vw[e] & 0xffffu); VTl[(cp * 8 + 2 * e + 1) * 264 + kj] = (bf16_t)(vw[e] >> 16); } }
    LDS_BAR();
    { const size_t qrow = (size_t)b * T + qb * 256 + 32 * wave;
      attn_pair16<128, 256, false>(cols + qrow * NC + C_XMQ + hm * 128, cols + (qrow + 16) * NC + C_XMQ + hm * 128, Qf[0], Qf[1], Zf[0], Zf[1], Kl, VTl, 0, 7, 0.08838834764831845f, -1e30f, 0.f, 0, 0, false, lane); }
    LDS_BAR();
}

#define XB_TMO      128
#define XB_XCNT(j)  (256  + 64 * (j))
#define XB_XSUB(j)  (1280 + 64 * (j))
#define XB_XGEN(j)  (2304 + 64 * (j))
#define XB_TOP      3328
#define XB_TOPGEN   3392
#define XCD_BAR_WORDS 3456
#define XB_SPIN_CAP (1u << 18)

__device__ __forceinline__ unsigned xb_ld(unsigned* p)              { return __hip_atomic_load(p, __ATOMIC_RELAXED, __HIP_MEMORY_SCOPE_AGENT); }
__device__ __forceinline__ unsigned xb_add(unsigned* p, unsigned v) { return __hip_atomic_fetch_add(p, v, __ATOMIC_RELAXED, __HIP_MEMORY_SCOPE_AGENT); }
__device__ __forceinline__ unsigned xb_xcc_id() { return (unsigned)__builtin_amdgcn_s_getreg((3 << 11) | 20) & 0xFu; }
#define XB_SPIN(cond, bar) do { unsigned _sp = 0; while (cond) { __builtin_amdgcn_s_sleep(1); \
    if ((++_sp & 255u) == 0u) { if (xb_ld(&(bar)[XB_TMO])) break; if (_sp > XB_SPIN_CAP) { atomicAdd(&(bar)[XB_TMO], 1u); break; } } } } while (0)

struct XcdBarrier {
    unsigned* bar; unsigned x;
    volatile LAS unsigned* st;
};

__device__ __forceinline__ XcdBarrier xcd_barrier_post(unsigned* bar, volatile LAS unsigned* st) {
    XcdBarrier b; b.bar = bar; b.x = xb_xcc_id(); b.st = st;
    if (threadIdx.x == 0) (void)xb_add(&bar[XB_XCNT(b.x)], 1u);
    return b;
}
__device__ __forceinline__ void xcd_barrier_complete(unsigned* bar, unsigned x, unsigned& nloc, unsigned& nx) {
    const unsigned G = gridDim.x * gridDim.y * gridDim.z;
    unsigned sum, cnt, mine, sp = 0u;
    for (;;) {
        sum = 0u; cnt = 0u; mine = 0u;
#pragma unroll
        for (unsigned j = 0; j < 16; ++j) { const unsigned c = xb_ld(&bar[XB_XCNT(j)]); sum += c; cnt += (c > 0u) ? 1u : 0u; mine = (j == x) ? c : mine; }
        if (sum == G) break;
        __builtin_amdgcn_s_sleep(1);
        if ((++sp & 255u) == 0u) { if (xb_ld(&bar[XB_TMO])) break; if (sp > XB_SPIN_CAP) { atomicAdd(&bar[XB_TMO], 1u); break; } }
    }
    nloc = mine > 0u ? mine : 1u; nx = cnt > 0u ? cnt : 1u;
}

__device__ __forceinline__ void xcd_barrier(const XcdBarrier& b) {
    asm volatile("s_waitcnt vmcnt(0)" ::: "memory");
    __syncthreads();
    if (threadIdx.x == 0) {
        unsigned* bar = b.bar;
        __builtin_amdgcn_s_waitcnt(0);
        unsigned nloc = b.st[0], nx = b.st[1];
        if (nloc == 0u) { xcd_barrier_complete(bar, b.x, nloc, nx); b.st[0] = nloc; b.st[1] = nx; }
        const unsigned old = xb_add(&bar[XB_XSUB(b.x)], 1u);
        const unsigned gen = old / nloc;
        if (old + 1u == (gen + 1u) * nloc) {
            __builtin_amdgcn_fence(__ATOMIC_RELEASE, "agent");
            asm volatile("s_waitcnt vmcnt(0)" ::: "memory");
            const unsigned og = xb_add(&bar[XB_TOP], 1u);
            const unsigned tg = og / nx;
            if (og + 1u == (tg + 1u) * nx) xb_add(&bar[XB_TOPGEN], 1u);
            else XB_SPIN(xb_ld(&bar[XB_TOPGEN]) == tg, bar);
            __builtin_amdgcn_fence(__ATOMIC_ACQUIRE, "agent");
            xb_add(&bar[XB_XGEN(b.x)], 1u);
            asm volatile("s_waitcnt vmcnt(0)" ::: "memory");
        } else {
            XB_SPIN(xb_ld(&bar[XB_XGEN(b.x)]) == gen, bar);
            __builtin_amdgcn_fence(__ATOMIC_ACQUIRE, "agent");
            asm volatile("s_waitcnt vmcnt(0)" ::: "memory");
        }
    }
    __syncthreads();
}


__global__ void __launch_bounds__(512) mega_fwd(Params p) {
    extern __shared__ __attribute__((aligned(16))) unsigned char lds_raw[];
    LAS unsigned char* lds = (LAS unsigned char*)lds_raw;
    const int G = gridDim.x, bx = blockIdx.x;
    const int vcu = (G % 8 == 0) ? (bx % 8) * (G / 8) + bx / 8 : bx;
    const Epi E{p.ws};
    unsigned* barw = (unsigned*)p.ws + 4096;
    volatile LAS unsigned* bst = (volatile LAS unsigned*)(lds + LDS_BYTES - 16);
    if (threadIdx.x == 0) { bst[0] = 0u; bst[1] = 0u; }
    __syncthreads();
    XcdBarrier bar = xcd_barrier_post(barw, bst);
#ifdef TSTAMP
    int nst = 0;
#define STAMP() do { if (bx == 0 && threadIdx.x == 0) ((unsigned long long*)p.ws)[nst] = __builtin_amdgcn_s_memrealtime(); ++nst; } while (0)
#else
#define STAMP() do {} while (0)
#endif
#define GRID_BAR() do { xcd_barrier(bar); STAMP(); } while (0)
    STAMP();
#pragma unroll 1
    for (int l = 0; l < 2; ++l) {
        p0_stage(p, l, lds);
        GRID_BAR();
#ifndef PROBE_REP
#define PROBE_REP 0
#endif
        for (int rep = 0; rep < ((PROBE_REP == 1 || PROBE_REP == 2) ? 2 : 1); ++rep) {
        { SchedA S{p.ws, G, bx}; pg8::gemm_phase<Epi, SchedA>(lds, S, E); }
        GRID_BAR();
        if (PROBE_REP == 1 && rep == 0) continue;
        for (int u = bx; u < 1024; u += G) delta_pre_unit(p, l, u, lds);
        GRID_BAR();
        if (G >= 64) {
            if (bx < 32) delta_scan_unit(p, l, bx, lds);
            else for (int u = bx - 32; u < 1024; u += G - 32) { if (u < 256) swa_unit(p, l, u, lds); else if (u < 512) xmem_unit(p, l, u - 256, lds); else gmlp_unit(p, l, u - 512, lds); }
        } else {
            for (int u = bx; u < 32 + 1024; u += G) { if (u < 32) delta_scan_unit(p, l, u, lds); else if (u < 288) swa_unit(p, l, u - 32, lds); else if (u < 544) xmem_unit(p, l, u - 288, lds); else gmlp_unit(p, l, u - 544, lds); }
        }
        GRID_BAR();
        }
        for (int rep = 0; rep < ((PROBE_REP == 3 || PROBE_REP == 4) ? 2 : 1); ++rep) {
        { SchedD S{p.ws, G, vcu}; pg8::gemm_phase<Epi, SchedD>(lds, S, E); }
        GRID_BAR();
        if (PROBE_REP == 3 && rep == 0) continue;
        { SchedE S{p.ws, G, vcu}; pg8::gemm_phase<Epi, SchedE>(lds, S, E); }
        GRID_BAR();
        }
    }
    p0_stage(p, 2, lds);
#ifdef TSTAMP
    __syncthreads();
    if (bx == 0 && threadIdx.x == 0) { const unsigned long long* st = (const unsigned long long*)p.ws; const float us = (float)(st[TS_B] - st[TS_A]) * 0.01f; p.out[0] += us * TS_SCALE; }
#endif
}

extern "C" void kernel_launch(void* const* d_in, const int* in_sizes, int n_in, void* d_out, int out_size, void* d_ws, size_t ws_size, hipStream_t stream) {
    static int grid = 0;
    if (grid == 0) {
        if (n_in != 17 || out_size != M * D || ws_size < WS_END) { fprintf(stderr, "kernel_launch: unexpected shapes / workspace (%d inputs, out %d, ws %zu)\n", n_in, out_size, ws_size); grid = -1; return; }
        int dev = 0, cus = 0, per_cu = 0;
        hipGetDevice(&dev);
        hipDeviceGetAttribute(&cus, hipDeviceAttributeMultiprocessorCount, dev);
        hipFuncSetAttribute((const void*)mega_fwd, hipFuncAttributeMaxDynamicSharedMemorySize, LDS_BYTES);
        hipOccupancyMaxActiveBlocksPerMultiprocessor(&per_cu, (const void*)mega_fwd, 512, LDS_BYTES);
        if (per_cu < 1) { fprintf(stderr, "kernel_launch: occupancy query reports %d blocks per CU\n", per_cu); (void)hipGetLastError(); per_cu = 1; }
        grid = cus * 1;
    }
    if (grid < 0) return;
    Params p{};
    p.x = (const float*)d_in[0]; p.mem = (const float*)d_in[1]; p.norm_pre = (const float*)d_in[2]; p.norm_post = (const float*)d_in[3]; p.norm_mem = (const float*)d_in[4];
    p.w_in = (const float*)d_in[5]; p.conv_w = (const float*)d_in[6]; p.a_log = (const float*)d_in[7]; p.dt_bias = (const float*)d_in[8]; p.dn_norm = (const float*)d_in[9];
    p.gm_norm = (const float*)d_in[10]; p.spatial_w = (const float*)d_in[11]; p.spatial_b = (const float*)d_in[12]; p.sinks = (const float*)d_in[13];
    p.w_mem_kv = (const float*)d_in[14]; p.w_up = (const float*)d_in[15]; p.w_out = (const float*)d_in[16];
    p.out = (float*)d_out; p.ws = (unsigned char*)d_ws;
    if (hipMemsetAsync((char*)d_ws + 16384, 0, XCD_BAR_WORDS * 4, stream) != hipSuccess) { fprintf(stderr, "kernel_launch: memset of the barrier words failed\n"); return; }
    void* args[] = {&p};
    hipError_t e = hipLaunchCooperativeKernel((const void*)mega_fwd, dim3(grid), dim3(512), args, LDS_BYTES, stream);
    if (e != hipSuccess) fprintf(stderr, "cooperative launch failed: %s (grid %d)\n", hipGetErrorString(e), grid);
}
```
